# Optimizing an MI355X kernel written in HIP

```python
import math
import jax, jax.numpy as jnp
from jax import lax
import numpy as np

D_MODEL = 4096
BATCH = 2
SEQ = 4096
DEPTH = 1

HEAD_DIM = 128
BLOCK = 128
GM_GROUPS = 12
GM_GROUP_DIM = 128
GM_WIDTH = GM_GROUPS * GM_GROUP_DIM
DIL_PAIRS = ((128, 1), (512, 4), (2048, 16))
DIL_HEADS = 4
DIL_GROUP_WIDTH = DIL_HEADS * HEAD_DIM
DIL_WIDTH = len(DIL_PAIRS) * DIL_GROUP_WIDTH
MEM_LEN = 256
MEM_HEADS = 4
MEM_HEAD_DIM = 256
MEM_WIDTH = MEM_HEADS * MEM_HEAD_DIM
N_BRANCHES = 3
IN_WIDTH = 2 * GM_WIDTH + 3 * DIL_WIDTH + MEM_WIDTH
PEER_HEADS = 8
PEER_KEYS = 128
PEER_EXPERTS = PEER_KEYS * PEER_KEYS
PEER_TOPK = 16
PEER_QUERY_DIM = 256
PEER_TOKEN_BLOCK = 128
ROPE_THETA = 10000.0
LN_EPS = 1e-5
DEEPNORM_ALPHA = (2 * DEPTH) ** 0.25
DEEPNORM_BETA = (8 * DEPTH) ** -0.25
NEG_INF = -1e30

kernel_name = "hybrid_gmlp_dilated_mem_peer_layer"


def layer_norm(x, g, b):
    xf = x.astype(jnp.float32)
    mu = jnp.mean(xf, axis=-1, keepdims=True)
    var = jnp.mean(jnp.square(xf - mu), axis=-1, keepdims=True)
    y = (xf - mu) * lax.rsqrt(var + LN_EPS)
    return (y * g.astype(jnp.float32) + b.astype(jnp.float32)).astype(x.dtype)


def rotary(t, positions):
    half = t.shape[-1] // 2
    inv_freq = ROPE_THETA ** (-jnp.arange(half, dtype=jnp.float32) / half)
    ang = positions.astype(jnp.float32)[..., None] * inv_freq
    cos = jnp.cos(ang)[:, :, None, :]
    sin = jnp.sin(ang)[:, :, None, :]
    tf = t.astype(jnp.float32)
    t1, t2 = tf[..., :half], tf[..., half:]
    return jnp.concatenate([t1 * cos - t2 * sin, t2 * cos + t1 * sin], axis=-1).astype(t.dtype)


def chunked_gmlp(u, v, ln_g, ln_b, w_s, b_s):
    B, S, _ = v.shape
    v = layer_norm(v, ln_g, ln_b)
    vb = v.reshape(B, S // BLOCK, BLOCK, GM_GROUPS, GM_GROUP_DIM)
    causal = jnp.tril(jnp.ones((BLOCK, BLOCK), dtype=bool))
    w = jnp.where(causal[None], w_s, jnp.zeros_like(w_s))
    mixed = jnp.einsum('gts,bnsgc->bntgc', w, vb) + b_s.T[None, None, :, :, None]
    return u * mixed.reshape(B, S, GM_WIDTH)


def dilated_window_attention(q, k, v, window, dilation):
    B, S, H, C = q.shape
    L = S // dilation
    nb = -(-L // BLOCK)
    Lp = nb * BLOCK
    span = window // dilation

    def to_sub(t):
        t = t.reshape(B, L, dilation, H, C).transpose(0, 2, 1, 3, 4)
        t = jnp.pad(t, ((0, 0), (0, 0), (0, Lp - L), (0, 0), (0, 0)))
        return t.reshape(B, dilation, nb, BLOCK, H, C)

    def with_prev(t):
        prev = jnp.pad(t[:, :, :-1], ((0, 0), (0, 0), (1, 0), (0, 0), (0, 0), (0, 0)))
        return jnp.concatenate([prev, t], axis=3)

    qs = to_sub(q)
    kk = with_prev(to_sub(k))
    vv = with_prev(to_sub(v))
    scores = jnp.einsum('brnqhc,brnkhc->brnhqk', qs, kk).astype(jnp.float32) * (C ** -0.5)
    qi = BLOCK + jnp.arange(BLOCK)[:, None]
    ki = jnp.arange(2 * BLOCK)[None, :]
    dist = qi - ki
    local = (dist >= 0) & (dist <= span)
    has_prev = (jnp.arange(nb)[:, None, None] > 0) | (ki[None] >= BLOCK)
    mask = local[None] & has_prev
    scores = jnp.where(mask[None, None, :, None], scores, NEG_INF)
    lse = jax.nn.logsumexp(scores, axis=-1)
    probs = jnp.exp(scores - lse[..., None])
    out = jnp.einsum('brnhqk,brnkhc->brnqhc', probs.astype(v.dtype), vv)
    out = out.reshape(B, dilation, Lp, H, C)[:, :, :L].transpose(0, 2, 1, 3, 4).reshape(B, S, H, C)
    lse = lse.transpose(0, 1, 2, 4, 3).reshape(B, dilation, Lp, H)[:, :, :L]
    lse = lse.transpose(0, 2, 1, 3).reshape(B, S, H)
    return out, lse


def mixer_block(h, mem, positions, w_in, gm_ln_g, gm_ln_b, gm_w_s, gm_b_s, w_mem_kv,
                w_gate, b_gate, w_br_gmlp, w_br_dil, w_br_mem, w_out):
    B, S, D = h.shape
    proj = h @ w_in
    splits = [int(c) for c in np.cumsum([GM_WIDTH, GM_WIDTH, DIL_WIDTH, DIL_WIDTH, DIL_WIDTH])]
    gu, gv, dq, dk, dv, mq = jnp.split(proj, splits, axis=-1)

    a_out = chunked_gmlp(jax.nn.gelu(gu), jax.nn.gelu(gv), gm_ln_g, gm_ln_b, gm_w_s, gm_b_s)

    n_dil_heads = len(DIL_PAIRS) * DIL_HEADS
    dq = rotary(dq.reshape(B, S, n_dil_heads, HEAD_DIM), positions)
    dk = rotary(dk.reshape(B, S, n_dil_heads, HEAD_DIM), positions)
    dv = dv.reshape(B, S, n_dil_heads, HEAD_DIM)
    outs, lses = [], []
    for g, (window, dilation) in enumerate(DIL_PAIRS):
        sl = slice(g * DIL_HEADS, (g + 1) * DIL_HEADS)
        o, l = dilated_window_attention(dq[:, :, sl], dk[:, :, sl], dv[:, :, sl], window, dilation)
        outs.append(o)
        lses.append(l)
    weights = jax.nn.softmax(jnp.stack(lses, axis=0), axis=0)
    b_out = jnp.einsum('gbsh,gbshc->bshc', weights.astype(dv.dtype), jnp.stack(outs, axis=0))
    b_out = b_out.reshape(B, S, DIL_GROUP_WIDTH)

    mkv = (mem @ w_mem_kv).reshape(B, MEM_LEN, 2, MEM_HEADS, MEM_HEAD_DIM)
    mq = mq.reshape(B, S, MEM_HEADS, MEM_HEAD_DIM)
    ms = jnp.einsum('bshc,bmhc->bhsm', mq, mkv[:, :, 0]).astype(jnp.float32) * (MEM_HEAD_DIM ** -0.5)
    mp = jax.nn.softmax(ms, axis=-1)
    m_out = jnp.einsum('bhsm,bmhc->bshc', mp.astype(mq.dtype), mkv[:, :, 1]).reshape(B, S, MEM_WIDTH)

    gates = jax.nn.sigmoid(h @ w_gate + b_gate).reshape(B, S, N_BRANCHES, D)
    merged = (gates[:, :, 0] * (a_out @ w_br_gmlp)
              + gates[:, :, 1] * (b_out @ w_br_dil)
              + gates[:, :, 2] * (m_out @ w_br_mem))
    return merged @ w_out


def peer_ffn(h, w_query, sub_keys, expert_u, expert_v):
    B, S, D = h.shape
    T = B * S
    xt = h.reshape(T, D)
    q = (xt @ w_query).reshape(T, PEER_HEADS, 2, PEER_QUERY_DIM // 2)
    s = jnp.einsum('thpc,hpkc->thpk', q, sub_keys).astype(jnp.float32)
    s_top, i_top = lax.top_k(s, PEER_TOPK)
    cand = s_top[:, :, 0, :, None] + s_top[:, :, 1, None, :]
    cand_idx = i_top[:, :, 0, :, None] * PEER_KEYS + i_top[:, :, 1, None, :]
    best, pos = lax.top_k(cand.reshape(T, PEER_HEADS, PEER_TOPK * PEER_TOPK), PEER_TOPK)
    experts = jnp.take_along_axis(cand_idx.reshape(T, PEER_HEADS, PEER_TOPK * PEER_TOPK), pos, axis=-1)
    gate = jax.nn.softmax(best, axis=-1).astype(h.dtype)

    n_sel = PEER_HEADS * PEER_TOPK
    nblk = T // PEER_TOKEN_BLOCK

    def block_fn(args):
        xb, eb, gb = args
        u = expert_u[eb]
        act = jax.nn.gelu(jnp.einsum('td,ted->te', xb, u)) * gb
        return jnp.einsum('te,ted->td', act, expert_v[eb])

    y = lax.map(block_fn, (xt.reshape(nblk, PEER_TOKEN_BLOCK, D),
                           experts.reshape(nblk, PEER_TOKEN_BLOCK, n_sel),
                           gate.reshape(nblk, PEER_TOKEN_BLOCK, n_sel)))
    return y.reshape(B, S, D)


def setup_inputs(seed: int = 0) -> dict:
    key = jax.random.key(seed)
    ks = jax.random.split(key, 24)

    def nrm(k, shape, scale):
        return jax.random.normal(k, shape, dtype=jnp.float32) * scale

    D = D_MODEL
    x = nrm(ks[0], (BATCH, SEQ, D), 1.0)
    mem = nrm(ks[1], (BATCH, MEM_LEN, D), 1.0)
    positions = (jax.random.randint(ks[2], (BATCH, 1), 0, 1024, dtype=jnp.int32)
                 + jnp.arange(SEQ, dtype=jnp.int32)[None, :])
    col_scale = jnp.concatenate([
        jnp.ones((2 * GM_WIDTH + 2 * DIL_WIDTH,), jnp.float32),
        jnp.full((DIL_WIDTH,), DEEPNORM_BETA, jnp.float32),
        jnp.ones((MEM_WIDTH,), jnp.float32)])
    w_in = nrm(ks[3], (DEPTH, D, IN_WIDTH), D ** -0.5) * col_scale
    gm_ln_g = 1.0 + nrm(ks[4], (DEPTH, GM_WIDTH), 0.01)
    gm_ln_b = nrm(ks[5], (DEPTH, GM_WIDTH), 0.01)
    gm_w_s = nrm(ks[6], (DEPTH, GM_GROUPS, BLOCK, BLOCK), BLOCK ** -0.5)
    gm_b_s = 1.0 + nrm(ks[7], (DEPTH, GM_GROUPS, BLOCK), 0.01)
    kv_scale = jnp.concatenate([jnp.ones((MEM_WIDTH,), jnp.float32),
                                jnp.full((MEM_WIDTH,), DEEPNORM_BETA, jnp.float32)])
    w_mem_kv = nrm(ks[8], (DEPTH, D, 2 * MEM_WIDTH), D ** -0.5) * kv_scale
    w_gate = nrm(ks[9], (DEPTH, D, N_BRANCHES * D), D ** -0.5)
    b_gate = nrm(ks[10], (DEPTH, N_BRANCHES * D), 0.01)
    w_br_gmlp = nrm(ks[11], (DEPTH, GM_WIDTH, D), GM_WIDTH ** -0.5 * DEEPNORM_BETA)
    w_br_dil = nrm(ks[12], (DEPTH, DIL_GROUP_WIDTH, D), DIL_GROUP_WIDTH ** -0.5 * DEEPNORM_BETA)
    w_br_mem = nrm(ks[13], (DEPTH, MEM_WIDTH, D), MEM_WIDTH ** -0.5 * DEEPNORM_BETA)
    w_out = nrm(ks[14], (DEPTH, D, D), D ** -0.5 * DEEPNORM_BETA)
    ln_mix_g = 1.0 + nrm(ks[15], (DEPTH, D), 0.01)
    ln_mix_b = nrm(ks[16], (DEPTH, D), 0.01)
    peer_w_query = nrm(ks[17], (DEPTH, D, PEER_HEADS * PEER_QUERY_DIM), D ** -0.5)
    peer_sub_keys = nrm(ks[18], (DEPTH, PEER_HEADS, 2, PEER_KEYS, PEER_QUERY_DIM // 2),
                        (PEER_QUERY_DIM // 2) ** -0.5)
    peer_u = nrm(ks[19], (DEPTH, PEER_EXPERTS, D), D ** -0.5)
    peer_v = nrm(ks[20], (DEPTH, PEER_EXPERTS, D), DEEPNORM_BETA)
    ln_ffn_g = 1.0 + nrm(ks[21], (DEPTH, D), 0.01)
    ln_ffn_b = nrm(ks[22], (DEPTH, D), 0.01)
    return {"x": x, "mem": mem, "positions": positions, "w_in": w_in,
            "gm_ln_g": gm_ln_g, "gm_ln_b": gm_ln_b, "gm_w_s": gm_w_s, "gm_b_s": gm_b_s,
            "w_mem_kv": w_mem_kv, "w_gate": w_gate, "b_gate": b_gate,
            "w_br_gmlp": w_br_gmlp, "w_br_dil": w_br_dil, "w_br_mem": w_br_mem,
            "w_out": w_out, "ln_mix_g": ln_mix_g, "ln_mix_b": ln_mix_b,
            "peer_w_query": peer_w_query, "peer_sub_keys": peer_sub_keys,
            "peer_u": peer_u, "peer_v": peer_v, "ln_ffn_g": ln_ffn_g, "ln_ffn_b": ln_ffn_b}


def reference(x, mem, positions, w_in, gm_ln_g, gm_ln_b, gm_w_s, gm_b_s, w_mem_kv,
              w_gate, b_gate, w_br_gmlp, w_br_dil, w_br_mem, w_out, ln_mix_g, ln_mix_b,
              peer_w_query, peer_sub_keys, peer_u, peer_v, ln_ffn_g, ln_ffn_b):
    h = x
    for l in range(DEPTH):
        y = mixer_block(h, mem, positions, w_in[l], gm_ln_g[l], gm_ln_b[l], gm_w_s[l], gm_b_s[l],
                        w_mem_kv[l], w_gate[l], b_gate[l], w_br_gmlp[l], w_br_dil[l],
                        w_br_mem[l], w_out[l])
        h = layer_norm(DEEPNORM_ALPHA * h + y, ln_mix_g[l], ln_mix_b[l])
        y = peer_ffn(h, peer_w_query[l], peer_sub_keys[l], peer_u[l], peer_v[l])
        h = layer_norm(DEEPNORM_ALPHA * h + y, ln_ffn_g[l], ln_ffn_b[l])
    return h
```

```cpp
#include <hip/hip_runtime.h>
#include <cstdio>
#include <cstdint>
#ifndef DBG_NEXPERTS
#define DBG_NEXPERTS 128
#endif
#ifndef DBG_MIXSCALE
#define DBG_MIXSCALE 1.0f
#endif
#ifndef DBG_BR
#define DBG_BR 7
#endif
#ifndef DBG_P5A
#define DBG_P5A 0
#endif
#ifndef DBG_P4SRC
#define DBG_P4SRC 0
#endif
#ifndef DBG_ZALT
#define DBG_ZALT 0
#endif
#ifndef DBG_GATEPLAIN
#define DBG_GATEPLAIN 0
#endif
namespace pg8 {
#define PG8_LAS __attribute__((address_space(3)))
typedef unsigned short bf16_t;
typedef short bf16x8 __attribute__((ext_vector_type(8)));
typedef float f32x4 __attribute__((ext_vector_type(4)));
typedef unsigned u32x4 __attribute__((ext_vector_type(4)));
constexpr int BM = 256, BK = 64, HALF = 128, HTB = HALF * BK * 2  , STAGE_BYTES = 8 * HTB, NXCD = 8, WGM = 8;

__host__ __device__ __forceinline__ int lds_byte(int r, int c) { const int st = (r >> 4) * 2 + (c >> 5), rr = r & 15, cc = c & 31, ob = rr * 64 + cc * 2; return st * 1024 + (ob ^ (((ob >> 9) & 1) << 5)); }
__host__ __device__ __forceinline__ void stage_rc(int b, int& R, int& C) { const int st = b / 1024, sb = b % 1024, swz = sb ^ (((sb >> 9) & 1) << 5); R = (st >> 1) * 16 + swz / 64; C = (st & 1) * 32 + (swz % 64) / 2; }
__host__ __device__ __forceinline__ int perm32(int rho) { const int n = rho >> 4, i = rho & 15; return 8 * (i >> 2) + 4 * n + (i & 3); }

struct Unit { int pm, pn; };
struct Gemm { const bf16_t* A; const bf16_t* Bt; int M, N, K; };

struct StaticOrder {
    int nM, nN, nwg, G, c;
    __host__ __device__ void init(int M, int N, int G_, int c_) { nM = M / BM; nN = N / BM; nwg = nM * nN; G = G_; c = c_; }
    __host__ __device__ bool next(int i, Unit& u) const {
        const long L = (long)i * G + c; if (L >= nwg) return false;
        int wgid = (int)L; { const int q = nwg / NXCD, r = nwg % NXCD, xcd = wgid % NXCD, off = wgid / NXCD; wgid = (xcd < r ? xcd * (q + 1) : r * (q + 1) + (xcd - r) * q) + off; }
        const int nig = WGM * nN, gid = wgid / nig, fm = gid * WGM, gsz = (nM - fm) < WGM ? (nM - fm) : WGM;
        u.pm = fm + ((wgid % nig) % gsz); u.pn = (wgid % nig) / gsz; return true;
    }
    __device__ __forceinline__ void a_ready(const Unit&) const {}
    __device__ __forceinline__ void done(const Unit&) const {}
};

typedef __bf16 bf16x2_t __attribute__((ext_vector_type(2)));
typedef float f32x2_t __attribute__((ext_vector_type(2)));
__device__ __forceinline__ unsigned cvt_pk_bf16(float lo, float hi) { const bf16x2_t r = __builtin_convertvector((f32x2_t){lo, hi}, bf16x2_t); return __builtin_bit_cast(unsigned, r); }
typedef float f32x2 __attribute__((ext_vector_type(2)));
typedef float f32x4u __attribute__((ext_vector_type(4), aligned(16)));
__device__ __forceinline__ float gelu_tanh(float x) {
    const float u = x * (1.5957691216f + 0.0713548163f * x * x);
    const float e = __builtin_amdgcn_exp2f(-1.4426950409f * u);
    return x * __builtin_amdgcn_rcpf(1.0f + e);
}
__device__ __forceinline__ float sigmoid_f(float x) { return __builtin_amdgcn_rcpf(1.0f + __builtin_amdgcn_exp2f(-1.4426950409f * x)); }
__device__ __forceinline__ u32x4 pack8(const f32x4& v0, const f32x4& v1) { u32x4 w; w.x = cvt_pk_bf16(v0[0], v0[1]); w.y = cvt_pk_bf16(v0[2], v0[3]); w.z = cvt_pk_bf16(v1[0], v1[1]); w.w = cvt_pk_bf16(v1[2], v1[3]); return w; }
__device__ __forceinline__ float bf_lo(unsigned w) { return __builtin_bit_cast(float, w << 16); }
__device__ __forceinline__ float bf_hi(unsigned w) { return __builtin_bit_cast(float, w & 0xffff0000u); }

struct EpiProj {
    static constexpr bool PERM = true, AFTER_DRAIN = false;
    bf16_t* proj; bf16_t* gates; bf16_t* mkv; const float* bgate; const float* rope;
    template <int KIND> __device__ __forceinline__ void tile(const f32x4 (&acc)[2][2][4][2], bf16_t* base, int ldc, int row0, int cb, float sc, const float* bias) const {
        f32x4 bv[2][2];
        if (KIND == 3) {
#pragma unroll
            for (int bj = 0; bj < 2; ++bj)
#pragma unroll
                for (int n = 0; n < 2; ++n) bv[bj][n] = *(const f32x4*)(bias + bj * HALF + 4 * n);
        }
#pragma unroll
        for (int ai = 0; ai < 2; ++ai)
#pragma unroll
            for (int m = 0; m < 4; ++m) {
                const int row = row0 + ai * HALF + m * 16;
                bf16_t* rowp = base + (size_t)row * ldc;
                f32x4 r0, r1;
                if (KIND == 1) { const float* rp = rope + (size_t)row * 128 + cb; r0 = *(const f32x4*)rp; r1 = *(const f32x4*)(rp + 4); }
#pragma unroll
                for (int bj = 0; bj < 2; ++bj) {
                    f32x4 v0 = acc[ai][bj][m][0], v1 = acc[ai][bj][m][1];
                    if (KIND == 0) {
#pragma unroll
                        for (int j = 0; j < 4; ++j) { v0[j] = gelu_tanh(v0[j]); v1[j] = gelu_tanh(v1[j]); }
                    } else if (KIND == 1) {
                        f32x4 a0, a1;
                        a0[0] = v0[0] * r0[0] - v0[1] * r0[1]; a0[1] = v0[1] * r0[0] + v0[0] * r0[1];
                        a0[2] = v0[2] * r0[2] - v0[3] * r0[3]; a0[3] = v0[3] * r0[2] + v0[2] * r0[3];
                        a1[0] = v1[0] * r1[0] - v1[1] * r1[1]; a1[1] = v1[1] * r1[0] + v1[0] * r1[1];
                        a1[2] = v1[2] * r1[2] - v1[3] * r1[3]; a1[3] = v1[3] * r1[2] + v1[2] * r1[3];
                        v0 = a0 * sc; v1 = a1 * sc;
                    } else if (KIND == 2) { v0 = v0 * sc; v1 = v1 * sc;
                    } else if (KIND == 3) {
                        v0 = v0 + bv[bj][0]; v1 = v1 + bv[bj][1];
#pragma unroll
                        for (int j = 0; j < 4; ++j) { v0[j] = sigmoid_f(v0[j]); v1[j] = sigmoid_f(v1[j]); }
                    }
                    *(u32x4*)(rowp + bj * HALF) = pack8(v0, v1);
                }
            }
    }
    __device__ __forceinline__ void operator()(const f32x4 (&acc)[2][2][4][2], const Unit& u, int wr, int wc, int fr, int fq) const {
        const int row0 = u.pm * BM + wr * 64 + fr, cw = wc * 32 + 8 * fq;
        if (u.pm >= 32) { tile<2>(acc, mkv + (u.pn - 82) * BM + cw, 2048, row0 - 8192, 0, 1.0f, nullptr); }
        else if (u.pn < 12) { tile<0>(acc, proj + u.pn * BM + cw, 8704, row0, 0, 1.0f, nullptr); }
        else if (u.pn < 24) { tile<1>(acc, proj + u.pn * BM + cw, 8704, row0, cw, u.pn < 18 ? 0.08838834764831845f : 1.0f, nullptr); }
        else if (u.pn < 34) { tile<2>(acc, proj + u.pn * BM + cw, 8704, row0, 0, u.pn >= 30 ? 0.0625f : 1.0f, nullptr); }
        else { const int cg = (u.pn - 34) * BM + cw; if (DBG_GATEPLAIN) tile<2>(acc, gates + cg, 12288, row0, 0, 1.0f, nullptr); else tile<3>(acc, gates + cg, 12288, row0, 0, 1.0f, bgate + cg); }
    }
};

template <int STEP> struct EpiMerge {
    static constexpr bool PERM = true, AFTER_DRAIN = false;
    const bf16_t* gates; float* merged; bf16_t* mergedb;
    __device__ __forceinline__ void operator()(const f32x4 (&acc)[2][2][4][2], const Unit& u, int wr, int wc, int fr, int fq) const {
        const int row0 = u.pm * BM + wr * 64 + fr, col0 = u.pn * BM + wc * 32 + 8 * fq;
#pragma unroll
        for (int ai = 0; ai < 2; ++ai)
#pragma unroll
            for (int m = 0; m < 4; ++m) {
                const size_t row = (size_t)(row0 + ai * HALF + m * 16);
#pragma unroll
                for (int bj = 0; bj < 2; ++bj) {
                    const int col = col0 + bj * HALF;
                    const u32x4 g = *(const u32x4*)(gates + row * 12288 + col);
                    f32x4 v0 = acc[ai][bj][m][0], v1 = acc[ai][bj][m][1];
                    if (!((DBG_BR >> STEP) & 1)) { v0 = v0 * 0.f; v1 = v1 * 0.f; }
                    v0[0] *= bf_lo(g.x); v0[1] *= bf_hi(g.x); v0[2] *= bf_lo(g.y); v0[3] *= bf_hi(g.y);
                    v1[0] *= bf_lo(g.z); v1[1] *= bf_hi(g.z); v1[2] *= bf_lo(g.w); v1[3] *= bf_hi(g.w);
                    float* mp = merged + row * 4096 + col;
                    if (STEP > 0) { v0 = v0 + *(const f32x4*)mp; v1 = v1 + *(const f32x4*)(mp + 4); }
                    if (STEP < 2) { *(f32x4*)mp = v0; *(f32x4*)(mp + 4) = v1; }
                    else *(u32x4*)(mergedb + row * 4096 + col) = pack8(v0, v1);
                }
            }
    }
};

struct EpiResid {
    static constexpr bool PERM = true, AFTER_DRAIN = false;
    const float* x; float* z; float alpha;
    __device__ __forceinline__ void operator()(const f32x4 (&acc)[2][2][4][2], const Unit& u, int wr, int wc, int fr, int fq) const {
        const int row0 = u.pm * BM + wr * 64 + fr, col0 = u.pn * BM + wc * 32 + 8 * fq;
#pragma unroll
        for (int ai = 0; ai < 2; ++ai)
#pragma unroll
            for (int m = 0; m < 4; ++m) {
                const size_t row = (size_t)(row0 + ai * HALF + m * 16);
#pragma unroll
                for (int bj = 0; bj < 2; ++bj) {
                    const size_t o = row * 4096 + col0 + bj * HALF;
                    const f32x4 x0 = *(const f32x4*)(x + o), x1 = *(const f32x4*)(x + o + 4);
                    *(f32x4*)(z + o) = x0 * alpha + acc[ai][bj][m][0] * DBG_MIXSCALE; *(f32x4*)(z + o + 4) = x1 * alpha + acc[ai][bj][m][1] * DBG_MIXSCALE;
                }
            }
    }
};

struct EpiPlain {
    static constexpr bool PERM = true, AFTER_DRAIN = false;
    bf16_t* O; int ldc;
    __device__ __forceinline__ void operator()(const f32x4 (&acc)[2][2][4][2], const Unit& u, int wr, int wc, int fr, int fq) const {
        const int row0 = u.pm * BM + wr * 64 + fr, col0 = u.pn * BM + wc * 32 + 8 * fq;
#pragma unroll
        for (int ai = 0; ai < 2; ++ai)
#pragma unroll
            for (int m = 0; m < 4; ++m) {
                bf16_t* rowp = O + (size_t)(row0 + ai * HALF + m * 16) * ldc + col0;
#pragma unroll
                for (int bj = 0; bj < 2; ++bj) *(u32x4*)(rowp + bj * HALF) = pack8(acc[ai][bj][m][0], acc[ai][bj][m][1]);
            }
    }
};

struct SchedP1 {
    StaticOrder so;
    __host__ __device__ void init(int G_, int c_) { so.init(8192, 82 * 256, G_, c_); }
    __host__ __device__ bool next(int i, Unit& u) const {
        if (so.next(i, u)) return true;
        const long L = (long)i * so.G + so.c - so.nwg; if (L < 0 || L >= 16) return false;
        u.pm = 32 + (int)(L >> 3); u.pn = 82 + (int)(L & 7); return true;
    }
    __device__ __forceinline__ void a_ready(const Unit&) const {}
    __device__ __forceinline__ void done(const Unit&) const {}
};

template <class Epi, class Sched, bool ALIGN_EPI = false, bool SP2 = false>
__device__ __forceinline__ void gemm_phase(PG8_LAS unsigned char* lds, const Gemm g, const Sched& S, const Epi& E) {
    const int tid = threadIdx.x, wid = __builtin_amdgcn_readfirstlane(tid >> 6), lane = tid & 63, wr = wid >> 2, wc = wid & 3, fr = lane & 15, fq = lane >> 4;
    const int K = g.K, nt = K / BK;
    unsigned voffA[2], voffB[2];
#pragma unroll
    for (int i = 0; i < 2; ++i) { int R, C; stage_rc(tid * 16 + i * 8192, R, C); const int Rb = Epi::PERM ? ((R & ~31) + perm32(R & 31)) : R;
        voffA[i] = (unsigned)(R * K + C) * 2u; voffB[i] = (unsigned)(Rb * K + C) * 2u; }
    const size_t kstep = (size_t)(BK * 2);
    const size_t hstep = (size_t)HALF * K * 2;
    const size_t tstep = 2 * hstep;
    const unsigned ldsw = (unsigned)wid * 1024u;
    const int aoff = lds_byte(wr * 64 + fr, fq * 8), boff = lds_byte(wc * 32 + fr, fq * 8);
#define PG8_SA(b, h) (((b) * 2 + (h)) * HTB)
#define PG8_SB(b, h) ((4 + (b) * 2 + (h)) * HTB)
#define PG8_STAGE(bufoff, gbase, voff) do { _Pragma("unroll") for (int _i = 0; _i < 2; ++_i) \
        __builtin_amdgcn_global_load_lds((const unsigned*)((const char*)(gbase) + (voff)[_i]), (PG8_LAS unsigned*)(lds + (bufoff) + ldsw + _i * 8192), 16, 0, 0); } while (0)
#define PG8_LDA(dst, b, h) do { _Pragma("unroll") for (int m = 0; m < 4; ++m) _Pragma("unroll") for (int k = 0; k < 2; ++k) dst[m][k] = *(const PG8_LAS bf16x8*)(lds + PG8_SA(b, h) + aoff + m * 2048 + k * 1024); } while (0)
#define PG8_LDB(dst, b, h) do { _Pragma("unroll") for (int n = 0; n < 2; ++n) _Pragma("unroll") for (int k = 0; k < 2; ++k) dst[n][k] = *(const PG8_LAS bf16x8*)(lds + PG8_SB(b, h) + boff + n * 2048 + k * 1024); } while (0)
#define PG8_MMA(ai, bj, At, Bt) do { __builtin_amdgcn_s_setprio(1); _Pragma("unroll") for (int m = 0; m < 4; ++m) _Pragma("unroll") for (int n = 0; n < 2; ++n) _Pragma("unroll") for (int k = 0; k < 2; ++k) \
        acc[ai][bj][m][n] = __builtin_amdgcn_mfma_f32_16x16x32_bf16(Bt[n][k], At[m][k], acc[ai][bj][m][n], 0, 0, 0); __builtin_amdgcn_s_setprio(0); } while (0)
#define PG8_WAIT_V(n) asm volatile("s_waitcnt vmcnt(" #n ")" ::: "memory")
#define PG8_WAIT_L(n) asm volatile("s_waitcnt lgkmcnt(" #n ")" ::: "memory")
#define PG8_BAR __builtin_amdgcn_s_barrier()
#define PG8_SCHED __builtin_amdgcn_sched_barrier(0)
    Unit cur, nxt; int ui = 0;
    if (!S.next(0, cur)) return;
    f32x4 acc[2][2][4][2];
#pragma unroll
    for (int a = 0; a < 2; ++a)
#pragma unroll
        for (int b = 0; b < 2; ++b)
#pragma unroll
            for (int m = 0; m < 4; ++m)
#pragma unroll
                for (int n = 0; n < 2; ++n) acc[a][b][m][n] = (f32x4){0.f, 0.f, 0.f, 0.f};
    bf16x8 At[4][2], B0[2][2], B1[2][2];
    const char* cA = (const char*)g.A + (size_t)cur.pm * tstep; const char* cB = (const char*)g.Bt + (size_t)cur.pn * tstep;
    S.a_ready(cur);
    if constexpr (SP2) {
        PG8_STAGE(PG8_SB(0, 0), cB, voffB); PG8_STAGE(PG8_SB(0, 1), cB + hstep, voffB); PG8_STAGE(PG8_SA(0, 0), cA, voffA); PG8_STAGE(PG8_SA(0, 1), cA + hstep, voffA);
        if (wr == 1) PG8_BAR;
        PG8_WAIT_V(2); PG8_BAR;
        PG8_STAGE(PG8_SB(1, 0), cB + kstep, voffB); PG8_STAGE(PG8_SA(1, 0), cA + kstep, voffA); PG8_STAGE(PG8_SB(1, 1), cB + hstep + kstep, voffB);
        PG8_WAIT_V(6); PG8_BAR;
    } else {
        PG8_STAGE(PG8_SB(0, 0), cB, voffB); PG8_STAGE(PG8_SA(0, 0), cA, voffA); PG8_STAGE(PG8_SB(0, 1), cB + hstep, voffB); PG8_STAGE(PG8_SA(0, 1), cA + hstep, voffA);
        if (wr == 1) PG8_BAR;
        PG8_WAIT_V(4); PG8_BAR;
        PG8_STAGE(PG8_SB(1, 0), cB + kstep, voffB); PG8_STAGE(PG8_SA(1, 0), cA + kstep, voffA); PG8_STAGE(PG8_SB(1, 1), cB + hstep + kstep, voffB);
        PG8_WAIT_V(6); PG8_BAR;
    }
    for (;;) {
        const bool has_next = S.next(ui + 1, nxt);
        const char* nA = has_next ? (const char*)g.A + (size_t)nxt.pm * tstep : cA; const char* nB = has_next ? (const char*)g.Bt + (size_t)nxt.pn * tstep : cB;
        for (int t = 0; t < nt; t += 2) {
            const bool last = (t == nt - 2);
            const char* a1 = cA + (size_t)(t + 1) * kstep;
            const char* a2 = last ? nA : cA + (size_t)(t + 2) * kstep; const char* b2 = last ? nB : cB + (size_t)(t + 2) * kstep;
            const char* a3 = a2 + kstep; const char* b3 = b2 + kstep;
            if (last && has_next) S.a_ready(nxt);
            if constexpr (SP2) {
            PG8_LDB(B0, 0, 0); PG8_LDB(B1, 0, 1); PG8_SCHED; PG8_LDA(At, 0, 0); PG8_STAGE(PG8_SA(1, 1), a1 + hstep, voffA);
            PG8_WAIT_V(8); PG8_WAIT_L(0); PG8_BAR; PG8_MMA(0, 0, At, B0); PG8_MMA(0, 1, At, B1); PG8_BAR; PG8_SCHED;
            PG8_LDA(At, 0, 1); PG8_STAGE(PG8_SB(0, 0), b2, voffB); PG8_STAGE(PG8_SB(0, 1), b2 + hstep, voffB); PG8_STAGE(PG8_SA(0, 0), a2, voffA);
            PG8_WAIT_V(8); PG8_WAIT_L(0); PG8_BAR; PG8_MMA(1, 0, At, B0); PG8_MMA(1, 1, At, B1); PG8_BAR; PG8_SCHED;
            PG8_LDB(B0, 1, 0); PG8_LDB(B1, 1, 1); PG8_SCHED; PG8_LDA(At, 1, 0); PG8_STAGE(PG8_SA(0, 1), a2 + hstep, voffA);
            PG8_WAIT_V(8); PG8_WAIT_L(0); PG8_BAR; PG8_MMA(0, 0, At, B0); PG8_MMA(0, 1, At, B1); PG8_BAR; PG8_SCHED;
            PG8_LDA(At, 1, 1); PG8_STAGE(PG8_SB(1, 0), b3, voffB); PG8_STAGE(PG8_SB(1, 1), b3 + hstep, voffB); PG8_STAGE(PG8_SA(1, 0), a3, voffA);
            PG8_WAIT_V(8); PG8_WAIT_L(0); PG8_BAR; PG8_MMA(1, 0, At, B0); PG8_MMA(1, 1, At, B1); PG8_BAR; PG8_SCHED;
            } else {
            PG8_LDB(B0, 0, 0); PG8_SCHED; PG8_LDA(At, 0, 0); PG8_STAGE(PG8_SA(1, 1), a1 + hstep, voffA);
            PG8_WAIT_L(8); PG8_BAR; PG8_WAIT_L(0); PG8_MMA(0, 0, At, B0); PG8_BAR; PG8_SCHED;
            PG8_LDB(B1, 0, 1); PG8_STAGE(PG8_SB(0, 0), b2, voffB);
            PG8_BAR; PG8_WAIT_L(0); PG8_MMA(0, 1, At, B1); PG8_BAR;
            PG8_LDA(At, 0, 1); PG8_STAGE(PG8_SA(0, 0), a2, voffA);
            PG8_BAR; PG8_WAIT_L(0); PG8_MMA(1, 0, At, B0); PG8_BAR; PG8_SCHED;
            PG8_STAGE(PG8_SB(0, 1), b2 + hstep, voffB);
            PG8_WAIT_V(6); PG8_BAR; PG8_MMA(1, 1, At, B1); PG8_BAR;
            PG8_LDB(B0, 1, 0); PG8_SCHED; PG8_LDA(At, 1, 0); PG8_STAGE(PG8_SA(0, 1), a2 + hstep, voffA);
            PG8_WAIT_L(8); PG8_BAR; PG8_WAIT_L(0); PG8_MMA(0, 0, At, B0); PG8_BAR; PG8_SCHED;
            PG8_LDB(B1, 1, 1); PG8_STAGE(PG8_SB(1, 0), b3, voffB);
            PG8_BAR; PG8_WAIT_L(0); PG8_MMA(0, 1, At, B1); PG8_BAR;
            PG8_LDA(At, 1, 1); PG8_STAGE(PG8_SA(1, 0), a3, voffA);
            PG8_BAR; PG8_WAIT_L(0); PG8_MMA(1, 0, At, B0); PG8_BAR; PG8_SCHED;
            PG8_STAGE(PG8_SB(1, 1), b3 + hstep, voffB);
            PG8_WAIT_V(6); PG8_BAR; PG8_MMA(1, 1, At, B1); PG8_BAR;
            }
        }
        if constexpr (ALIGN_EPI) { if (wr == 0) PG8_BAR; }
        if constexpr (!Epi::AFTER_DRAIN) { E(acc, cur, wr, wc, fr, fq); S.done(cur); }
        if (!has_next) break;
#pragma unroll
        for (int a = 0; a < 2; ++a)
#pragma unroll
            for (int b = 0; b < 2; ++b)
#pragma unroll
                for (int m = 0; m < 4; ++m)
#pragma unroll
                    for (int n = 0; n < 2; ++n) acc[a][b][m][n] = (f32x4){0.f, 0.f, 0.f, 0.f};
        cur = nxt; cA = nA; cB = nB; ++ui;
        if constexpr (ALIGN_EPI) { if (wr == 1) PG8_BAR; }
    }
    PG8_WAIT_V(0);
    if constexpr (!ALIGN_EPI) { if (wr == 0) PG8_BAR; }
    PG8_BAR;
    if constexpr (Epi::AFTER_DRAIN) { E.fused(acc, cur, wr, wc, fr, fq, lds, wid, lane); S.done(cur); }
#undef PG8_SA
#undef PG8_SB
#undef PG8_STAGE
#undef PG8_LDA
#undef PG8_LDB
#undef PG8_MMA
#undef PG8_WAIT_V
#undef PG8_WAIT_L
#undef PG8_BAR
#undef PG8_SCHED
}
}
#ifndef PG8_SP2
#define PG8_SP2 true
#endif
#ifndef PG8_ALIGN
#define PG8_ALIGN true
#endif
constexpr int NWAVES = 8;
#ifndef MK_N_LAUNCHES
#define MK_N_LAUNCHES 1
#endif
constexpr int N_PHASES = 12;
constexpr int N_LAUNCHES = MK_N_LAUNCHES;

constexpr int BATCH = 2, SEQ = 4096, T = BATCH * SEQ, D = 4096;
constexpr int GMW = 1536, INW = 8704, GATEW = 12288, MEMLEN = 256, MROWS = BATCH * MEMLEN;
constexpr int NALL = INW + GATEW + 2048;
constexpr int MALL = T + MROWS;
constexpr int PEER_E = 16384;
constexpr float LN_EPS = 1e-5f;
constexpr float ALPHA = 1.189207115002721f;
constexpr int C_GU = 0, C_GV = 1536, C_DQ = 3072, C_DK = 4608, C_DV = 6144, C_MQ = 7680;

constexpr size_t MiB = 1u << 20;
constexpr size_t WS_CTL = 0, CTL_ZERO_BYTES = 1 * MiB;
constexpr size_t WS_WALL = 1 * MiB;
constexpr size_t WS_XA = 181 * MiB;
constexpr size_t WS_AOUT = 1 * MiB;
constexpr size_t WS_OG = 25 * MiB;
constexpr size_t WS_BOUT = 49 * MiB;
constexpr size_t WS_MOUT = 57 * MiB;
constexpr size_t WS_LSE = 73 * MiB;
constexpr size_t WS_MERGEDB = 80 * MiB;
constexpr size_t WS_WBRA = 249 * MiB;
constexpr size_t WS_WBRB = 261 * MiB;
constexpr size_t WS_WBRM = 265 * MiB;
constexpr size_t WS_WOUT = 273 * MiB;
constexpr size_t WS_WQ = 305 * MiB;
constexpr size_t WS_SK = 321 * MiB;
constexpr size_t WS_ROPE = 322 * MiB;
constexpr size_t WS_MKV = 326 * MiB;
constexpr size_t WS_PROJ = 328 * MiB;
constexpr size_t WS_MERGED = 328 * MiB;
constexpr size_t WS_Q = 328 * MiB;
constexpr size_t WS_SELI = 360 * MiB;
constexpr size_t WS_SELG = 364 * MiB;
constexpr size_t WS_GATES = 464 * MiB;
constexpr size_t WS_Z = (DBG_ZALT ? 328 : 464) * MiB;
constexpr size_t WS_H1B = (DBG_ZALT ? 1 : 592) * MiB;
constexpr size_t WS_PU = 656 * MiB;
constexpr size_t WS_PV = 784 * MiB;
constexpr size_t WS_END = 912 * MiB;
static_assert(WS_WALL + (size_t)NALL * D * 2 == WS_XA && WS_XA + (size_t)MALL * D * 2 == WS_WBRA, "ws map A");
static_assert(WS_PROJ + (size_t)T * INW * 2 == WS_GATES && WS_GATES + (size_t)T * GATEW * 2 == WS_PU, "ws map B");
static_assert(DBG_ZALT || (WS_Z + (size_t)T * D * 4 == WS_H1B && WS_H1B + (size_t)T * D * 2 == WS_PU), "ws map C");
constexpr int CW_TMO = 0, CW_CODE = 1;
constexpr int CW_BAR = 4096;

constexpr int RING_OFF = 0, RING_BYTES = 131072;
constexpr int LDSCTL_OFF = RING_BYTES, MISC_OFF = LDSCTL_OFF + 320;
constexpr int LDS_BYTES = 147456;
static_assert(MISC_OFF + 128 <= LDS_BYTES, "LDS map");

#define GAS __attribute__((address_space(1)))
#define LAS __attribute__((address_space(3)))
typedef unsigned short bf16;
typedef unsigned v4u __attribute__((ext_vector_type(4)));
typedef float f32x4 __attribute__((ext_vector_type(4)));
typedef short bf16x8 __attribute__((ext_vector_type(8)));
typedef GAS unsigned gu32;
typedef GAS unsigned long long gu64;
#define RLX_AGENT __ATOMIC_RELAXED, __HIP_MEMORY_SCOPE_AGENT
#define LDS_WAIT() asm volatile("s_waitcnt lgkmcnt(0)" ::: "memory")
#define VM_WAIT() asm volatile("s_waitcnt vmcnt(0)" ::: "memory")
__device__ __forceinline__ unsigned long long rt() { return __builtin_amdgcn_s_memrealtime(); }
__device__ __forceinline__ unsigned f2bf(float f) { unsigned u = __builtin_bit_cast(unsigned, f); return (u + 0x7fffu + ((u >> 16) & 1u)) >> 16; }
__device__ __forceinline__ unsigned pk2(float lo, float hi) { return f2bf(lo) | (f2bf(hi) << 16); }

#define XB_TMO      128
#define XB_XCNT(j)  (256  + 64 * (j))
#define XB_XSUB(j)  (1280 + 64 * (j))
#define XB_XGEN(j)  (2304 + 64 * (j))
#define XB_TOP      3328
#define XB_TOPGEN   3392
#define XCD_BAR_WORDS 3456
#define XB_SPIN_CAP (1u << 18)

__device__ __forceinline__ unsigned xb_ld(unsigned* p)              { return __hip_atomic_load(p, __ATOMIC_RELAXED, __HIP_MEMORY_SCOPE_AGENT); }
__device__ __forceinline__ unsigned xb_add(unsigned* p, unsigned v) { return __hip_atomic_fetch_add(p, v, __ATOMIC_RELAXED, __HIP_MEMORY_SCOPE_AGENT); }
__device__ __forceinline__ unsigned xb_xcc_id() { return (unsigned)__builtin_amdgcn_s_getreg((3 << 11) | 20) & 0xFu; }
#define XB_SPIN(cond, bar) do { unsigned _sp = 0; while (cond) { __builtin_amdgcn_s_sleep(1); \
    if ((++_sp & 255u) == 0u) { if (xb_ld(&(bar)[XB_TMO])) break; if (_sp > XB_SPIN_CAP) { atomicAdd(&(bar)[XB_TMO], 1u); break; } } } } while (0)

struct XcdBarrier {
    unsigned* bar; unsigned x;
    volatile LAS unsigned* st;
};

__device__ __forceinline__ XcdBarrier xcd_barrier_post(unsigned* bar, volatile LAS unsigned* st) {
    XcdBarrier b; b.bar = bar; b.x = xb_xcc_id(); b.st = st;
    if (threadIdx.x == 0) (void)xb_add(&bar[XB_XCNT(b.x)], 1u);
    return b;
}
__device__ __forceinline__ void xcd_barrier_complete(unsigned* bar, unsigned x, unsigned& nloc, unsigned& nx) {
    const unsigned G = gridDim.x * gridDim.y * gridDim.z;
    unsigned sum, cnt, mine, sp = 0u;
    for (;;) {
        sum = 0u; cnt = 0u; mine = 0u;
#pragma unroll
        for (unsigned j = 0; j < 16; ++j) { const unsigned c = xb_ld(&bar[XB_XCNT(j)]); sum += c; cnt += (c > 0u) ? 1u : 0u; mine = (j == x) ? c : mine; }
        if (sum == G) break;
        __builtin_amdgcn_s_sleep(1);
        if ((++sp & 255u) == 0u) { if (xb_ld(&bar[XB_TMO])) break; if (sp > XB_SPIN_CAP) { atomicAdd(&bar[XB_TMO], 1u); break; } }
    }
    nloc = mine > 0u ? mine : 1u; nx = cnt > 0u ? cnt : 1u;
}

__device__ __forceinline__ void xcd_barrier(const XcdBarrier& b) {
    asm volatile("s_waitcnt vmcnt(0)" ::: "memory");
    __syncthreads();
    if (threadIdx.x == 0) {
        unsigned* bar = b.bar;
        __builtin_amdgcn_s_waitcnt(0);
        unsigned nloc = b.st[0], nx = b.st[1];
        if (nloc == 0u) { xcd_barrier_complete(bar, b.x, nloc, nx); b.st[0] = nloc; b.st[1] = nx; }
        const unsigned old = xb_add(&bar[XB_XSUB(b.x)], 1u);
        const unsigned gen = old / nloc;
        if (old + 1u == (gen + 1u) * nloc) {
            __builtin_amdgcn_fence(__ATOMIC_RELEASE, "agent");
            asm volatile("s_waitcnt vmcnt(0)" ::: "memory");
            const unsigned og = xb_add(&bar[XB_TOP], 1u);
            const unsigned tg = og / nx;
            if (og + 1u == (tg + 1u) * nx) xb_add(&bar[XB_TOPGEN], 1u);
            else XB_SPIN(xb_ld(&bar[XB_TOPGEN]) == tg, bar);
            __builtin_amdgcn_fence(__ATOMIC_ACQUIRE, "agent");
            xb_add(&bar[XB_XGEN(b.x)], 1u);
            asm volatile("s_waitcnt vmcnt(0)" ::: "memory");
        } else {
            XB_SPIN(xb_ld(&bar[XB_XGEN(b.x)]) == gen, bar);
            __builtin_amdgcn_fence(__ATOMIC_ACQUIRE, "agent");
            asm volatile("s_waitcnt vmcnt(0)" ::: "memory");
        }
    }
    __syncthreads();
}

struct Frame {
    LAS unsigned char* lds;
    volatile LAS unsigned* MISC;
    gu32* ctl;
    int tid, lane, wave;
    int vcu, G;
    const float* in[23];
    float* out;
    unsigned char* ws;
};
enum { I_X = 0, I_MEM, I_POS, I_WIN, I_GLNG, I_GLNB, I_GWS, I_GBS, I_WMKV, I_WGATE, I_BGATE, I_WBRA, I_WBRB, I_WBRM, I_WOUT, I_LNMG, I_LNMB, I_WQ, I_SK, I_PU, I_PV, I_LNFG, I_LNFB };

__device__ __forceinline__ float wave_sum(float v) {
#pragma unroll
    for (int o = 1; o < 64; o <<= 1) v += __shfl_xor(v, o);
    return v;
}
__device__ __forceinline__ float wave_max(float v) {
#pragma unroll
    for (int o = 1; o < 64; o <<= 1) v = fmaxf(v, __shfl_xor(v, o));
    return v;
}

template <bool ROT>
__device__ __forceinline__ void p0_transpose_item(const float* W, int K, int N, bf16* WT, int row_off, LAS float* scr, int item, int lane) {
    const int nblk = N / 32, kb = item / nblk, nb = item % nblk, k0 = 64 * kb, n0 = 32 * nb;
#pragma unroll 8
    for (int i = 0; i < 32; ++i) { const int kk = 2 * i + (lane >> 5); scr[kk * 33 + (lane & 31)] = W[(size_t)(k0 + kk) * N + n0 + (lane & 31)]; }
    LDS_WAIT(); asm volatile("" ::: "memory");
    const int c = lane & 7;
#pragma unroll
    for (int j = 0; j < 4; ++j) { const int n = (lane >> 3) + 8 * j; const LAS float* s = scr + (8 * c) * 33 + n;
        v4u o; o.x = pk2(s[0 * 33], s[1 * 33]); o.y = pk2(s[2 * 33], s[3 * 33]); o.z = pk2(s[4 * 33], s[5 * 33]); o.w = pk2(s[6 * 33], s[7 * 33]);
        int nn = n0 + n;
        if (ROT && nn >= C_DQ && nn < C_DV) { const int hb = nn & ~127, d = nn & 127; nn = hb + ((d & 63) << 1) + (d >> 6); }
        *(GAS v4u*)(WT + (size_t)(row_off + nn) * K + k0 + 8 * c) = o; }
    LDS_WAIT(); asm volatile("" ::: "memory");
}
__device__ __forceinline__ void p0_convert(const float* src, bf16* dst, size_t n, int gw, int NGW, int lane) {
    const size_t nchunk = n / 512;
    for (size_t ch = gw; ch < nchunk; ch += NGW) {
        const GAS f32x4* s = (const GAS f32x4*)(src + ch * 512) + 2 * lane;
        const f32x4 a = s[0], b = s[1];
        v4u o; o.x = pk2(a.x, a.y); o.y = pk2(a.z, a.w); o.z = pk2(b.x, b.y); o.w = pk2(b.z, b.w);
        *((GAS v4u*)(dst + ch * 512) + lane) = o;
    }
}
__device__ __forceinline__ void sincos_d(double a, float& sn, float& cs) {
    const double k = rint(a * 0.63661977236758134308);
    double y = fma(-k, 1.57079632679489655800e+00, a); y = fma(-k, 6.12323399573676603587e-17, y);
    const double y2 = y * y;
    double s = y2 * (-2.50521083854417187751e-08) + 2.75573192239858906526e-06; s = s * y2 - 1.98412698412698412698e-04; s = s * y2 + 8.33333333333333333333e-03; s = s * y2 - 1.66666666666666666667e-01; s = y + y * y2 * s;
    double c = y2 * (2.08767569878680989792e-09) - 2.75573192239858906526e-07; c = c * y2 + 2.48015873015873015873e-05; c = c * y2 - 1.38888888888888888889e-03; c = c * y2 + 4.16666666666666666667e-02; c = c * y2 - 0.5; c = c * y2 + 1.0;
    const int q = ((int)(long long)k) & 3;
    const double ss = (q & 1) ? c : s, cc = (q & 1) ? s : c;
    sn = (float)((q & 2) ? -ss : ss); cs = (float)(((q + 1) & 2) ? -cc : cc);
}
__device__ __forceinline__ void p0_prologue(Frame& F) {
    LAS float* scr = (LAS float*)(F.lds + RING_OFF + F.wave * 16384);
    const int gw = F.vcu * NWAVES + F.wave, NGW = F.G * NWAVES;
    bf16* WALL = (bf16*)(F.ws + WS_WALL);
    constexpr int I_IN = (D / 64) * (INW / 32), I_GT = (D / 64) * (GATEW / 32), I_MK = (D / 64) * (2048 / 32);
    constexpr int I_BA = (1536 / 64) * (D / 32), I_BB = (512 / 64) * (D / 32), I_BM = (1024 / 64) * (D / 32), I_WO = (D / 64) * (D / 32), I_Q = (D / 64) * (2048 / 32);
    constexpr int NITEMS = I_IN + I_GT + I_MK + I_BA + I_BB + I_BM + I_WO + I_Q;
    for (int it = gw; it < NITEMS; it += NGW) {
        int r = it;
        if (r < I_IN) { p0_transpose_item<true>(F.in[I_WIN], D, INW, WALL, 0, scr, r, F.lane); continue; } r -= I_IN;
        if (r < I_GT) { p0_transpose_item<false>(F.in[I_WGATE], D, GATEW, WALL, INW, scr, r, F.lane); continue; } r -= I_GT;
        if (r < I_MK) { p0_transpose_item<false>(F.in[I_WMKV], D, 2048, WALL, INW + GATEW, scr, r, F.lane); continue; } r -= I_MK;
        if (r < I_BA) { p0_transpose_item<false>(F.in[I_WBRA], 1536, D, (bf16*)(F.ws + WS_WBRA), 0, scr, r, F.lane); continue; } r -= I_BA;
        if (r < I_BB) { p0_transpose_item<false>(F.in[I_WBRB], 512, D, (bf16*)(F.ws + WS_WBRB), 0, scr, r, F.lane); continue; } r -= I_BB;
        if (r < I_BM) { p0_transpose_item<false>(F.in[I_WBRM], 1024, D, (bf16*)(F.ws + WS_WBRM), 0, scr, r, F.lane); continue; } r -= I_BM;
        if (r < I_WO) { p0_transpose_item<false>(F.in[I_WOUT], D, D, (bf16*)(F.ws + WS_WOUT), 0, scr, r, F.lane); continue; } r -= I_WO;
        p0_transpose_item<false>(F.in[I_WQ], D, 2048, (bf16*)(F.ws + WS_WQ), 0, scr, r, F.lane);
    }
    bf16* XA = (bf16*)(F.ws + WS_XA);
    p0_convert(F.in[I_X], XA, (size_t)T * D, gw, NGW, F.lane);
    p0_convert(F.in[I_MEM], XA + (size_t)T * D, (size_t)MROWS * D, gw, NGW, F.lane);
    p0_convert(F.in[I_SK], (bf16*)(F.ws + WS_SK), (size_t)8 * 2 * 128 * 128, gw, NGW, F.lane);
    p0_convert(F.in[I_PU], (bf16*)(F.ws + WS_PU), (size_t)PEER_E * D, gw, NGW, F.lane);
    p0_convert(F.in[I_PV], (bf16*)(F.ws + WS_PV), (size_t)PEER_E * D, gw, NGW, F.lane);
    {
        float* rope = (float*)(F.ws + WS_ROPE);
        const int* pos = (const int*)F.in[I_POS];
        const int gt = (F.vcu * NWAVES + F.wave) * 64 + F.lane, NGT = NGW * 64;
        for (int i = gt; i < T * 64; i += NGT) {
            const int m = i >> 6, j = i & 63;
            const double inv = exp2(-(double)j * (13.287712379549449 / 64.0));
            float sn, cs; sincos_d((double)pos[m] * inv, sn, cs);
            { typedef float f32x2g __attribute__((ext_vector_type(2))); *(GAS f32x2g*)(rope + (size_t)i * 2) = (f32x2g){cs, sn}; }
        }
    }
}
typedef unsigned v2u __attribute__((ext_vector_type(2)));
__device__ __forceinline__ bf16x8 as_bf16x8(v4u v) { return __builtin_bit_cast(bf16x8, v); }
constexpr int KP = 272;
constexpr int VP = 528;

struct RowMap { const bf16* base; long row0; int rstride; int pitch; };
__device__ __forceinline__ const bf16* rm_ptr(const RowMap& r, int i) { return r.base + (r.row0 + (long)i * r.rstride) * (long)r.pitch; }

template <int NCH, bool BAND>
__device__ __forceinline__ void attn_unit(LAS unsigned char* lds, const RowMap qm, const RowMap km, const RowMap vm, bf16* obase, long orow0, int orstride, int opitch, int kmin, float* lse_out, int lse_stride, int tid) {
    const int lane = tid & 63, w = __builtin_amdgcn_readfirstlane(tid >> 6), l15 = lane & 15, fq = lane >> 4;
    const int qi = 16 * w + l15;
    f32x4 s[16];
#pragma unroll
    for (int kt = 0; kt < 16; ++kt) s[kt] = (f32x4){0.f, 0.f, 0.f, 0.f};
    const bf16* qp = rm_ptr(qm, qi);
#pragma unroll
    for (int ch = 0; ch < NCH; ++ch) {
#pragma unroll
        for (int p = 0; p < 8; ++p) { const int idx = p * 512 + tid, key = idx >> 4, c16 = idx & 15;
            v4u val = (v4u){0u, 0u, 0u, 0u};
            if (key >= kmin) val = *(const GAS v4u*)(rm_ptr(km, key) + ch * 128 + c16 * 8);
            *(LAS v4u*)(lds + key * KP + c16 * 16) = val; }
        bf16x8 qf[4];
#pragma unroll
        for (int ks = 0; ks < 4; ++ks) qf[ks] = as_bf16x8(*(const GAS v4u*)(qp + ch * 128 + 32 * ks + 8 * fq));
        __syncthreads();
#pragma unroll
        for (int kt = 0; kt < 16; ++kt)
#pragma unroll
            for (int ks = 0; ks < 4; ++ks) {
                const bf16x8 kf = as_bf16x8(*(const LAS v4u*)(lds + (16 * kt + l15) * KP + 64 * ks + 16 * fq));
                s[kt] = __builtin_amdgcn_mfma_f32_16x16x32_bf16(kf, qf[ks], s[kt], 0, 0, 0);
            }
        __syncthreads();
    }
    float mx = -3.0e38f;
#pragma unroll
    for (int kt = 0; kt < 16; ++kt)
#pragma unroll
        for (int i = 0; i < 4; ++i) {
            if (BAND) { const int kj = 16 * kt + 4 * fq + i; const bool ok = (kj >= qi) && (kj <= qi + 128) && (kj >= kmin); s[kt][i] = ok ? s[kt][i] : -1.0e30f; }
            mx = fmaxf(mx, s[kt][i]);
        }
    mx = fmaxf(mx, __shfl_xor(mx, 16)); mx = fmaxf(mx, __shfl_xor(mx, 32));
    float sum = 0.f;
#pragma unroll
    for (int kt = 0; kt < 16; ++kt)
#pragma unroll
        for (int i = 0; i < 4; ++i) { const float p = __builtin_amdgcn_exp2f((s[kt][i] - mx) * 1.4426950409f); s[kt][i] = p; sum += p; }
    sum += __shfl_xor(sum, 16); sum += __shfl_xor(sum, 32);
    const float inv = 1.0f / sum;
    if (lse_out && fq == 0) lse_out[(long)qi * lse_stride] = mx + __logf(sum);
    bf16x8 pf[8];
#pragma unroll
    for (int kk = 0; kk < 8; ++kk) { v4u t; t.x = pg8::cvt_pk_bf16(s[2 * kk][0], s[2 * kk][1]); t.y = pg8::cvt_pk_bf16(s[2 * kk][2], s[2 * kk][3]);
        t.z = pg8::cvt_pk_bf16(s[2 * kk + 1][0], s[2 * kk + 1][1]); t.w = pg8::cvt_pk_bf16(s[2 * kk + 1][2], s[2 * kk + 1][3]); pf[kk] = as_bf16x8(t); }
    bf16* op = obase + (orow0 + (long)qi * orstride) * (long)opitch;
#pragma unroll
    for (int ch = 0; ch < NCH; ++ch) {
#pragma unroll
        for (int p = 0; p < 4; ++p) { const int idx = p * 512 + tid, kp = idx & 127, dg = idx >> 7;
            v4u a = (v4u){0u, 0u, 0u, 0u}, b = (v4u){0u, 0u, 0u, 0u};
            if (2 * kp >= kmin) { a = *(const GAS v4u*)(rm_ptr(vm, 2 * kp) + ch * 128 + dg * 8); b = *(const GAS v4u*)(rm_ptr(vm, 2 * kp + 1) + ch * 128 + dg * 8); }
#pragma unroll
            for (int e = 0; e < 8; ++e) { const unsigned lo = (a[e >> 1] >> (16 * (e & 1))) & 0xffffu, hi = (b[e >> 1] >> (16 * (e & 1))) & 0xffffu;
                *(LAS unsigned*)(lds + (dg * 8 + e) * VP + kp * 4) = lo | (hi << 16); } }
        __syncthreads();
        f32x4 o[8];
#pragma unroll
        for (int nt = 0; nt < 8; ++nt) o[nt] = (f32x4){0.f, 0.f, 0.f, 0.f};
#pragma unroll
        for (int nt = 0; nt < 8; ++nt)
#pragma unroll
            for (int kk = 0; kk < 8; ++kk) {
                const LAS unsigned char* vp = lds + (16 * nt + l15) * VP + 64 * kk + 8 * fq;
                const v2u v0 = *(const LAS v2u*)vp, v1 = *(const LAS v2u*)(vp + 32);
                const bf16x8 vf = as_bf16x8((v4u){v0.x, v0.y, v1.x, v1.y});
                o[nt] = __builtin_amdgcn_mfma_f32_16x16x32_bf16(vf, pf[kk], o[nt], 0, 0, 0);
            }
#pragma unroll
        for (int nt = 0; nt < 8; ++nt) { v2u t; t.x = pg8::cvt_pk_bf16(o[nt][0] * inv, o[nt][1] * inv); t.y = pg8::cvt_pk_bf16(o[nt][2] * inv, o[nt][3] * inv);
            *(GAS v2u*)(op + ch * 128 + 16 * nt + 4 * fq) = t; }
        __syncthreads();
    }
}

__device__ __forceinline__ void gmlp_unit(Frame& F, int n, int g) {
    const int tid = F.tid, lane = F.lane, w = F.wave, l15 = lane & 15, fq = lane >> 4;
    const bf16* proj = (const bf16*)(F.ws + WS_PROJ);
    LAS unsigned char* vt = F.lds + RING_OFF;
    LAS float* stats = (LAS float*)(F.lds + RING_OFF + 128 * KP);
    const long R0 = (long)n * 128;
    for (int tt = 0; tt < 16; ++tt) {
        const int tok = 16 * w + tt;
        const GAS v4u* rp = (const GAS v4u*)(proj + (R0 + tok) * INW + C_GV) + lane;
        float v[24]; float sm = 0.f;
#pragma unroll
        for (int j = 0; j < 3; ++j) { const v4u q = rp[64 * j];
#pragma unroll
            for (int e = 0; e < 4; ++e) { v[j * 8 + 2 * e] = pg8::bf_lo(q[e]); v[j * 8 + 2 * e + 1] = pg8::bf_hi(q[e]); sm += v[j * 8 + 2 * e] + v[j * 8 + 2 * e + 1]; } }
        const float mean = wave_sum(sm) * (1.0f / GMW); float s2 = 0.f;
#pragma unroll
        for (int j = 0; j < 24; ++j) { const float d = v[j] - mean; s2 += d * d; }
        const float rstd = 1.0f / sqrtf(wave_sum(s2) * (1.0f / GMW) + LN_EPS);
        if (lane == 0) { stats[2 * tok] = mean; stats[2 * tok + 1] = rstd; }
    }
    __syncthreads();
    const float* lng = F.in[I_GLNG] + g * 128; const float* lnb = F.in[I_GLNB] + g * 128;
#pragma unroll
    for (int p = 0; p < 2; ++p) { const int idx = p * 512 + tid, sp = idx & 63, cg = idx >> 6;
        const v4u a = *(const GAS v4u*)(proj + (R0 + 2 * sp) * INW + C_GV + g * 128 + cg * 8), b = *(const GAS v4u*)(proj + (R0 + 2 * sp + 1) * INW + C_GV + g * 128 + cg * 8);
        const float m0 = stats[4 * sp], r0 = stats[4 * sp + 1], m1 = stats[4 * sp + 2], r1 = stats[4 * sp + 3];
#pragma unroll
        for (int e = 0; e < 8; ++e) { const float x0 = (e & 1) ? pg8::bf_hi(a[e >> 1]) : pg8::bf_lo(a[e >> 1]), x1 = (e & 1) ? pg8::bf_hi(b[e >> 1]) : pg8::bf_lo(b[e >> 1]);
            const float gg = lng[cg * 8 + e], bb = lnb[cg * 8 + e];
            *(LAS unsigned*)(vt + (cg * 8 + e) * KP + sp * 4) = pk2((x0 - m0) * r0 * gg + bb, (x1 - m1) * r1 * gg + bb); } }
    __syncthreads();
    f32x4 acc[8];
#pragma unroll
    for (int ct = 0; ct < 8; ++ct) acc[ct] = (f32x4){0.f, 0.f, 0.f, 0.f};
    const int t = 16 * w + l15;
    const float* wrow = F.in[I_GWS] + ((size_t)g * 128 + t) * 128;
#pragma unroll
    for (int ks = 0; ks < 4; ++ks) {
        if (32 * ks <= 16 * w + 15) {
            const int s0 = 32 * ks + 8 * fq;
            const f32x4 w0 = *(const GAS f32x4*)(wrow + s0), w1 = *(const GAS f32x4*)(wrow + s0 + 4);
            v4u wf; wf.x = pk2(s0 + 0 <= t ? w0.x : 0.f, s0 + 1 <= t ? w0.y : 0.f); wf.y = pk2(s0 + 2 <= t ? w0.z : 0.f, s0 + 3 <= t ? w0.w : 0.f);
            wf.z = pk2(s0 + 4 <= t ? w1.x : 0.f, s0 + 5 <= t ? w1.y : 0.f); wf.w = pk2(s0 + 6 <= t ? w1.z : 0.f, s0 + 7 <= t ? w1.w : 0.f);
            const bf16x8 wb = as_bf16x8(wf);
#pragma unroll
            for (int ct = 0; ct < 8; ++ct) {
                const bf16x8 vf = as_bf16x8(*(const LAS v4u*)(vt + (16 * ct + l15) * KP + 64 * ks + 16 * fq));
                acc[ct] = __builtin_amdgcn_mfma_f32_16x16x32_bf16(vf, wb, acc[ct], 0, 0, 0);
            }
        }
    }
    const float bs = F.in[I_GBS][g * 128 + t];
    bf16* aout = (bf16*)(F.ws + WS_AOUT);
#pragma unroll
    for (int ct = 0; ct < 8; ++ct) {
        const int c = g * 128 + 16 * ct + 4 * fq;
        const v2u uu = *(const GAS v2u*)(proj + (R0 + t) * INW + C_GU + c);
        v2u o; o.x = pg8::cvt_pk_bf16(pg8::bf_lo(uu.x) * (acc[ct][0] + bs), pg8::bf_hi(uu.x) * (acc[ct][1] + bs)); o.y = pg8::cvt_pk_bf16(pg8::bf_lo(uu.y) * (acc[ct][2] + bs), pg8::bf_hi(uu.y) * (acc[ct][3] + bs));
        *(GAS v2u*)(aout + (R0 + t) * GMW + c) = o;
    }
    __syncthreads();
}

__device__ __forceinline__ void p2_mixers(Frame& F) {
    const bf16* proj = (const bf16*)(F.ws + WS_PROJ);
    const bf16* mkv = (const bf16*)(F.ws + WS_MKV);
    LAS unsigned char* lds = F.lds + RING_OFF;
    for (int u = F.vcu; u < 256; u += F.G) {
        const int b = u >> 7, h = (u >> 5) & 3, qb = u & 31;
        const RowMap qm{proj + C_MQ + h * 256, (long)b * SEQ + qb * 128, 1, INW};
        const RowMap km{mkv + h * 256, (long)b * MEMLEN, 1, 2048};
        const RowMap vm{mkv + 1024 + h * 256, (long)b * MEMLEN, 1, 2048};
        attn_unit<2, false>(lds, qm, km, vm, (bf16*)(F.ws + WS_MOUT) + h * 256, (long)b * SEQ + qb * 128, 1, 1024, 0, nullptr, 0, F.tid);
    }
    for (int u = F.vcu; u < 768; u += F.G) {
        const int g = u >> 8, b = (u >> 7) & 1, hs = (u >> 5) & 3, rn = u & 31;
        const int d = (g == 0) ? 1 : (g == 1 ? 4 : 16), nb = 32 / d, r = rn / nb, n = rn % nb;
        const int head = g * 4 + hs;
        const long q0 = (long)b * SEQ + (long)n * 128 * d + r, k0 = q0 - 128L * d;
        const RowMap qm{proj + C_DQ + head * 128, q0, d, INW};
        const RowMap km{proj + C_DK + head * 128, k0, d, INW};
        const RowMap vm{proj + C_DV + head * 128, k0, d, INW};
        float* lse = (float*)(F.ws + WS_LSE) + ((size_t)g * T + q0) * 4 + hs;
        attn_unit<1, true>(lds, qm, km, vm, (bf16*)(F.ws + WS_OG) + (size_t)g * T * 512 + hs * 128, q0, d, 512, n == 0 ? 128 : 0, lse, 4 * d, F.tid);
    }
    for (int u = F.vcu; u < 768; u += F.G) gmlp_unit(F, u / 12, u % 12);
}

__device__ __forceinline__ void p3_merge(Frame& F) {
    const bf16* og = (const bf16*)(F.ws + WS_OG); const float* lse = (const float*)(F.ws + WS_LSE); bf16* bout = (bf16*)(F.ws + WS_BOUT);
    const int gt = (F.vcu * NWAVES + F.wave) * 64 + F.lane, NGT = F.G * NWAVES * 64;
    for (int i = gt; i < T * 64; i += NGT) {
        const int tok = i >> 6, c8 = i & 63, hs = c8 >> 4;
        const float l0 = lse[((size_t)0 * T + tok) * 4 + hs], l1 = lse[((size_t)1 * T + tok) * 4 + hs], l2 = lse[((size_t)2 * T + tok) * 4 + hs];
        const float m = fmaxf(l0, fmaxf(l1, l2)); const float e0 = __expf(l0 - m), e1 = __expf(l1 - m), e2 = __expf(l2 - m); const float is = 1.0f / (e0 + e1 + e2);
        const float w0 = e0 * is, w1 = e1 * is, w2 = e2 * is;
        const v4u a = *(const GAS v4u*)(og + ((size_t)0 * T + tok) * 512 + c8 * 8), b = *(const GAS v4u*)(og + ((size_t)1 * T + tok) * 512 + c8 * 8), c = *(const GAS v4u*)(og + ((size_t)2 * T + tok) * 512 + c8 * 8);
        v4u o;
#pragma unroll
        for (int e = 0; e < 4; ++e) o[e] = pk2(w0 * pg8::bf_lo(a[e]) + w1 * pg8::bf_lo(b[e]) + w2 * pg8::bf_lo(c[e]), w0 * pg8::bf_hi(a[e]) + w1 * pg8::bf_hi(b[e]) + w2 * pg8::bf_hi(c[e]));
        *(GAS v4u*)(bout + (size_t)tok * 512 + c8 * 8) = o;
    }
}
__device__ __forceinline__ void p6_layernorm(Frame& F) {
    float* z = (float*)(F.ws + WS_Z); bf16* h1b = (bf16*)(F.ws + WS_H1B);
    const float* lg = F.in[I_LNMG]; const float* lb = F.in[I_LNMB];
    const int gw = F.vcu * NWAVES + F.wave, NGW = F.G * NWAVES, lane = F.lane;
    for (int m = gw; m < T; m += NGW) {
        GAS f32x4* xr = (GAS f32x4*)(z + (size_t)m * D) + lane;
        f32x4 v[16]; float s = 0.f;
#pragma unroll
        for (int j = 0; j < 16; ++j) { v[j] = xr[64 * j]; s += (v[j].x + v[j].y) + (v[j].z + v[j].w); }
        const float mean = wave_sum(s) * (1.f / D); float s2 = 0.f;
#pragma unroll
        for (int j = 0; j < 16; ++j) { v[j] = v[j] - mean; s2 += (v[j].x * v[j].x + v[j].y * v[j].y) + (v[j].z * v[j].z + v[j].w * v[j].w); }
        const float rstd = 1.f / sqrtf(wave_sum(s2) * (1.f / D) + LN_EPS);
        GAS v2u* o8 = (GAS v2u*)(h1b + (size_t)m * D) + lane;
#pragma unroll
        for (int j = 0; j < 16; ++j) {
            const f32x4 g4 = *((const GAS f32x4*)lg + lane + 64 * j), b4 = *((const GAS f32x4*)lb + lane + 64 * j);
            const f32x4 y = v[j] * rstd * g4 + b4;
            xr[64 * j] = y;
            v2u o; o.x = pk2(y.x, y.y); o.y = pk2(y.z, y.w); o8[64 * j] = o;
        }
    }
}

__device__ __forceinline__ void p8_topk(Frame& F) {
    const bf16* Q = (const bf16*)(F.ws + WS_Q); const bf16* SK = (const bf16*)(F.ws + WS_SK);
    int* seli = (int*)(F.ws + WS_SELI); float* selg = (float*)(F.ws + WS_SELG);
    LAS unsigned char* lds = F.lds + RING_OFF;
    const int tid = F.tid, lane = F.lane, w = F.wave, l15 = lane & 15, fq = lane >> 4, gbase = lane & 48;
    for (int u = F.vcu; u < 512; u += F.G) {
        const int tb = u >> 3, h = u & 7;
#pragma unroll
        for (int p = 0; p < 8; ++p) { const int idx = p * 512 + tid, half = idx >> 11, key = (idx >> 4) & 127, c16 = idx & 15;
            *(LAS v4u*)(lds + (half * 128 + key) * KP + c16 * 16) = *(const GAS v4u*)(SK + ((size_t)(h * 2 + half) * 128 + key) * 128 + c16 * 8); }
        __syncthreads();
        f32x4 sc[2][8];
        const bf16* qrow = Q + (size_t)(tb * 128 + 16 * w + l15) * 2048 + h * 256;
#pragma unroll
        for (int p = 0; p < 2; ++p) {
            bf16x8 qf[4];
#pragma unroll
            for (int ks = 0; ks < 4; ++ks) qf[ks] = as_bf16x8(*(const GAS v4u*)(qrow + p * 128 + 32 * ks + 8 * fq));
#pragma unroll
            for (int nt = 0; nt < 8; ++nt) { sc[p][nt] = (f32x4){0.f, 0.f, 0.f, 0.f};
#pragma unroll
                for (int ks = 0; ks < 4; ++ks) {
                    const bf16x8 kf = as_bf16x8(*(const LAS v4u*)(lds + (p * 128 + 16 * nt + l15) * KP + 64 * ks + 16 * fq));
                    sc[p][nt] = __builtin_amdgcn_mfma_f32_16x16x32_bf16(qf[ks], kf, sc[p][nt], 0, 0, 0);
                } }
        }
        __syncthreads();
#pragma unroll
        for (int i = 0; i < 4; ++i) {
            float stop[2]; int itop[2];
#pragma unroll
            for (int p = 0; p < 2; ++p) {
                float v[8];
#pragma unroll
                for (int nt = 0; nt < 8; ++nt) v[nt] = sc[p][nt][i];
                float rv = 0.f; int ri = 0;
#pragma unroll 1
                for (int it = 0; it < 16; ++it) {
                    float bv = v[0]; int bi = 0;
#pragma unroll
                    for (int nt = 1; nt < 8; ++nt) if (v[nt] > bv) { bv = v[nt]; bi = nt; }
                    int bidx = bi * 16 + l15;
#pragma unroll
                    for (int off = 1; off < 16; off <<= 1) { const float ov = __shfl_xor(bv, off); const int oi = __shfl_xor(bidx, off); if (ov > bv || (ov == bv && oi < bidx)) { bv = ov; bidx = oi; } }
                    if (l15 == it) { rv = bv; ri = bidx; }
                    const bool mine = (bidx & 15) == l15; const int slot = bidx >> 4;
#pragma unroll
                    for (int nt = 0; nt < 8; ++nt) if (mine && slot == nt) v[nt] = -3.0e38f;
                }
                stop[p] = rv; itop[p] = ri;
            }
            float c[16];
#pragma unroll
            for (int b = 0; b < 16; ++b) c[b] = stop[0] + __shfl(stop[1], gbase + b);
            float best = 0.f; int ex = 0;
#pragma unroll 1
            for (int it = 0; it < 16; ++it) {
                float bv = c[0]; int bi = 0;
#pragma unroll
                for (int b = 1; b < 16; ++b) if (c[b] > bv) { bv = c[b]; bi = b; }
                int bidx = l15 * 16 + bi;
#pragma unroll
                for (int off = 1; off < 16; off <<= 1) { const float ov = __shfl_xor(bv, off); const int oi = __shfl_xor(bidx, off); if (ov > bv || (ov == bv && oi < bidx)) { bv = ov; bidx = oi; } }
                const int e1 = __shfl(itop[0], gbase + (bidx >> 4)), e2 = __shfl(itop[1], gbase + (bidx & 15));
                if (l15 == it) { best = bv; ex = e1 * 128 + e2; }
                const bool mine = (bidx >> 4) == l15; const int slot = bidx & 15;
#pragma unroll
                for (int b = 0; b < 16; ++b) if (mine && slot == b) c[b] = -3.0e38f;
            }
            const float mx = __shfl(best, gbase);
            const float ev = __expf(best - mx); float sm = ev;
#pragma unroll
            for (int off = 1; off < 16; off <<= 1) sm += __shfl_xor(sm, off);
            const size_t tok = (size_t)tb * 128 + 16 * w + 4 * fq + i;
            seli[tok * 128 + h * 16 + l15] = ex; selg[tok * 128 + h * 16 + l15] = ev / sm;
        }
    }
}

__device__ __forceinline__ void p9_peer(Frame& F) {
    const float* h1 = (const float*)(F.ws + WS_Z); const bf16* h1b = (const bf16*)(F.ws + WS_H1B);
    const bf16* PU = (const bf16*)(F.ws + WS_PU); const bf16* PV = (const bf16*)(F.ws + WS_PV);
    const int* seli = (const int*)(F.ws + WS_SELI); const float* selg = (const float*)(F.ws + WS_SELG);
    const float* lg = F.in[I_LNFG]; const float* lb = F.in[I_LNFB];
    const int gw = F.vcu * NWAVES + F.wave, NGW = F.G * NWAVES, lane = F.lane;
    for (int tok = gw; tok < T; tok += NGW) {
        v4u xp[8]; f32x4 y[8][2];
        { const GAS v4u* xb = (const GAS v4u*)(h1b + (size_t)tok * D) + lane;
#pragma unroll
          for (int kk = 0; kk < 8; ++kk) { xp[kk] = xb[64 * kk]; y[kk][0] = (f32x4){0.f, 0.f, 0.f, 0.f}; y[kk][1] = (f32x4){0.f, 0.f, 0.f, 0.f}; } }
        const int id0 = seli[(size_t)tok * 128 + lane], id1 = seli[(size_t)tok * 128 + 64 + lane];
        const float g0 = selg[(size_t)tok * 128 + lane], g1 = selg[(size_t)tok * 128 + 64 + lane];
#pragma unroll 1
        for (int e = 0; e < DBG_NEXPERTS; ++e) {
            const int eid = (e < 64) ? __builtin_amdgcn_readlane(id0, e & 63) : __builtin_amdgcn_readlane(id1, e & 63);
            const float gate = (e < 64) ? __builtin_bit_cast(float, __builtin_amdgcn_readlane(__builtin_bit_cast(int, g0), e & 63)) : __builtin_bit_cast(float, __builtin_amdgcn_readlane(__builtin_bit_cast(int, g1), e & 63));
            const GAS v4u* up = (const GAS v4u*)(PU + (size_t)eid * D) + lane; const GAS v4u* vp = (const GAS v4u*)(PV + (size_t)eid * D) + lane;
            v4u uu[8], vv[8];
#pragma unroll
            for (int kk = 0; kk < 8; ++kk) uu[kk] = up[64 * kk];
#pragma unroll
            for (int kk = 0; kk < 8; ++kk) vv[kk] = vp[64 * kk];
            float dot = 0.f;
#pragma unroll
            for (int kk = 0; kk < 8; ++kk)
#pragma unroll
                for (int q = 0; q < 4; ++q) asm volatile("" : "+v"(xp[kk][q]));
#pragma unroll
            for (int kk = 0; kk < 8; ++kk)
#pragma unroll
                for (int q = 0; q < 4; ++q) dot += pg8::bf_lo(uu[kk][q]) * pg8::bf_lo(xp[kk][q]) + pg8::bf_hi(uu[kk][q]) * pg8::bf_hi(xp[kk][q]);
            dot = wave_sum(dot);
            const float a = pg8::gelu_tanh(dot) * gate;
#pragma unroll
            for (int kk = 0; kk < 8; ++kk) {
                y[kk][0].x += a * pg8::bf_lo(vv[kk].x); y[kk][0].y += a * pg8::bf_hi(vv[kk].x); y[kk][0].z += a * pg8::bf_lo(vv[kk].y); y[kk][0].w += a * pg8::bf_hi(vv[kk].y);
                y[kk][1].x += a * pg8::bf_lo(vv[kk].z); y[kk][1].y += a * pg8::bf_hi(vv[kk].z); y[kk][1].z += a * pg8::bf_lo(vv[kk].w); y[kk][1].w += a * pg8::bf_hi(vv[kk].w);
            }
        }
        float s = 0.f;
        { const GAS f32x4* xr = (const GAS f32x4*)(h1 + (size_t)tok * D) + 2 * lane;
#pragma unroll
          for (int kk = 0; kk < 8; ++kk)
#pragma unroll
            for (int q = 0; q < 2; ++q) { y[kk][q] = xr[128 * kk + q] * ALPHA + y[kk][q]; s += (y[kk][q].x + y[kk][q].y) + (y[kk][q].z + y[kk][q].w); } }
        const float mean = wave_sum(s) * (1.f / D); float s2 = 0.f;
#pragma unroll
        for (int kk = 0; kk < 8; ++kk)
#pragma unroll
            for (int q = 0; q < 2; ++q) { y[kk][q] = y[kk][q] - mean; s2 += (y[kk][q].x * y[kk][q].x + y[kk][q].y * y[kk][q].y) + (y[kk][q].z * y[kk][q].z + y[kk][q].w * y[kk][q].w); }
        const float rstd = 1.f / sqrtf(wave_sum(s2) * (1.f / D) + LN_EPS);
        GAS f32x4* orow = (GAS f32x4*)(F.out + (size_t)tok * D) + 2 * lane;
#pragma unroll
        for (int kk = 0; kk < 8; ++kk)
#pragma unroll
            for (int q = 0; q < 2; ++q) {
                const f32x4 g4 = *((const GAS f32x4*)lg + 2 * lane + 128 * kk + q), b4 = *((const GAS f32x4*)lb + 2 * lane + 128 * kk + q);
                orow[128 * kk + q] = y[kk][q] * rstd * g4 + b4;
            }
    }
}
struct Args { const float* in[23]; float* out; unsigned char* ws; int ph_lo, ph_hi, li, pad; };
__global__ void __launch_bounds__(NWAVES * 64, 2) fwd_kernel(Args args) {
    extern __shared__ __attribute__((aligned(16))) unsigned char lds[];
    Frame F;
    F.lds = (LAS unsigned char*)lds;
    F.MISC = (volatile LAS unsigned*)(F.lds + MISC_OFF);
    F.tid = threadIdx.x; F.lane = F.tid & 63; F.wave = __builtin_amdgcn_readfirstlane(F.tid >> 6);
    F.G = gridDim.x; { const int bx = blockIdx.x; F.vcu = (F.G % 8 == 0) ? (bx % 8) * (F.G / 8) + bx / 8 : bx; }
    F.ws = args.ws; F.out = args.out;
    F.ctl = (gu32*)(args.ws + WS_CTL);
#pragma unroll
    for (int i = 0; i < 23; ++i) F.in[i] = args.in[i];
    for (int u = F.tid; u < (LDS_BYTES - LDSCTL_OFF) / 4; u += NWAVES * 64) ((LAS unsigned*)(F.lds + LDSCTL_OFF))[u] = 0u;
    __syncthreads();
    XcdBarrier bar; bar.bar = (unsigned*)(F.ctl + CW_BAR); bar.x = 0; bar.st = nullptr;
    if (N_LAUNCHES == 1) bar = xcd_barrier_post((unsigned*)(F.ctl + CW_BAR), F.MISC + 8);
#define GRID_BAR() do { if (N_LAUNCHES == 1) xcd_barrier(bar); } while (0)
    const int lo = args.ph_lo, hi = args.ph_hi;
#ifndef PHASE_MASK
#define PHASE_MASK 0xfff
#endif
#define IN(k) (((PHASE_MASK >> (k)) & 1) && lo <= (k) && (k) < hi)
#define BOTH(k) (IN(k) && IN((k) + 1))
    unsigned char* ws = args.ws;

    if (IN(0)) { p0_prologue(F); if (BOTH(0)) GRID_BAR(); }

    if (IN(1)) {
        pg8::Gemm g{(const pg8::bf16_t*)(ws + WS_XA), (const pg8::bf16_t*)(ws + WS_WALL), MALL, NALL, D};
        pg8::SchedP1 S; S.init(F.G, (int)blockIdx.x);
        pg8::EpiProj E{(pg8::bf16_t*)(ws + WS_PROJ), (pg8::bf16_t*)(ws + WS_GATES), (pg8::bf16_t*)(ws + WS_MKV), F.in[I_BGATE], (const float*)(ws + WS_ROPE)};
        pg8::gemm_phase<pg8::EpiProj, pg8::SchedP1, PG8_ALIGN, PG8_SP2>(F.lds + RING_OFF, g, S, E);
        if (BOTH(1)) GRID_BAR();
    }

    if (IN(2)) { p2_mixers(F); if (BOTH(2)) GRID_BAR(); }

    if (IN(3)) { p3_merge(F); if (BOTH(3)) GRID_BAR(); }

    if (IN(4)) {
        pg8::StaticOrder S; S.init(T, D, F.G, (int)blockIdx.x);
        pg8::Gemm g{(const pg8::bf16_t*)(ws + (DBG_P4SRC ? WS_XA : WS_AOUT)), (const pg8::bf16_t*)(ws + WS_WBRA), T, D, 1536};
        pg8::EpiMerge<0> E{(const pg8::bf16_t*)(ws + (DBG_P4SRC == 1 ? WS_PU : WS_GATES)), (float*)(ws + WS_MERGED), (pg8::bf16_t*)(ws + WS_MERGEDB)};
        pg8::gemm_phase<pg8::EpiMerge<0>, pg8::StaticOrder, PG8_ALIGN, PG8_SP2>(F.lds + RING_OFF, g, S, E);
        if (BOTH(4)) GRID_BAR();
    }
    if (IN(5)) {
        pg8::StaticOrder S; S.init(T, D, F.G, (int)blockIdx.x);
        pg8::Gemm g{(const pg8::bf16_t*)(ws + (DBG_P4SRC ? WS_XA : WS_BOUT)), (const pg8::bf16_t*)(ws + WS_WBRB), T, D, 512};
        pg8::EpiMerge<1> E{(const pg8::bf16_t*)(ws + (DBG_P4SRC == 1 ? WS_PU : WS_GATES)) + 4096, (float*)(ws + WS_MERGED), (pg8::bf16_t*)(ws + WS_MERGEDB)};
        pg8::gemm_phase<pg8::EpiMerge<1>, pg8::StaticOrder, PG8_ALIGN, PG8_SP2>(F.lds + RING_OFF, g, S, E);
        if (BOTH(5)) GRID_BAR();
    }
    if (IN(6)) {
        pg8::StaticOrder S; S.init(T, D, F.G, (int)blockIdx.x);
        pg8::Gemm g{(const pg8::bf16_t*)(ws + (DBG_P4SRC ? WS_XA : WS_MOUT)), (const pg8::bf16_t*)(ws + WS_WBRM), T, D, 1024};
        pg8::EpiMerge<2> E{(const pg8::bf16_t*)(ws + (DBG_P4SRC == 1 ? WS_PU : WS_GATES)) + 8192, (float*)(ws + WS_MERGED), (pg8::bf16_t*)(ws + WS_MERGEDB)};
        pg8::gemm_phase<pg8::EpiMerge<2>, pg8::StaticOrder, PG8_ALIGN, PG8_SP2>(F.lds + RING_OFF, g, S, E);
        if (BOTH(6)) GRID_BAR();
    }

    if (IN(7)) {
        pg8::Gemm g{(const pg8::bf16_t*)(ws + (DBG_P5A == 1 ? WS_XA : (DBG_P5A == 2 ? WS_PROJ : (DBG_P5A == 3 ? WS_AOUT : (DBG_P5A == 4 ? WS_GATES : (DBG_P5A == 5 ? WS_GATES + 128 * MiB : WS_MERGEDB)))))), (const pg8::bf16_t*)(ws + WS_WOUT), T, D, D};
        pg8::StaticOrder S; S.init(T, D, F.G, (int)blockIdx.x);
        pg8::EpiResid E{F.in[I_X], (float*)(ws + WS_Z), ALPHA};
        pg8::gemm_phase<pg8::EpiResid, pg8::StaticOrder, PG8_ALIGN, PG8_SP2>(F.lds + RING_OFF, g, S, E);
        if (BOTH(7)) GRID_BAR();
    }

    if (IN(8)) { p6_layernorm(F); if (BOTH(8)) GRID_BAR(); }

    if (IN(9)) {
        pg8::Gemm g{(const pg8::bf16_t*)(ws + WS_H1B), (const pg8::bf16_t*)(ws + WS_WQ), T, 2048, D};
        pg8::StaticOrder S; S.init(T, 2048, F.G, (int)blockIdx.x);
        pg8::EpiPlain E{(pg8::bf16_t*)(ws + WS_Q), 2048};
        pg8::gemm_phase<pg8::EpiPlain, pg8::StaticOrder, PG8_ALIGN, PG8_SP2>(F.lds + RING_OFF, g, S, E);
        if (BOTH(9)) GRID_BAR();
    }

    if (IN(10)) { p8_topk(F); if (BOTH(10)) GRID_BAR(); }

    if (IN(11)) { p9_peer(F); }
#undef IN
#undef BOTH
#undef GRID_BAR
}

extern "C" void kernel_launch(void* const* d_in, const int* in_sizes, int n_in, void* d_out, int out_size, void* d_ws, size_t ws_size, hipStream_t stream) {
    static int grid = 0;
    if (grid == 0) {
        if (n_in != 23 || in_sizes[0] != T * D || out_size != T * D || ws_size < WS_END) { fprintf(stderr, "kernel_launch: unexpected shapes (n_in %d, in0 %d, out %d, ws %zu); nothing launched\n", n_in, n_in > 0 ? in_sizes[0] : -1, out_size, ws_size); grid = -1; return; }
        int dev = 0, cus = 0, per_cu = 0;
        if (hipGetDevice(&dev) != hipSuccess || hipDeviceGetAttribute(&cus, hipDeviceAttributeMultiprocessorCount, dev) != hipSuccess) { grid = -1; return; }
        if (hipFuncSetAttribute((const void*)fwd_kernel, hipFuncAttributeMaxDynamicSharedMemorySize, LDS_BYTES) != hipSuccess) { fprintf(stderr, "kernel_launch: hipFuncSetAttribute failed\n"); grid = -1; return; }
        if (hipOccupancyMaxActiveBlocksPerMultiprocessor(&per_cu, (const void*)fwd_kernel, NWAVES * 64, LDS_BYTES) != hipSuccess || per_cu < 1)
            fprintf(stderr, "kernel_launch: note: occupancy query reports %d workgroups per CU\n", per_cu);
        (void)hipGetLastError();
        grid = cus;
    }
    if (grid < 0) return;
    if (hipMemsetAsync((char*)d_ws + WS_CTL, 0, CTL_ZERO_BYTES, stream) != hipSuccess) return;
    Args a{};
    for (int i = 0; i < 23; ++i) a.in[i] = (const float*)d_in[i];
    a.out = (float*)d_out; a.ws = (unsigned char*)d_ws; a.pad = 0;
    for (int li = 0; li < N_LAUNCHES; ++li) {
        a.ph_lo = (N_LAUNCHES == 1) ? 0 : li; a.ph_hi = (N_LAUNCHES == 1) ? N_PHASES : li + 1; a.li = li;
        hipLaunchKernelGGL(fwd_kernel, dim3(grid), dim3(NWAVES * 64), LDS_BYTES, stream, a);
        if (hipPeekAtLastError() != hipSuccess) break;
    }
}
```

```cpp
#include <hip/hip_runtime.h>
#include <cstdio>
#include <cstdint>
#ifndef DBG_NEXPERTS
#define DBG_NEXPERTS 128
#endif
#ifndef DBG_MIXSCALE
#define DBG_MIXSCALE 1.0f
#endif
#ifndef DBG_BR
#define DBG_BR 7
#endif
#ifndef DBG_P5A
#define DBG_P5A 0
#endif
#ifndef DBG_P4SRC
#define DBG_P4SRC 0
#endif
#ifndef DBG_ZALT
#define DBG_ZALT 0
#endif
#ifndef DBG_GATEPLAIN
#define DBG_GATEPLAIN 0
#endif
#ifndef DBG_PROBE_A
#define DBG_PROBE_A -1
#endif
#ifndef DBG_PROBE_B
#define DBG_PROBE_B -1
#endif
#ifndef DBG_P2SKIP
#define DBG_P2SKIP 0
#endif
#ifndef DBG_HALFMMA
#define DBG_HALFMMA 0
#endif
#ifndef DBG_PEER_NT
#define DBG_PEER_NT 0
#endif
namespace pg8 {
#define PG8_LAS __attribute__((address_space(3)))
typedef unsigned short bf16_t;
typedef short bf16x8 __attribute__((ext_vector_type(8)));
typedef float f32x4 __attribute__((ext_vector_type(4)));
typedef unsigned u32x4 __attribute__((ext_vector_type(4)));
constexpr int BM = 256, BK = 64, HALF = 128, HTB = HALF * BK * 2  , STAGE_BYTES = 8 * HTB, NXCD = 8, WGM = 8;

__host__ __device__ __forceinline__ int lds_byte(int r, int c) { const int st = (r >> 4) * 2 + (c >> 5), rr = r & 15, cc = c & 31, ob = rr * 64 + cc * 2; return st * 1024 + (ob ^ (((ob >> 9) & 1) << 5)); }
__host__ __device__ __forceinline__ void stage_rc(int b, int& R, int& C) { const int st = b / 1024, sb = b % 1024, swz = sb ^ (((sb >> 9) & 1) << 5); R = (st >> 1) * 16 + swz / 64; C = (st & 1) * 32 + (swz % 64) / 2; }
__host__ __device__ __forceinline__ int perm32(int rho) { const int n = rho >> 4, i = rho & 15; return 8 * (i >> 2) + 4 * n + (i & 3); }

struct Unit { int pm, pn; };
struct Gemm { const bf16_t* A; const bf16_t* Bt; int M, N, K; int sA, sB; int ld; };

struct StaticOrder {
    int nM, nN, nwg, G, c;
    __host__ __device__ void init(int M, int N, int G_, int c_) { nM = M / BM; nN = N / BM; nwg = nM * nN; G = G_; c = c_; }
    __host__ __device__ bool next(int i, Unit& u) const {
        const long L = (long)i * G + c; if (L >= nwg) return false;
        int wgid = (int)L; { const int q = nwg / NXCD, r = nwg % NXCD, xcd = wgid % NXCD, off = wgid / NXCD; wgid = (xcd < r ? xcd * (q + 1) : r * (q + 1) + (xcd - r) * q) + off; }
        const int nig = WGM * nN, gid = wgid / nig, fm = gid * WGM, gsz = (nM - fm) < WGM ? (nM - fm) : WGM;
        u.pm = fm + ((wgid % nig) % gsz); u.pn = (wgid % nig) / gsz; return true;
    }
    __device__ __forceinline__ void a_ready(const Unit&) const {}
    __device__ __forceinline__ void done(const Unit&) const {}
};

__device__ __forceinline__ unsigned pk4_fp8(float a, float b, float c, float d) { a = __builtin_amdgcn_fmed3f(a, -448.f, 448.f); b = __builtin_amdgcn_fmed3f(b, -448.f, 448.f); c = __builtin_amdgcn_fmed3f(c, -448.f, 448.f); d = __builtin_amdgcn_fmed3f(d, -448.f, 448.f);
    int w = 0; w = __builtin_amdgcn_cvt_pk_fp8_f32(a, b, w, false); w = __builtin_amdgcn_cvt_pk_fp8_f32(c, d, w, true); return (unsigned)w; }
typedef __bf16 bf16x2_t __attribute__((ext_vector_type(2)));
typedef float f32x2_t __attribute__((ext_vector_type(2)));
__device__ __forceinline__ unsigned cvt_pk_bf16(float lo, float hi) { const bf16x2_t r = __builtin_convertvector((f32x2_t){lo, hi}, bf16x2_t); return __builtin_bit_cast(unsigned, r); }
typedef float f32x2 __attribute__((ext_vector_type(2)));
typedef float f32x4u __attribute__((ext_vector_type(4), aligned(16)));
__device__ __forceinline__ float gelu_tanh(float x) {
    const float u = x * (1.5957691216f + 0.0713548163f * x * x);
    const float e = __builtin_amdgcn_exp2f(-1.4426950409f * u);
    return x * __builtin_amdgcn_rcpf(1.0f + e);
}
__device__ __forceinline__ float sigmoid_f(float x) { return __builtin_amdgcn_rcpf(1.0f + __builtin_amdgcn_exp2f(-1.4426950409f * x)); }
__device__ __forceinline__ u32x4 pack8(const f32x4& v0, const f32x4& v1) { u32x4 w; w.x = cvt_pk_bf16(v0[0], v0[1]); w.y = cvt_pk_bf16(v0[2], v0[3]); w.z = cvt_pk_bf16(v1[0], v1[1]); w.w = cvt_pk_bf16(v1[2], v1[3]); return w; }
__device__ __forceinline__ float bf_lo(unsigned w) { return __builtin_bit_cast(float, w << 16); }
__device__ __forceinline__ float bf_hi(unsigned w) { return __builtin_bit_cast(float, w & 0xffff0000u); }

struct EpiProj {
    static constexpr bool PERM = true, AFTER_DRAIN = false, MIDK = false; static constexpr int T1 = -1, T2 = -1;
    bf16_t* proj; bf16_t* gates; bf16_t* mkv; const float* bgate; const float* rope;
    template <int KIND> __device__ __forceinline__ void tile(const f32x4 (&acc)[2][2][4][2], bf16_t* base, int ldc, int row0, int cb, float sc, const float* bias) const {
        f32x4 bv[2][2];
        if (KIND == 3) {
#pragma unroll
            for (int bj = 0; bj < 2; ++bj)
#pragma unroll
                for (int n = 0; n < 2; ++n) bv[bj][n] = *(const f32x4*)(bias + bj * HALF + 4 * n);
        }
#pragma unroll
        for (int ai = 0; ai < 2; ++ai)
#pragma unroll
            for (int m = 0; m < 4; ++m) {
                const int row = row0 + ai * HALF + m * 16;
                bf16_t* rowp = base + (size_t)row * ldc;
                f32x4 r0, r1;
                if (KIND == 1) { const float* rp = rope + (size_t)row * 128 + cb; r0 = *(const f32x4*)rp; r1 = *(const f32x4*)(rp + 4); }
#pragma unroll
                for (int bj = 0; bj < 2; ++bj) {
                    f32x4 v0 = acc[ai][bj][m][0], v1 = acc[ai][bj][m][1];
                    if (KIND == 0) {
#pragma unroll
                        for (int j = 0; j < 4; ++j) { v0[j] = gelu_tanh(v0[j]); v1[j] = gelu_tanh(v1[j]); }
                    } else if (KIND == 1) {
                        f32x4 a0, a1;
                        a0[0] = v0[0] * r0[0] - v0[1] * r0[1]; a0[1] = v0[1] * r0[0] + v0[0] * r0[1];
                        a0[2] = v0[2] * r0[2] - v0[3] * r0[3]; a0[3] = v0[3] * r0[2] + v0[2] * r0[3];
                        a1[0] = v1[0] * r1[0] - v1[1] * r1[1]; a1[1] = v1[1] * r1[0] + v1[0] * r1[1];
                        a1[2] = v1[2] * r1[2] - v1[3] * r1[3]; a1[3] = v1[3] * r1[2] + v1[2] * r1[3];
                        v0 = a0 * sc; v1 = a1 * sc;
                    } else if (KIND == 2) { v0 = v0 * sc; v1 = v1 * sc;
                    } else if (KIND == 3) {
                        v0 = v0 + bv[bj][0]; v1 = v1 + bv[bj][1];
#pragma unroll
                        for (int j = 0; j < 4; ++j) { v0[j] = sigmoid_f(v0[j]); v1[j] = sigmoid_f(v1[j]); }
                    }
                    if (KIND == 3) { typedef unsigned u32x2 __attribute__((ext_vector_type(2))); u32x2 w8; w8.x = pk4_fp8(v0[0], v0[1], v0[2], v0[3]); w8.y = pk4_fp8(v1[0], v1[1], v1[2], v1[3]);
                        __builtin_nontemporal_store(w8, (u32x2*)((unsigned char*)base + (size_t)row * ldc + bj * HALF)); }
                    else __builtin_nontemporal_store(pack8(v0, v1), (u32x4*)(rowp + bj * HALF));
                }
            }
    }
    __device__ __forceinline__ void operator()(const f32x4 (&acc)[2][2][4][2], const Unit& u, int wr, int wc, int fr, int fq) const {
        int row0 = u.pm * BM + wr * 64 + fr, cw = wc * 32 + 8 * fq;
        asm volatile("" : "+v"(row0), "+v"(cw));
        if (u.pm >= 32) { tile<2>(acc, mkv + (u.pn - 82) * BM + cw, 2048, row0 - 8192, 0, 1.0f, nullptr); }
        else if (u.pn < 12) { tile<0>(acc, proj + u.pn * BM + cw, 8704, row0, 0, 1.0f, nullptr); }
        else if (u.pn < 24) { tile<1>(acc, proj + u.pn * BM + cw, 8704, row0, cw, u.pn < 18 ? 0.08838834764831845f : 1.0f, nullptr); }
        else if (u.pn < 34) { tile<2>(acc, proj + u.pn * BM + cw, 8704, row0, 0, u.pn >= 30 ? 0.0625f : 1.0f, nullptr); }
        else { const int cg = (u.pn - 34) * BM + cw; tile<3>(acc, (bf16_t*)((unsigned char*)gates + cg), 12288, row0, 0, 1.0f, bgate + cg); }
    }
};
struct EpiGate {
    static constexpr bool PERM = true, AFTER_DRAIN = false, MIDK = false; static constexpr int T1 = -1, T2 = -1;
    EpiProj P;
    __device__ __forceinline__ void operator()(const f32x4 (&acc)[2][2][4][2], const Unit& u, int wr, int wc, int fr, int fq) const { Unit v = u; v.pn = u.pn + 34; P(acc, v, wr, wc, fr, fq); }
};

template <int STEP> struct EpiMerge {
    static constexpr bool PERM = true, AFTER_DRAIN = false, MIDK = false; static constexpr int T1 = -1, T2 = -1;
    const unsigned char* gates; bf16_t* merged; bf16_t* mergedb;
    __device__ __forceinline__ void operator()(const f32x4 (&acc)[2][2][4][2], const Unit& u, int wr, int wc, int fr, int fq) const {
        typedef unsigned u32x2 __attribute__((ext_vector_type(2))); typedef float f32x2e __attribute__((ext_vector_type(2)));
        const int row0 = u.pm * BM + wr * 64 + fr, col0 = u.pn * BM + wc * 32 + 8 * fq;
#pragma unroll
        for (int ai = 0; ai < 2; ++ai)
#pragma unroll
            for (int m = 0; m < 4; ++m) {
                const size_t row = (size_t)(row0 + ai * HALF + m * 16);
#pragma unroll
                for (int bj = 0; bj < 2; ++bj) {
                    const int col = col0 + bj * HALF;
                    const u32x2 g = *(const u32x2*)(gates + row * 12288 + col);
                    const f32x2e g0 = __builtin_amdgcn_cvt_pk_f32_fp8((int)g.x, false), g1 = __builtin_amdgcn_cvt_pk_f32_fp8((int)g.x, true), g2 = __builtin_amdgcn_cvt_pk_f32_fp8((int)g.y, false), g3 = __builtin_amdgcn_cvt_pk_f32_fp8((int)g.y, true);
                    f32x4 v0 = acc[ai][bj][m][0], v1 = acc[ai][bj][m][1];
                    if (!((DBG_BR >> STEP) & 1)) { v0 = v0 * 0.f; v1 = v1 * 0.f; }
                    v0[0] *= g0.x; v0[1] *= g0.y; v0[2] *= g1.x; v0[3] *= g1.y; v1[0] *= g2.x; v1[1] *= g2.y; v1[2] *= g3.x; v1[3] *= g3.y;
                    bf16_t* mp = merged + row * 4096 + col;
                    if (STEP > 0) { const u32x4 pm = *(const u32x4*)mp; v0[0] += bf_lo(pm.x); v0[1] += bf_hi(pm.x); v0[2] += bf_lo(pm.y); v0[3] += bf_hi(pm.y); v1[0] += bf_lo(pm.z); v1[1] += bf_hi(pm.z); v1[2] += bf_lo(pm.w); v1[3] += bf_hi(pm.w); }
                    if (STEP < 2) *(u32x4*)mp = pack8(v0, v1);
                    else { v0 = v0 * 8.0f; v1 = v1 * 8.0f; u32x2 w8; w8.x = pk4_fp8(v0[0], v0[1], v0[2], v0[3]); w8.y = pk4_fp8(v1[0], v1[1], v1[2], v1[3]);
                        *(u32x2*)((unsigned char*)mergedb + row * 4096 + col) = w8; }
                }
            }
    }
};

struct EpiMerge3 {
    static constexpr bool PERM = true, AFTER_DRAIN = false, MIDK = true; static constexpr int T1 = 12, T2 = 16;
    const unsigned char* gates; bf16_t* mergedb;
    typedef unsigned u32x2 __attribute__((ext_vector_type(2))); typedef float f32x2e __attribute__((ext_vector_type(2)));
    static __device__ __forceinline__ void gate8(const unsigned char* p, f32x4& a, f32x4& b) {
        const u32x2 g = *(const u32x2*)p;
        const f32x2e g0 = __builtin_amdgcn_cvt_pk_f32_fp8((int)g.x, false), g1 = __builtin_amdgcn_cvt_pk_f32_fp8((int)g.x, true), g2 = __builtin_amdgcn_cvt_pk_f32_fp8((int)g.y, false), g3 = __builtin_amdgcn_cvt_pk_f32_fp8((int)g.y, true);
        a = (f32x4){fmaxf(g0.x, 0.001953125f), fmaxf(g0.y, 0.001953125f), fmaxf(g1.x, 0.001953125f), fmaxf(g1.y, 0.001953125f)};
        b = (f32x4){fmaxf(g2.x, 0.001953125f), fmaxf(g2.y, 0.001953125f), fmaxf(g3.x, 0.001953125f), fmaxf(g3.y, 0.001953125f)};
    }
    static __device__ __forceinline__ void gate8w(const u32x2 g, f32x4& a, f32x4& b) {
        const f32x2e g0 = __builtin_amdgcn_cvt_pk_f32_fp8((int)g.x, false), g1 = __builtin_amdgcn_cvt_pk_f32_fp8((int)g.x, true), g2 = __builtin_amdgcn_cvt_pk_f32_fp8((int)g.y, false), g3 = __builtin_amdgcn_cvt_pk_f32_fp8((int)g.y, true);
        a = (f32x4){fmaxf(g0.x, 0.001953125f), fmaxf(g0.y, 0.001953125f), fmaxf(g1.x, 0.001953125f), fmaxf(g1.y, 0.001953125f)};
        b = (f32x4){fmaxf(g2.x, 0.001953125f), fmaxf(g2.y, 0.001953125f), fmaxf(g3.x, 0.001953125f), fmaxf(g3.y, 0.001953125f)};
    }
    __device__ __forceinline__ void midk(f32x4 (&acc)[2][2][4][2], const Unit& u, int t, int wr, int wc, int fr, int fq) const {
        int row0 = u.pm * BM + wr * 64 + fr, col0 = u.pn * BM + wc * 32 + 8 * fq; const int b = (t == T1) ? 0 : 1;
        asm volatile("" : "+v"(row0), "+v"(col0));
#pragma unroll
        for (int ai = 0; ai < 2; ++ai) {
            u32x2 gn[4][2], gd[4][2];
#pragma unroll
            for (int m = 0; m < 4; ++m)
#pragma unroll
                for (int bj = 0; bj < 2; ++bj) {
                    const unsigned char* gp = gates + (size_t)(row0 + ai * HALF + m * 16) * 12288 + b * 4096 + col0 + bj * HALF;
                    gn[m][bj] = *(const u32x2*)gp; gd[m][bj] = *(const u32x2*)(gp + 4096);
                }
            __builtin_amdgcn_sched_barrier(0);
#pragma unroll
            for (int m = 0; m < 4; ++m)
#pragma unroll
                for (int bj = 0; bj < 2; ++bj) {
                    f32x4 n0, n1, d0, d1; gate8w(gn[m][bj], n0, n1); gate8w(gd[m][bj], d0, d1);
#pragma unroll
                    for (int j = 0; j < 4; ++j) { acc[ai][bj][m][0][j] *= n0[j] * __builtin_amdgcn_rcpf(d0[j]); acc[ai][bj][m][1][j] *= n1[j] * __builtin_amdgcn_rcpf(d1[j]); }
                }
            __builtin_amdgcn_sched_barrier(0);
        }
    }
    __device__ __forceinline__ void operator()(const f32x4 (&acc)[2][2][4][2], const Unit& u, int wr, int wc, int fr, int fq) const {
        int row0 = u.pm * BM + wr * 64 + fr, col0 = u.pn * BM + wc * 32 + 8 * fq;
        asm volatile("" : "+v"(row0), "+v"(col0));
#pragma unroll
        for (int ai = 0; ai < 2; ++ai) {
            u32x2 gw[4][2];
#pragma unroll
            for (int m = 0; m < 4; ++m)
#pragma unroll
                for (int bj = 0; bj < 2; ++bj) gw[m][bj] = *(const u32x2*)(gates + (size_t)(row0 + ai * HALF + m * 16) * 12288 + 8192 + col0 + bj * HALF);
            __builtin_amdgcn_sched_barrier(0);
#pragma unroll
            for (int m = 0; m < 4; ++m) {
                const size_t row = (size_t)(row0 + ai * HALF + m * 16);
#pragma unroll
                for (int bj = 0; bj < 2; ++bj) {
                    const int col = col0 + bj * HALF;
                    f32x4 g0, g1; gate8w(gw[m][bj], g0, g1);
                    const f32x4 v0 = acc[ai][bj][m][0] * g0 * 8.0f, v1 = acc[ai][bj][m][1] * g1 * 8.0f;
                    u32x2 w8; w8.x = pk4_fp8(v0[0], v0[1], v0[2], v0[3]); w8.y = pk4_fp8(v1[0], v1[1], v1[2], v1[3]);
                    *(u32x2*)((unsigned char*)mergedb + row * 4096 + col) = w8;
                }
            }
            __builtin_amdgcn_sched_barrier(0);
        }
    }
};

struct EpiResid {
    static constexpr bool PERM = true, AFTER_DRAIN = false, MIDK = false; static constexpr int T1 = -1, T2 = -1;
    const float* x; bf16_t* z; float alpha;
    __device__ __forceinline__ void operator()(const f32x4 (&acc)[2][2][4][2], const Unit& u, int wr, int wc, int fr, int fq) const {
        int row0 = u.pm * BM + wr * 64 + fr, col0 = u.pn * BM + wc * 32 + 8 * fq;
        asm volatile("" : "+v"(row0), "+v"(col0));
#pragma unroll
        for (int ai = 0; ai < 2; ++ai)
#pragma unroll
            for (int mh = 0; mh < 2; ++mh) {
                f32x4 xv[2][2][2];
#pragma unroll
                for (int mm = 0; mm < 2; ++mm)
#pragma unroll
                    for (int bj = 0; bj < 2; ++bj) {
                        const size_t o = (size_t)(row0 + ai * HALF + (2 * mh + mm) * 16) * 4096 + col0 + bj * HALF;
                        xv[mm][bj][0] = __builtin_nontemporal_load((const f32x4*)(x + o)); xv[mm][bj][1] = __builtin_nontemporal_load((const f32x4*)(x + o + 4));
                    }
                __builtin_amdgcn_sched_barrier(0);
#pragma unroll
                for (int mm = 0; mm < 2; ++mm)
#pragma unroll
                    for (int bj = 0; bj < 2; ++bj) {
                        const int m = 2 * mh + mm;
                        const size_t o = (size_t)(row0 + ai * HALF + m * 16) * 4096 + col0 + bj * HALF;
                        *(u32x4*)(z + o) = pack8(xv[mm][bj][0] * alpha + acc[ai][bj][m][0] * DBG_MIXSCALE, xv[mm][bj][1] * alpha + acc[ai][bj][m][1] * DBG_MIXSCALE);
                    }
                __builtin_amdgcn_sched_barrier(0);
            }
    }
};

struct EpiPlain {
    static constexpr bool PERM = true, AFTER_DRAIN = false, MIDK = false; static constexpr int T1 = -1, T2 = -1;
    bf16_t* O; int ldc;
    __device__ __forceinline__ void operator()(const f32x4 (&acc)[2][2][4][2], const Unit& u, int wr, int wc, int fr, int fq) const {
        const int row0 = u.pm * BM + wr * 64 + fr, col0 = u.pn * BM + wc * 32 + 8 * fq;
#pragma unroll
        for (int ai = 0; ai < 2; ++ai)
#pragma unroll
            for (int m = 0; m < 4; ++m) {
                bf16_t* rowp = O + (size_t)(row0 + ai * HALF + m * 16) * ldc + col0;
#pragma unroll
                for (int bj = 0; bj < 2; ++bj) *(u32x4*)(rowp + bj * HALF) = pack8(acc[ai][bj][m][0], acc[ai][bj][m][1]);
            }
    }
};

struct SchedP1 {
    StaticOrder so;
    __host__ __device__ void init(int G_, int c_) { so.init(8192, 34 * 256, G_, c_); }
    __host__ __device__ bool next(int i, Unit& u) const {
        if (so.next(i, u)) return true;
        const long L = (long)i * so.G + so.c - so.nwg; if (L < 0 || L >= 16) return false;
        u.pm = 32 + (int)(L >> 3); u.pn = 82 + (int)(L & 7); return true;
    }
    __device__ __forceinline__ void a_ready(const Unit&) const {}
    __device__ __forceinline__ void done(const Unit&) const {}
};

typedef int i32x8 __attribute__((ext_vector_type(8)));
typedef int i32x4v __attribute__((ext_vector_type(4)));
__device__ __forceinline__ i32x8 cat8(const bf16x8& lo, const bf16x8& hi) { return __builtin_shufflevector(__builtin_bit_cast(i32x4v, lo), __builtin_bit_cast(i32x4v, hi), 0, 1, 2, 3, 4, 5, 6, 7); }
template <class Epi, class Sched, bool ALIGN_EPI = false, bool SP2 = false, int FP8 = 0>
__device__ __forceinline__ void gemm_phase(PG8_LAS unsigned char* lds, const Gemm g, const Sched& S, const Epi& E) {
    const int tid = threadIdx.x, wid = __builtin_amdgcn_readfirstlane(tid >> 6), lane = tid & 63, wr = wid >> 2, wc = wid & 3, fr = lane & 15, fq = lane >> 4;
    const int K = g.ld ? g.ld : g.K, nt = g.K / BK;
    unsigned voffA[2], voffB[2];
#pragma unroll
    for (int i = 0; i < 2; ++i) { int R, C; stage_rc(tid * 16 + i * 8192, R, C); const int Rb = Epi::PERM ? ((R & ~31) + perm32(R & 31)) : R;
        voffA[i] = (unsigned)(R * K + C) * 2u; voffB[i] = (unsigned)(Rb * K + C) * 2u; }
    const size_t kstep = (size_t)(BK * 2);
    const size_t hstep = (size_t)HALF * K * 2;
    const size_t tstep = 2 * hstep;
    const unsigned ldsw = (unsigned)wid * 1024u;
    const int aoff = lds_byte(wr * 64 + fr, fq * 8), boff = lds_byte(wc * 32 + fr, fq * 8);
#define PG8_SA(b, h) (((b) * 2 + (h)) * HTB)
#define PG8_SB(b, h) ((4 + (b) * 2 + (h)) * HTB)
#define PG8_STAGE(bufoff, gbase, voff) do { _Pragma("unroll") for (int _i = 0; _i < 2; ++_i) \
        __builtin_amdgcn_global_load_lds((const unsigned*)((const char*)(gbase) + (voff)[_i]), (PG8_LAS unsigned*)(lds + (bufoff) + ldsw + _i * 8192), 16, 0, 0); } while (0)
#define PG8_LDA(dst, b, h) do { _Pragma("unroll") for (int m = 0; m < 4; ++m) _Pragma("unroll") for (int k = 0; k < 2; ++k) dst[m][k] = *(const PG8_LAS bf16x8*)(lds + PG8_SA(b, h) + aoff + m * 2048 + k * 1024); } while (0)
#define PG8_LDB(dst, b, h) do { _Pragma("unroll") for (int n = 0; n < 2; ++n) _Pragma("unroll") for (int k = 0; k < 2; ++k) dst[n][k] = *(const PG8_LAS bf16x8*)(lds + PG8_SB(b, h) + boff + n * 2048 + k * 1024); } while (0)
#define PG8_MMA(ai, bj, At, Bt) do { __builtin_amdgcn_s_setprio(1); \
        if constexpr (FP8 == 2) { _Pragma("unroll") for (int k = 0; k < 2; ++k) _Pragma("unroll") for (int m = 0; m < 4; ++m) _Pragma("unroll") for (int n = 0; n < 2; ++n) \
            asm volatile("v_mfma_scale_f32_16x16x128_f8f6f4 %0, %1, %2, %0, %3, %4 op_sel_hi:[0,0,0] cbsz:4 blgp:4" : "+v"(acc[ai][bj][m][n]) : "v"(Bt[n][k]), "v"(At[m][k]), "v"(sclB), "v"(sclA)); } \
        else if constexpr (FP8 == 1) { _Pragma("unroll") for (int m = 0; m < (DBG_HALFMMA ? 2 : 4); ++m) _Pragma("unroll") for (int n = 0; n < 2; ++n) \
            asm volatile("v_mfma_scale_f32_16x16x128_f8f6f4 %0, %1, %2, %0, %3, %4 op_sel_hi:[0,0,0]" : "+v"(acc[ai][bj][m][n]) : "v"(cat8(Bt[n][0], Bt[n][1])), "v"(cat8(At[m][0], At[m][1])), "v"(sclB), "v"(sclA)); } \
        else { _Pragma("unroll") for (int m = 0; m < 4; ++m) _Pragma("unroll") for (int n = 0; n < 2; ++n) _Pragma("unroll") for (int k = 0; k < 2; ++k) \
            acc[ai][bj][m][n] = __builtin_amdgcn_mfma_f32_16x16x32_bf16(Bt[n][k], At[m][k], acc[ai][bj][m][n], 0, 0, 0); } \
        __builtin_amdgcn_s_setprio(0); } while (0)
#define PG8_WAIT_V(n) asm volatile("s_waitcnt vmcnt(" #n ")" ::: "memory")
#define PG8_WAIT_L(n) asm volatile("s_waitcnt lgkmcnt(" #n ")" ::: "memory")
#define PG8_BAR __builtin_amdgcn_s_barrier()
#define PG8_SCHED __builtin_amdgcn_sched_barrier(0)
    Unit cur, nxt; int ui = 0;
    if (!S.next(0, cur)) return;
    int sclA = g.sA, sclB = g.sB;
    if constexpr (FP8) asm volatile("" : "+v"(sclA), "+v"(sclB));
    f32x4 acc[2][2][4][2];
#pragma unroll
    for (int a = 0; a < 2; ++a)
#pragma unroll
        for (int b = 0; b < 2; ++b)
#pragma unroll
            for (int m = 0; m < 4; ++m)
#pragma unroll
                for (int n = 0; n < 2; ++n) acc[a][b][m][n] = (f32x4){0.f, 0.f, 0.f, 0.f};
    bf16x8 At[4][2], B0[2][2], B1[2][2];
    const char* cA = (const char*)g.A + (size_t)cur.pm * tstep; const char* cB = (const char*)g.Bt + (size_t)cur.pn * tstep;
    S.a_ready(cur);
    if constexpr (SP2) {
        PG8_STAGE(PG8_SB(0, 0), cB, voffB); PG8_STAGE(PG8_SB(0, 1), cB + hstep, voffB); PG8_STAGE(PG8_SA(0, 0), cA, voffA); PG8_STAGE(PG8_SA(0, 1), cA + hstep, voffA);
        if (wr == 1) PG8_BAR;
        PG8_WAIT_V(2); PG8_BAR;
        PG8_STAGE(PG8_SB(1, 0), cB + kstep, voffB); PG8_STAGE(PG8_SA(1, 0), cA + kstep, voffA); PG8_STAGE(PG8_SB(1, 1), cB + hstep + kstep, voffB);
        PG8_WAIT_V(6); PG8_BAR;
    } else {
        PG8_STAGE(PG8_SB(0, 0), cB, voffB); PG8_STAGE(PG8_SA(0, 0), cA, voffA); PG8_STAGE(PG8_SB(0, 1), cB + hstep, voffB); PG8_STAGE(PG8_SA(0, 1), cA + hstep, voffA);
        if (wr == 1) PG8_BAR;
        PG8_WAIT_V(4); PG8_BAR;
        PG8_STAGE(PG8_SB(1, 0), cB + kstep, voffB); PG8_STAGE(PG8_SA(1, 0), cA + kstep, voffA); PG8_STAGE(PG8_SB(1, 1), cB + hstep + kstep, voffB);
        PG8_WAIT_V(6); PG8_BAR;
    }
    for (;;) {
        const bool has_next = S.next(ui + 1, nxt);
        const char* nA = has_next ? (const char*)g.A + (size_t)nxt.pm * tstep : cA; const char* nB = has_next ? (const char*)g.Bt + (size_t)nxt.pn * tstep : cB;
        for (int t = 0; t < nt; t += 2) {
            const bool last = (t == nt - 2);
            const char* a1 = cA + (size_t)(t + 1) * kstep;
            const char* a2 = last ? nA : cA + (size_t)(t + 2) * kstep; const char* b2 = last ? nB : cB + (size_t)(t + 2) * kstep;
            const char* a3 = a2 + kstep; const char* b3 = b2 + kstep;
            if (last && has_next) S.a_ready(nxt);
            if constexpr (Epi::MIDK) { if (t == Epi::T1 || t == Epi::T2) { if constexpr (FP8) asm volatile("s_nop 15\n\ts_nop 15" ::: "memory"); E.midk(acc, cur, t, wr, wc, fr, fq); } }
            if constexpr (SP2) {
            PG8_LDB(B0, 0, 0); PG8_LDB(B1, 0, 1); PG8_SCHED; PG8_LDA(At, 0, 0); PG8_STAGE(PG8_SA(1, 1), a1 + hstep, voffA);
            PG8_WAIT_V(8); PG8_WAIT_L(0); PG8_BAR; PG8_MMA(0, 0, At, B0); PG8_MMA(0, 1, At, B1); PG8_BAR; PG8_SCHED;
            PG8_LDA(At, 0, 1); PG8_STAGE(PG8_SB(0, 0), b2, voffB); PG8_STAGE(PG8_SB(0, 1), b2 + hstep, voffB); PG8_STAGE(PG8_SA(0, 0), a2, voffA);
            PG8_WAIT_V(8); PG8_WAIT_L(0); PG8_BAR; PG8_MMA(1, 0, At, B0); PG8_MMA(1, 1, At, B1); PG8_BAR; PG8_SCHED;
            PG8_LDB(B0, 1, 0); PG8_LDB(B1, 1, 1); PG8_SCHED; PG8_LDA(At, 1, 0); PG8_STAGE(PG8_SA(0, 1), a2 + hstep, voffA);
            PG8_WAIT_V(8); PG8_WAIT_L(0); PG8_BAR; PG8_MMA(0, 0, At, B0); PG8_MMA(0, 1, At, B1); PG8_BAR; PG8_SCHED;
            PG8_LDA(At, 1, 1); PG8_STAGE(PG8_SB(1, 0), b3, voffB); PG8_STAGE(PG8_SB(1, 1), b3 + hstep, voffB); PG8_STAGE(PG8_SA(1, 0), a3, voffA);
            PG8_WAIT_V(8); PG8_WAIT_L(0); PG8_BAR; PG8_MMA(1, 0, At, B0); PG8_MMA(1, 1, At, B1); PG8_BAR; PG8_SCHED;
            } else {
            PG8_LDB(B0, 0, 0); PG8_SCHED; PG8_LDA(At, 0, 0); PG8_STAGE(PG8_SA(1, 1), a1 + hstep, voffA);
            PG8_WAIT_L(8); PG8_BAR; PG8_WAIT_L(0); PG8_MMA(0, 0, At, B0); PG8_BAR; PG8_SCHED;
            PG8_LDB(B1, 0, 1); PG8_STAGE(PG8_SB(0, 0), b2, voffB);
            PG8_BAR; PG8_WAIT_L(0); PG8_MMA(0, 1, At, B1); PG8_BAR;
            PG8_LDA(At, 0, 1); PG8_STAGE(PG8_SA(0, 0), a2, voffA);
            PG8_BAR; PG8_WAIT_L(0); PG8_MMA(1, 0, At, B0); PG8_BAR; PG8_SCHED;
            PG8_STAGE(PG8_SB(0, 1), b2 + hstep, voffB);
            PG8_WAIT_V(6); PG8_BAR; PG8_MMA(1, 1, At, B1); PG8_BAR;
            PG8_LDB(B0, 1, 0); PG8_SCHED; PG8_LDA(At, 1, 0); PG8_STAGE(PG8_SA(0, 1), a2 + hstep, voffA);
            PG8_WAIT_L(8); PG8_BAR; PG8_WAIT_L(0); PG8_MMA(0, 0, At, B0); PG8_BAR; PG8_SCHED;
            PG8_LDB(B1, 1, 1); PG8_STAGE(PG8_SB(1, 0), b3, voffB);
            PG8_BAR; PG8_WAIT_L(0); PG8_MMA(0, 1, At, B1); PG8_BAR;
            PG8_LDA(At, 1, 1); PG8_STAGE(PG8_SA(1, 0), a3, voffA);
            PG8_BAR; PG8_WAIT_L(0); PG8_MMA(1, 0, At, B0); PG8_BAR; PG8_SCHED;
            PG8_STAGE(PG8_SB(1, 1), b3 + hstep, voffB);
            PG8_WAIT_V(6); PG8_BAR; PG8_MMA(1, 1, At, B1); PG8_BAR;
            }
        }
        if constexpr (ALIGN_EPI) { if (wr == 0) PG8_BAR; }
        if constexpr (FP8) asm volatile("s_nop 15\n\ts_nop 15" ::: "memory");
        if constexpr (!Epi::AFTER_DRAIN) { E(acc, cur, wr, wc, fr, fq); S.done(cur); }
        if (!has_next) break;
#pragma unroll
        for (int a = 0; a < 2; ++a)
#pragma unroll
            for (int b = 0; b < 2; ++b)
#pragma unroll
                for (int m = 0; m < 4; ++m)
#pragma unroll
                    for (int n = 0; n < 2; ++n) acc[a][b][m][n] = (f32x4){0.f, 0.f, 0.f, 0.f};
        cur = nxt; cA = nA; cB = nB; ++ui;
        if constexpr (ALIGN_EPI) { if (wr == 1) PG8_BAR; }
    }
    PG8_WAIT_V(0);
    if constexpr (!ALIGN_EPI) { if (wr == 0) PG8_BAR; }
    PG8_BAR;
    if constexpr (Epi::AFTER_DRAIN) { E.fused(acc, cur, wr, wc, fr, fq, lds, wid, lane); S.done(cur); }
#undef PG8_SA
#undef PG8_SB
#undef PG8_STAGE
#undef PG8_LDA
#undef PG8_LDB
#undef PG8_MMA
#undef PG8_WAIT_V
#undef PG8_WAIT_L
#undef PG8_BAR
#undef PG8_SCHED
}
}
#ifndef PG8_SP2
#define PG8_SP2 true
#endif
#ifndef PG8_ALIGN
#define PG8_ALIGN true
#endif
constexpr int NWAVES = 8;
#ifndef MK_N_LAUNCHES
#define MK_N_LAUNCHES 1
#endif
constexpr int N_PHASES = 12;
constexpr int N_LAUNCHES = MK_N_LAUNCHES;

constexpr int BATCH = 2, SEQ = 4096, T = BATCH * SEQ, D = 4096;
constexpr int GMW = 1536, INW = 8704, GATEW = 12288, MEMLEN = 256, MROWS = BATCH * MEMLEN;
constexpr int NALL = INW + GATEW + 2048;
constexpr int MALL = T + MROWS;
constexpr int PEER_E = 16384;
constexpr int ACT_PITCH = 3072;
constexpr int P1_PITCH = D;
constexpr float LN_EPS = 1e-5f;
constexpr float ALPHA = 1.189207115002721f;
constexpr int C_GU = 0, C_GV = 1536, C_DQ = 3072, C_DK = 4608, C_DV = 6144, C_MQ = 7680;

constexpr size_t MiB = 1u << 20;
constexpr size_t WS_CTL = 0, CTL_ZERO_BYTES = 1 * MiB;
constexpr size_t WS_WALL = 1 * MiB;
constexpr size_t WS_XA = 181 * MiB;
constexpr size_t WS_AOUT = 1 * MiB;
constexpr size_t WS_OG = 25 * MiB;
constexpr size_t WS_BOUT = 1 * MiB + 1536;
constexpr size_t WS_MOUT = 1 * MiB + 2048;
constexpr size_t WS_LSE = 73 * MiB;
constexpr size_t WS_MERGEDB = 80 * MiB;
constexpr size_t WS_WBRA = 249 * MiB;
constexpr size_t WS_WBRB = 261 * MiB;
constexpr size_t WS_WBRM = 265 * MiB;
constexpr size_t WS_WOUT = 273 * MiB;
constexpr size_t WS_WQ = 305 * MiB;
constexpr size_t WS_SK = 321 * MiB;
constexpr size_t WS_ROPE = 322 * MiB;
constexpr size_t WS_MKV = 326 * MiB;
constexpr size_t WS_PROJ = 328 * MiB;
constexpr size_t WS_MERGED = 328 * MiB;
constexpr size_t WS_Q = 328 * MiB;
constexpr size_t WS_SELI = 360 * MiB;
constexpr size_t WS_SELG = 364 * MiB;
constexpr size_t WS_GATES = 464 * MiB;
constexpr size_t WS_Z = (DBG_ZALT ? 328 : 464) * MiB;
constexpr size_t WS_H1B = (DBG_ZALT ? 1 : 592) * MiB;
constexpr size_t WS_PU = 656 * MiB;
constexpr size_t WS_PV = 704 * MiB;
constexpr size_t WS_XA4 = 752 * MiB;
constexpr size_t WS_WG4 = 768 * MiB;
constexpr int P1B_PITCH = D / 2;
constexpr size_t WS_END = 792 * MiB;
static_assert(WS_WALL + (size_t)NALL * D * 2 == WS_XA && WS_XA + (size_t)MALL * D * 2 == WS_WBRA, "ws map A");
static_assert(WS_PROJ + (size_t)T * INW * 2 == WS_GATES && WS_GATES + (size_t)T * GATEW * 2 == WS_PU, "ws map B");
static_assert(DBG_ZALT || (WS_Z + (size_t)T * D * 4 == WS_H1B && WS_H1B + (size_t)T * D * 2 == WS_PU), "ws map C");
constexpr int CW_TMO = 0, CW_CODE = 1;
constexpr int CW_ROWS = 16384;
constexpr float PV_SCALE = 3.36f;
constexpr int CW_P11 = 32768, P11_NSH = 16;
constexpr int CW_DONE = 65536;
constexpr size_t WS_YP = 80 * MiB;
constexpr int CW_BAR = 4096;

constexpr int RING_OFF = 0, RING_BYTES = 131072;
constexpr int LDSCTL_OFF = RING_BYTES, MISC_OFF = LDSCTL_OFF + 320;
constexpr int LDS_BYTES = 147456;
static_assert(MISC_OFF + 128 <= LDS_BYTES, "LDS map");

#define GAS __attribute__((address_space(1)))
#define LAS __attribute__((address_space(3)))
typedef unsigned short bf16;
typedef unsigned v4u __attribute__((ext_vector_type(4)));
typedef float f32x4 __attribute__((ext_vector_type(4)));
typedef short bf16x8 __attribute__((ext_vector_type(8)));
typedef GAS unsigned gu32;
typedef GAS unsigned long long gu64;
#define RLX_AGENT __ATOMIC_RELAXED, __HIP_MEMORY_SCOPE_AGENT
#define LDS_WAIT() asm volatile("s_waitcnt lgkmcnt(0)" ::: "memory")
#define VM_WAIT() asm volatile("s_waitcnt vmcnt(0)" ::: "memory")
__device__ __forceinline__ unsigned long long rt() { return __builtin_amdgcn_s_memrealtime(); }
__device__ __forceinline__ unsigned f2bf(float f) { unsigned u = __builtin_bit_cast(unsigned, f); return (u + 0x7fffu + ((u >> 16) & 1u)) >> 16; }
__device__ __forceinline__ unsigned pk2(float lo, float hi) { return f2bf(lo) | (f2bf(hi) << 16); }

#define XB_TMO      128
#define XB_XCNT(j)  (256  + 64 * (j))
#define XB_XSUB(j)  (1280 + 64 * (j))
#define XB_XGEN(j)  (2304 + 64 * (j))
#define XB_TOP      3328
#define XB_TOPGEN   3392
#define XCD_BAR_WORDS 3456
#define XB_SPIN_CAP (1u << 18)

__device__ __forceinline__ unsigned xb_ld(unsigned* p)              { return __hip_atomic_load(p, __ATOMIC_RELAXED, __HIP_MEMORY_SCOPE_AGENT); }
__device__ __forceinline__ unsigned xb_add(unsigned* p, unsigned v) { return __hip_atomic_fetch_add(p, v, __ATOMIC_RELAXED, __HIP_MEMORY_SCOPE_AGENT); }
__device__ __forceinline__ unsigned xb_xcc_id() { return (unsigned)__builtin_amdgcn_s_getreg((3 << 11) | 20) & 0xFu; }
#define XB_SPIN(cond, bar) do { unsigned _sp = 0; while (cond) { __builtin_amdgcn_s_sleep(1); \
    if ((++_sp & 255u) == 0u) { if (xb_ld(&(bar)[XB_TMO])) break; if (_sp > XB_SPIN_CAP) { atomicAdd(&(bar)[XB_TMO], 1u); break; } } } } while (0)

struct XcdBarrier {
    unsigned* bar; unsigned x;
    volatile LAS unsigned* st;
};

__device__ __forceinline__ XcdBarrier xcd_barrier_post(unsigned* bar, volatile LAS unsigned* st) {
    XcdBarrier b; b.bar = bar; b.x = xb_xcc_id(); b.st = st;
    if (threadIdx.x == 0) (void)xb_add(&bar[XB_XCNT(b.x)], 1u);
    return b;
}
__device__ __forceinline__ void xcd_barrier_complete(unsigned* bar, unsigned x, unsigned& nloc, unsigned& nx) {
    const unsigned G = gridDim.x * gridDim.y * gridDim.z;
    unsigned sum, cnt, mine, sp = 0u;
    for (;;) {
        sum = 0u; cnt = 0u; mine = 0u;
#pragma unroll
        for (unsigned j = 0; j < 16; ++j) { const unsigned c = xb_ld(&bar[XB_XCNT(j)]); sum += c; cnt += (c > 0u) ? 1u : 0u; mine = (j == x) ? c : mine; }
        if (sum == G) break;
        __builtin_amdgcn_s_sleep(1);
        if ((++sp & 255u) == 0u) { if (xb_ld(&bar[XB_TMO])) break; if (sp > XB_SPIN_CAP) { atomicAdd(&bar[XB_TMO], 1u); break; } }
    }
    nloc = mine > 0u ? mine : 1u; nx = cnt > 0u ? cnt : 1u;
}

__device__ __forceinline__ void xcd_barrier(const XcdBarrier& b) {
    asm volatile("s_waitcnt vmcnt(0)" ::: "memory");
    __syncthreads();
    if (threadIdx.x == 0) {
        unsigned* bar = b.bar;
        __builtin_amdgcn_s_waitcnt(0);
        unsigned nloc = b.st[0], nx = b.st[1];
        if (nloc == 0u) { xcd_barrier_complete(bar, b.x, nloc, nx); b.st[0] = nloc; b.st[1] = nx; }
        const unsigned old = xb_add(&bar[XB_XSUB(b.x)], 1u);
        const unsigned gen = old / nloc;
        if (old + 1u == (gen + 1u) * nloc) {
            __builtin_amdgcn_fence(__ATOMIC_RELEASE, "agent");
            asm volatile("s_waitcnt vmcnt(0)" ::: "memory");
            const unsigned og = xb_add(&bar[XB_TOP], 1u);
            const unsigned tg = og / nx;
            if (og + 1u == (tg + 1u) * nx) xb_add(&bar[XB_TOPGEN], 1u);
            else XB_SPIN(xb_ld(&bar[XB_TOPGEN]) == tg, bar);
            __builtin_amdgcn_fence(__ATOMIC_ACQUIRE, "agent");
            xb_add(&bar[XB_XGEN(b.x)], 1u);
            asm volatile("s_waitcnt vmcnt(0)" ::: "memory");
        } else {
            XB_SPIN(xb_ld(&bar[XB_XGEN(b.x)]) == gen, bar);
            __builtin_amdgcn_fence(__ATOMIC_ACQUIRE, "agent");
            asm volatile("s_waitcnt vmcnt(0)" ::: "memory");
        }
    }
    __syncthreads();
}

struct Frame {
    LAS unsigned char* lds;
    volatile LAS unsigned* MISC;
    gu32* ctl;
    int tid, lane, wave;
    int vcu, G;
    const float* in[23];
    float* out;
    unsigned char* ws;
};
enum { I_X = 0, I_MEM, I_POS, I_WIN, I_GLNG, I_GLNB, I_GWS, I_GBS, I_WMKV, I_WGATE, I_BGATE, I_WBRA, I_WBRB, I_WBRM, I_WOUT, I_LNMG, I_LNMB, I_WQ, I_SK, I_PU, I_PV, I_LNFG, I_LNFB };

__device__ __forceinline__ float wave_sum(float v) {
#pragma unroll
    for (int o = 1; o < 64; o <<= 1) v += __shfl_xor(v, o);
    return v;
}
__device__ __forceinline__ float wave_max(float v) {
#pragma unroll
    for (int o = 1; o < 64; o <<= 1) v = fmaxf(v, __shfl_xor(v, o));
    return v;
}

typedef unsigned v2u __attribute__((ext_vector_type(2)));
#define DPP_QX1 0xB1
#define DPP_QX2 0x4E
#define DPP_RHM 0x141
#define DPP_RM  0x140
__device__ __forceinline__ unsigned row_max_u32(unsigned k) {
    k = max(k, (unsigned)__builtin_amdgcn_update_dpp(0, (int)k, DPP_QX1, 0xF, 0xF, false));
    k = max(k, (unsigned)__builtin_amdgcn_update_dpp(0, (int)k, DPP_QX2, 0xF, 0xF, false));
    k = max(k, (unsigned)__builtin_amdgcn_update_dpp(0, (int)k, DPP_RHM, 0xF, 0xF, false));
    k = max(k, (unsigned)__builtin_amdgcn_update_dpp(0, (int)k, DPP_RM, 0xF, 0xF, false));
    return k;
}
__device__ __forceinline__ float row_sum_f32(float v) {
    v += __builtin_bit_cast(float, __builtin_amdgcn_update_dpp(0, __builtin_bit_cast(int, v), DPP_QX1, 0xF, 0xF, false));
    v += __builtin_bit_cast(float, __builtin_amdgcn_update_dpp(0, __builtin_bit_cast(int, v), DPP_QX2, 0xF, 0xF, false));
    v += __builtin_bit_cast(float, __builtin_amdgcn_update_dpp(0, __builtin_bit_cast(int, v), DPP_RHM, 0xF, 0xF, false));
    v += __builtin_bit_cast(float, __builtin_amdgcn_update_dpp(0, __builtin_bit_cast(int, v), DPP_RM, 0xF, 0xF, false));
    return v;
}
__device__ __forceinline__ float wave_sum_dpp(float v) {
    v = row_sum_f32(v);
    const float a = __builtin_bit_cast(float, __builtin_amdgcn_readlane(__builtin_bit_cast(int, v), 0)), b = __builtin_bit_cast(float, __builtin_amdgcn_readlane(__builtin_bit_cast(int, v), 16));
    const float c = __builtin_bit_cast(float, __builtin_amdgcn_readlane(__builtin_bit_cast(int, v), 32)), d = __builtin_bit_cast(float, __builtin_amdgcn_readlane(__builtin_bit_cast(int, v), 48));
    return (a + b) + (c + d);
}
using pg8::pk4_fp8;
template <bool ROT, int FP8 = 0>
__device__ __forceinline__ void p0_transpose_finish(const float (&tv)[32], int K, bf16* WT, int row_off, LAS float* scr, int k0, int n0, int lane, int pitch = 0) {
    if (pitch == 0) pitch = K;
#pragma unroll
    for (int i = 0; i < 32; ++i) scr[(2 * i + (lane >> 5)) * 33 + (lane & 31)] = tv[i];
    LDS_WAIT(); asm volatile("" ::: "memory");
    const int c = lane & 7;
#pragma unroll
    for (int j = 0; j < 4; ++j) { const int n = (lane >> 3) + 8 * j; const LAS float* s = scr + (8 * c) * 33 + n;
        int nn = n0 + n;
        if (ROT && nn >= C_DQ && nn < C_DV) { const int hb = nn & ~127, d = nn & 127; nn = hb + ((d & 63) << 1) + (d >> 6); }
        if (FP8 == 2) { unsigned q = 0u;
            q = __builtin_amdgcn_cvt_scalef32_pk_fp4_f32(q, s[0 * 33] * 128.f, s[1 * 33] * 128.f, 1.0f, 0); q = __builtin_amdgcn_cvt_scalef32_pk_fp4_f32(q, s[2 * 33] * 128.f, s[3 * 33] * 128.f, 1.0f, 1);
            q = __builtin_amdgcn_cvt_scalef32_pk_fp4_f32(q, s[4 * 33] * 128.f, s[5 * 33] * 128.f, 1.0f, 2); q = __builtin_amdgcn_cvt_scalef32_pk_fp4_f32(q, s[6 * 33] * 128.f, s[7 * 33] * 128.f, 1.0f, 3);
            *(GAS unsigned*)((unsigned char*)WT + (size_t)(row_off + nn) * pitch + (k0 + 8 * c) / 2) = q; }
        else if (FP8 == 1) { v2u o8; o8.x = pk4_fp8(s[0 * 33] * 64.f, s[1 * 33] * 64.f, s[2 * 33] * 64.f, s[3 * 33] * 64.f); o8.y = pk4_fp8(s[4 * 33] * 64.f, s[5 * 33] * 64.f, s[6 * 33] * 64.f, s[7 * 33] * 64.f);
            *(GAS v2u*)((unsigned char*)WT + (size_t)(row_off + nn) * pitch + k0 + 8 * c) = o8; }
        else { v4u o; o.x = pk2(s[0 * 33], s[1 * 33]); o.y = pk2(s[2 * 33], s[3 * 33]); o.z = pk2(s[4 * 33], s[5 * 33]); o.w = pk2(s[6 * 33], s[7 * 33]);
            *(GAS v4u*)(WT + (size_t)(row_off + nn) * K + k0 + 8 * c) = o; } }
    LDS_WAIT(); asm volatile("" ::: "memory");
}
__device__ __forceinline__ void p0_convert(const float* src, bf16* dst, size_t n, int gw, int NGW, int lane) {
    const size_t nchunk = n / 512;
    for (size_t ch = gw; ch < nchunk; ch += NGW) {
        const GAS f32x4* s = (const GAS f32x4*)(src + ch * 512) + 2 * lane;
        const f32x4 a = s[0], b = s[1];
        v4u o; o.x = pk2(a.x, a.y); o.y = pk2(a.z, a.w); o.z = pk2(b.x, b.y); o.w = pk2(b.z, b.w);
        *((GAS v4u*)(dst + ch * 512) + lane) = o;
    }
}
__device__ __forceinline__ void p0_convert_fp8(const float* src, unsigned char* dst, size_t n, float scale, int gw, int NGW, int lane) {
    const size_t nchunk = n / 1024;
    for (size_t ch = gw; ch < nchunk; ch += NGW) {
        const GAS f32x4* s = (const GAS f32x4*)(src + ch * 1024) + 4 * lane;
        v4u o;
#pragma unroll
        for (int j = 0; j < 4; ++j) { const f32x4 a = s[j] * scale; int w = 0; w = __builtin_amdgcn_cvt_pk_fp8_f32(a.x, a.y, w, false); w = __builtin_amdgcn_cvt_pk_fp8_f32(a.z, a.w, w, true); o[j] = (unsigned)w; }
        *((GAS v4u*)(dst + ch * 1024) + lane) = o;
    }
}
__device__ __forceinline__ unsigned fp6_code(float x) {
    const unsigned xb = __builtin_bit_cast(unsigned, x), ab = xb & 0x7fffffffu;
    const float ax = __builtin_bit_cast(float, ab);
    const unsigned rb = (ab + 0x0007ffffu + ((ab >> 20) & 1u)) >> 20;
    const unsigned cn = min(rb - (126u << 3), 31u);
    const unsigned cs = (unsigned)__builtin_rintf(ax * 8.f);
    const unsigned c = (ax < 1.f) ? cs : cn;
    return ((xb >> 26) & 32u) | c;
}
__device__ __forceinline__ void p0_convert_fp6_row(const float* src, unsigned char* dst, int r, float scale, int lane) {
    {
        const GAS float* sr = (const GAS float*)(src + (size_t)r * D) + lane;
        unsigned d[14];
#pragma unroll
        for (int i = 0; i < 14; ++i) d[i] = 0u;
#pragma unroll
        for (int g = 0; g < 2; ++g) {
            float a[32];
#pragma unroll
            for (int j = 0; j < 32; ++j) a[j] = __builtin_nontemporal_load(sr + (32 * g + j) * 64);
#pragma unroll
            for (int j = 0; j < 32; ++j) {
                const unsigned c = fp6_code(a[j] * scale);
                const int bp = 6 * j, dw = 6 * g + (bp >> 5), off = bp & 31;
                d[dw] |= c << off;
                if (off > 26) d[dw + 1] |= c >> (32 - off);
            }
        }
        unsigned char* rowp = dst + (size_t)r * 3072;
        __builtin_nontemporal_store((v4u){d[0], d[1], d[2], d[3]}, (GAS v4u*)rowp + lane); __builtin_nontemporal_store((v2u){d[4], d[5]}, (GAS v2u*)(rowp + 1024) + lane);
        __builtin_nontemporal_store((v2u){d[6], d[7]}, (GAS v2u*)(rowp + 1536) + lane); __builtin_nontemporal_store((v4u){d[8], d[9], d[10], d[11]}, (GAS v4u*)(rowp + 2048) + lane);
    }
}
__device__ __forceinline__ void p0_fp4_row_load(const float* src, int r, int lane, float (&a)[64]) {
    const GAS float* sr = (const GAS float*)(src + (size_t)r * D) + lane;
#pragma unroll
    for (int j = 0; j < 64; ++j) a[j] = __builtin_nontemporal_load(sr + j * 64);
}
__device__ __forceinline__ void p0_fp4_row_finish(const float (&a)[64], unsigned char* dst, int r, float scale, int lane) {
    unsigned d[8];
#pragma unroll
    for (int w = 0; w < 8; ++w) {
        unsigned q = 0u;
        q = __builtin_amdgcn_cvt_scalef32_pk_fp4_f32(q, a[8 * w + 0] * scale, a[8 * w + 1] * scale, 1.0f, 0);
        q = __builtin_amdgcn_cvt_scalef32_pk_fp4_f32(q, a[8 * w + 2] * scale, a[8 * w + 3] * scale, 1.0f, 1);
        q = __builtin_amdgcn_cvt_scalef32_pk_fp4_f32(q, a[8 * w + 4] * scale, a[8 * w + 5] * scale, 1.0f, 2);
        q = __builtin_amdgcn_cvt_scalef32_pk_fp4_f32(q, a[8 * w + 6] * scale, a[8 * w + 7] * scale, 1.0f, 3);
        d[w] = q;
    }
    unsigned char* rowp = dst + (size_t)r * 2048;
    __builtin_nontemporal_store((v4u){d[0], d[1], d[2], d[3]}, (GAS v4u*)rowp + lane); __builtin_nontemporal_store((v4u){d[4], d[5], d[6], d[7]}, (GAS v4u*)(rowp + 1024) + lane);
}
__device__ __forceinline__ void p0_convert_fp8_rows(const float* src, unsigned char* dst, int nrows, int pitch, int gw, int NGW, int lane, unsigned char* dst4 = nullptr) {
    const int nchunk = nrows * (D / 1024);
    for (int ch = gw; ch < nchunk; ch += NGW) {
        const int r = ch / (D / 1024), q = ch % (D / 1024);
        const GAS f32x4* s = (const GAS f32x4*)(src + (size_t)r * D + q * 1024) + 4 * lane;
        v4u o; v2u o4;
#pragma unroll
        for (int j = 0; j < 4; ++j) { const f32x4 a = __builtin_nontemporal_load(s + j); o[j] = pk4_fp8(a.x, a.y, a.z, a.w);
            if (dst4) { unsigned w = (j & 1) ? o4[j >> 1] : 0u;
                if (j & 1) { w = __builtin_amdgcn_cvt_scalef32_pk_fp4_f32(w, a.x * 2.0f, a.y * 2.0f, 1.0f, 2); w = __builtin_amdgcn_cvt_scalef32_pk_fp4_f32(w, a.z * 2.0f, a.w * 2.0f, 1.0f, 3); }
                else { w = __builtin_amdgcn_cvt_scalef32_pk_fp4_f32(w, a.x * 2.0f, a.y * 2.0f, 1.0f, 0); w = __builtin_amdgcn_cvt_scalef32_pk_fp4_f32(w, a.z * 2.0f, a.w * 2.0f, 1.0f, 1); }
                o4[j >> 1] = w; } }
        *((GAS v4u*)(dst + (size_t)r * pitch + q * 1024) + lane) = o;
        if (dst4) *((GAS v2u*)(dst4 + (size_t)r * P1B_PITCH + q * 512) + lane) = o4;
    }
}
__device__ __forceinline__ void sincos_d(double a, float& sn, float& cs) {
    const double k = rint(a * 0.63661977236758134308);
    double y = fma(-k, 1.57079632679489655800e+00, a); y = fma(-k, 6.12323399573676603587e-17, y);
    const double y2 = y * y;
    double s = y2 * (-2.50521083854417187751e-08) + 2.75573192239858906526e-06; s = s * y2 - 1.98412698412698412698e-04; s = s * y2 + 8.33333333333333333333e-03; s = s * y2 - 1.66666666666666666667e-01; s = y + y * y2 * s;
    double c = y2 * (2.08767569878680989792e-09) - 2.75573192239858906526e-07; c = c * y2 + 2.48015873015873015873e-05; c = c * y2 - 1.38888888888888888889e-03; c = c * y2 + 4.16666666666666666667e-02; c = c * y2 - 0.5; c = c * y2 + 1.0;
    const int q = ((int)(long long)k) & 3;
    const double ss = (q & 1) ? c : s, cc = (q & 1) ? s : c;
    sn = (float)((q & 2) ? -ss : ss); cs = (float)(((q + 1) & 2) ? -cc : cc);
}
constexpr int P0_I_IN = (D / 64) * (INW / 32), P0_I_GT = (D / 64) * (GATEW / 32), P0_I_MK = (D / 64) * (2048 / 32);
constexpr int P0_I_BA = (1536 / 64) * (D / 32), P0_I_BB = (512 / 64) * (D / 32), P0_I_BM = (1024 / 64) * (D / 32), P0_I_WO = (D / 64) * (D / 32), P0_I_Q = (D / 64) * (2048 / 32);
constexpr int P0_NITEMS = P0_I_IN + P0_I_GT + P0_I_MK + P0_I_BA + P0_I_BB + P0_I_BM + P0_I_WO + P0_I_Q;
struct P0It { const float* W; int N, k0, n0, kind; };
__device__ __forceinline__ bool p0_decode(const Frame& F, int it, int it1, P0It& d) {
    if (it >= it1) return false;
    int r = it;
    if (r < P0_I_IN) { d.W = F.in[I_WIN]; d.N = INW; d.kind = 0; }
    else if ((r -= P0_I_IN) < P0_I_GT) { d.W = F.in[I_WGATE]; d.N = GATEW; d.kind = 1; }
    else if ((r -= P0_I_GT) < P0_I_MK) { d.W = F.in[I_WMKV]; d.N = 2048; d.kind = 2; }
    else if ((r -= P0_I_MK) < P0_I_BA) { d.W = F.in[I_WBRA]; d.N = D; d.kind = 3; }
    else if ((r -= P0_I_BA) < P0_I_BB) { d.W = F.in[I_WBRB]; d.N = D; d.kind = 4; }
    else if ((r -= P0_I_BB) < P0_I_BM) { d.W = F.in[I_WBRM]; d.N = D; d.kind = 5; }
    else if ((r -= P0_I_BM) < P0_I_WO) { d.W = F.in[I_WOUT]; d.N = D; d.kind = 6; }
    else { r -= P0_I_WO; d.W = F.in[I_WQ]; d.N = 2048; d.kind = 7; }
    const int nblk = d.N / 32; d.k0 = 64 * (r / nblk); d.n0 = 32 * (r % nblk);
    return true;
}
__device__ __forceinline__ void p0_item_load(const P0It& d, int lane, float (&tv)[32]) {
    const GAS float* p = (const GAS float*)d.W + (size_t)(d.k0 + (lane >> 5)) * d.N + d.n0 + (lane & 31);
#pragma unroll
    for (int i = 0; i < 32; ++i) tv[i] = __builtin_nontemporal_load(p + (size_t)(2 * i) * d.N);
}
__device__ __forceinline__ void p0_item_finish(Frame& F, const P0It& d, const float (&tv)[32], LAS float* scr) {
    bf16* WALL = (bf16*)(F.ws + WS_WALL);
    switch (d.kind) {
    case 0: p0_transpose_finish<true, 1>(tv, D, WALL, 0, scr, d.k0, d.n0, F.lane, P1_PITCH); break;
    case 1: p0_transpose_finish<false, 2>(tv, D, (bf16*)(F.ws + WS_WG4), 0, scr, d.k0, d.n0, F.lane, P1B_PITCH); break;
    case 2: p0_transpose_finish<false, 1>(tv, D, WALL, INW + GATEW, scr, d.k0, d.n0, F.lane, P1_PITCH); break;
    case 3: p0_transpose_finish<false, 1>(tv, 1536, (bf16*)(F.ws + WS_WBRA), 0, scr, d.k0, d.n0, F.lane, ACT_PITCH); break;
    case 4: p0_transpose_finish<false, 1>(tv, 512, (bf16*)(F.ws + WS_WBRA + 1536), 0, scr, d.k0, d.n0, F.lane, ACT_PITCH); break;
    case 5: p0_transpose_finish<false, 1>(tv, 1024, (bf16*)(F.ws + WS_WBRA + 2048), 0, scr, d.k0, d.n0, F.lane, ACT_PITCH); break;
    case 6: p0_transpose_finish<false, 1>(tv, D, (bf16*)(F.ws + WS_WOUT), 0, scr, d.k0, d.n0, F.lane); break;
    default: p0_transpose_finish<false, 0>(tv, D, (bf16*)(F.ws + WS_WQ), 0, scr, d.k0, d.n0, F.lane); break;
    }
}
__device__ __forceinline__ void p0_weight_items(Frame& F, int it0, int it1, int gw, int NGW) {
    LAS float* scr = (LAS float*)(F.lds + RING_OFF + F.wave * 16384);
    P0It cur, nxt; float ta[32], tb[32];
    int it = it0 + gw;
    if (!p0_decode(F, it, it1, cur)) return;
    p0_item_load(cur, F.lane, ta);
#pragma unroll 1
    for (;;) {
        bool more = p0_decode(F, it + NGW, it1, nxt);
        if (more) p0_item_load(nxt, F.lane, tb);
        p0_item_finish(F, cur, ta, scr);
        if (!more) break;
        more = p0_decode(F, it + 2 * NGW, it1, cur);
        if (more) p0_item_load(cur, F.lane, ta);
        p0_item_finish(F, nxt, tb, scr);
        if (!more) break;
        it += 2 * NGW;
    }
}
__device__ __forceinline__ void p0_prologue(Frame& F) {
    const int gw = F.vcu * NWAVES + F.wave, NGW = F.G * NWAVES;
    p0_weight_items(F, 0, P0_NITEMS, gw, NGW);
    bf16* XA = (bf16*)(F.ws + WS_XA);
    p0_convert_fp8_rows(F.in[I_X], (unsigned char*)XA, T, P1_PITCH, gw, NGW, F.lane, F.ws + WS_XA4);
    p0_convert_fp8_rows(F.in[I_MEM], (unsigned char*)XA + (size_t)T * P1_PITCH, MROWS, P1_PITCH, gw, NGW, F.lane);
    p0_convert(F.in[I_SK], (bf16*)(F.ws + WS_SK), (size_t)8 * 2 * 128 * 128, gw, NGW, F.lane);
    {
        float* rope = (float*)(F.ws + WS_ROPE);
        const int* pos = (const int*)F.in[I_POS];
        const int gt = (F.vcu * NWAVES + F.wave) * 64 + F.lane, NGT = NGW * 64;
        for (int i = gt; i < T * 64; i += NGT) {
            const int m = i >> 6, j = i & 63;
            const double inv = exp2(-(double)j * (13.287712379549449 / 64.0));
            float sn, cs; sincos_d((double)pos[m] * inv, sn, cs);
            { typedef float f32x2g __attribute__((ext_vector_type(2))); *(GAS f32x2g*)(rope + (size_t)i * 2) = (f32x2g){cs, sn}; }
        }
    }
}

__device__ __forceinline__ void peer_tables_convert(Frame& F) {
    gu32* ctr = F.ctl + CW_ROWS;
#define PTC_TICKET(dst) do { unsigned t_ = 0u; if (F.lane == 0) t_ = __hip_atomic_fetch_add(ctr, 4u, RLX_AGENT); dst = __builtin_amdgcn_readfirstlane((int)t_); } while (0)
#define PTC_LOAD(row, arr) do { if ((row) < PEER_E) p0_fp4_row_load(F.in[I_PU], (row), F.lane, arr); else p0_fp4_row_load(F.in[I_PV], (row) - PEER_E, F.lane, arr); } while (0)
#define PTC_FINISH(row, arr) do { if ((row) < PEER_E) p0_fp4_row_finish(arr, F.ws + WS_PU, (row), 128.0f, F.lane); else p0_fp4_row_finish(arr, F.ws + WS_PV, (row) - PEER_E, PV_SCALE, F.lane); } while (0)
    int base; PTC_TICKET(base);
    if (base >= 2 * PEER_E) return;
    int k = 0; float ta[64], tb[64];
    PTC_LOAD(base, ta);
#pragma unroll 1
    for (;;) {
        int nb = base, nk = k + 1;
        if (nk == 4) { PTC_TICKET(nb); nk = 0; }
        bool more = nb < 2 * PEER_E;
        if (more) PTC_LOAD(nb + nk, tb);
        PTC_FINISH(base + k, ta);
        if (!more) break;
        base = nb; k = nk;
        nb = base; nk = k + 1;
        if (nk == 4) { PTC_TICKET(nb); nk = 0; }
        more = nb < 2 * PEER_E;
        if (more) PTC_LOAD(nb + nk, ta);
        PTC_FINISH(base + k, tb);
        if (!more) break;
        base = nb; k = nk;
    }
#undef PTC_TICKET
#undef PTC_LOAD
#undef PTC_FINISH
}
__device__ __forceinline__ bf16x8 as_bf16x8(v4u v) { return __builtin_bit_cast(bf16x8, v); }
constexpr int KP = 272;
constexpr int VP = 528;

struct RowMap { const bf16* base; long row0; int rstride; int pitch; };
__device__ __forceinline__ const bf16* rm_ptr(const RowMap& r, int i) { return r.base + (r.row0 + (long)i * r.rstride) * (long)r.pitch; }

template <int NCH, bool BAND, bool OUT8>
__device__ __forceinline__ void attn_unit(LAS unsigned char* lds, const RowMap qm, const RowMap km, const RowMap vm, bf16* obase, long orow0, int orstride, int opitch, int kmin, float* lse_out, int lse_stride, int tid) {
    const int lane = tid & 63, w = __builtin_amdgcn_readfirstlane(tid >> 6), l15 = lane & 15, fq = lane >> 4;
    const int qi = 16 * w + l15;
    f32x4 s[16];
#pragma unroll
    for (int kt = 0; kt < 16; ++kt) s[kt] = (f32x4){0.f, 0.f, 0.f, 0.f};
    const bf16* qp = rm_ptr(qm, qi);
    v4u kreg[8], va[4], vb[4];
#define ATT_LOAD_K(ch) do { _Pragma("unroll") for (int p = 0; p < 8; ++p) { const int idx = p * 512 + tid, key = idx >> 4, c16 = idx & 15; \
        kreg[p] = (v4u){0u, 0u, 0u, 0u}; if (key >= kmin) kreg[p] = *(const GAS v4u*)(rm_ptr(km, key) + (ch) * 128 + c16 * 8); } } while (0)
#define ATT_WRITE_K() do { _Pragma("unroll") for (int p = 0; p < 8; ++p) { const int idx = p * 512 + tid, key = idx >> 4, c16 = idx & 15; *(LAS v4u*)(lds + key * KP + c16 * 16) = kreg[p]; } } while (0)
#define ATT_LOAD_V(ch) do { _Pragma("unroll") for (int p = 0; p < 4; ++p) { const int idx = p * 512 + tid, kp = idx & 127, dg = idx >> 7; \
        va[p] = (v4u){0u, 0u, 0u, 0u}; vb[p] = (v4u){0u, 0u, 0u, 0u}; \
        if (2 * kp >= kmin) { va[p] = *(const GAS v4u*)(rm_ptr(vm, 2 * kp) + (ch) * 128 + dg * 8); vb[p] = *(const GAS v4u*)(rm_ptr(vm, 2 * kp + 1) + (ch) * 128 + dg * 8); } } } while (0)
#define ATT_WRITE_VT() do { _Pragma("unroll") for (int p = 0; p < 4; ++p) { const int idx = p * 512 + tid, kp = idx & 127, dg = idx >> 7; \
        _Pragma("unroll") for (int e = 0; e < 8; ++e) { const unsigned lo = (va[p][e >> 1] >> (16 * (e & 1))) & 0xffffu, hi = (vb[p][e >> 1] >> (16 * (e & 1))) & 0xffffu; \
            *(LAS unsigned*)(lds + (dg * 8 + e) * VP + kp * 4) = lo | (hi << 16); } } } while (0)
    ATT_LOAD_K(0);
#pragma unroll
    for (int ch = 0; ch < NCH; ++ch) {
        ATT_WRITE_K();
        bf16x8 qf[4];
#pragma unroll
        for (int ks = 0; ks < 4; ++ks) qf[ks] = as_bf16x8(*(const GAS v4u*)(qp + ch * 128 + 32 * ks + 8 * fq));
        __syncthreads();
        if (ch + 1 < NCH) ATT_LOAD_K(ch + 1); else ATT_LOAD_V(0);
#pragma unroll
        for (int kt = 0; kt < 16; ++kt)
#pragma unroll
            for (int ks = 0; ks < 4; ++ks) {
                const bf16x8 kf = as_bf16x8(*(const LAS v4u*)(lds + (16 * kt + l15) * KP + 64 * ks + 16 * fq));
                s[kt] = __builtin_amdgcn_mfma_f32_16x16x32_bf16(kf, qf[ks], s[kt], 0, 0, 0);
            }
        __syncthreads();
    }
    float mx = -3.0e38f;
#pragma unroll
    for (int kt = 0; kt < 16; ++kt)
#pragma unroll
        for (int i = 0; i < 4; ++i) {
            if (BAND) { const int kj = 16 * kt + 4 * fq + i; const bool ok = (kj >= qi) && (kj <= qi + 128) && (kj >= kmin); s[kt][i] = ok ? s[kt][i] : -1.0e30f; }
            mx = fmaxf(mx, s[kt][i]);
        }
    mx = fmaxf(mx, __shfl_xor(mx, 16)); mx = fmaxf(mx, __shfl_xor(mx, 32));
    float sum = 0.f;
#pragma unroll
    for (int kt = 0; kt < 16; ++kt)
#pragma unroll
        for (int i = 0; i < 4; ++i) { const float p = __builtin_amdgcn_exp2f((s[kt][i] - mx) * 1.4426950409f); s[kt][i] = p; sum += p; }
    sum += __shfl_xor(sum, 16); sum += __shfl_xor(sum, 32);
    const float inv = 1.0f / sum;
    if (lse_out && fq == 0) lse_out[(long)qi * lse_stride] = mx + __logf(sum);
    bf16x8 pf[8];
#pragma unroll
    for (int kk = 0; kk < 8; ++kk) { v4u t; t.x = pg8::cvt_pk_bf16(s[2 * kk][0], s[2 * kk][1]); t.y = pg8::cvt_pk_bf16(s[2 * kk][2], s[2 * kk][3]);
        t.z = pg8::cvt_pk_bf16(s[2 * kk + 1][0], s[2 * kk + 1][1]); t.w = pg8::cvt_pk_bf16(s[2 * kk + 1][2], s[2 * kk + 1][3]); pf[kk] = as_bf16x8(t); }
    bf16* op = obase + (orow0 + (long)qi * orstride) * (long)opitch;
#pragma unroll
    for (int ch = 0; ch < NCH; ++ch) {
        ATT_WRITE_VT();
        __syncthreads();
        if (ch + 1 < NCH) ATT_LOAD_V(ch + 1);
        f32x4 o[8];
#pragma unroll
        for (int nt = 0; nt < 8; ++nt) o[nt] = (f32x4){0.f, 0.f, 0.f, 0.f};
#pragma unroll
        for (int nt = 0; nt < 8; ++nt)
#pragma unroll
            for (int kk = 0; kk < 8; ++kk) {
                const LAS unsigned char* vp = lds + (16 * nt + l15) * VP + 64 * kk + 8 * fq;
                const v2u v0 = *(const LAS v2u*)vp, v1 = *(const LAS v2u*)(vp + 32);
                const bf16x8 vf = as_bf16x8((v4u){v0.x, v0.y, v1.x, v1.y});
                o[nt] = __builtin_amdgcn_mfma_f32_16x16x32_bf16(vf, pf[kk], o[nt], 0, 0, 0);
            }
#pragma unroll
        for (int nt = 0; nt < 8; ++nt) {
            if (OUT8) { const float i8 = inv * 8.0f; *(GAS unsigned*)((unsigned char*)obase + (orow0 + (long)qi * orstride) * (long)opitch + ch * 128 + 16 * nt + 4 * fq) = pg8::pk4_fp8(o[nt][0] * i8, o[nt][1] * i8, o[nt][2] * i8, o[nt][3] * i8); }
            else { v2u t; t.x = pg8::cvt_pk_bf16(o[nt][0] * inv, o[nt][1] * inv); t.y = pg8::cvt_pk_bf16(o[nt][2] * inv, o[nt][3] * inv);
            *(GAS v2u*)(op + ch * 128 + 16 * nt + 4 * fq) = t; } }
        __syncthreads();
    }
#undef ATT_LOAD_K
#undef ATT_WRITE_K
#undef ATT_LOAD_V
#undef ATT_WRITE_VT
}

__device__ __forceinline__ void gmlp_unit(Frame& F, int n, int g3) {
    const int tid = F.tid, lane = F.lane, w = F.wave, l15 = lane & 15, fq = lane >> 4;
    const bf16* proj = (const bf16*)(F.ws + WS_PROJ);
    LAS unsigned char* vt = F.lds + RING_OFF;
    LAS float* stats = (LAS float*)(F.lds + RING_OFF + 128 * KP);
    const long R0 = (long)n * 128;
#pragma unroll 1
    for (int t4 = 0; t4 < 4; ++t4) {
        v4u q[4][3];
#pragma unroll
        for (int tt = 0; tt < 4; ++tt) { const GAS v4u* rp = (const GAS v4u*)(proj + (R0 + 16 * w + 4 * t4 + tt) * INW + C_GV) + lane;
#pragma unroll
            for (int j = 0; j < 3; ++j) q[tt][j] = rp[64 * j]; }
#pragma unroll
        for (int tt = 0; tt < 4; ++tt) {
            float sm = 0.f;
#pragma unroll
            for (int j = 0; j < 3; ++j)
#pragma unroll
                for (int e = 0; e < 4; ++e) sm += pg8::bf_lo(q[tt][j][e]) + pg8::bf_hi(q[tt][j][e]);
            const float mean = wave_sum_dpp(sm) * (1.0f / GMW); float s2 = 0.f;
#pragma unroll
            for (int j = 0; j < 3; ++j)
#pragma unroll
                for (int e = 0; e < 4; ++e) { const float d0 = pg8::bf_lo(q[tt][j][e]) - mean, d1 = pg8::bf_hi(q[tt][j][e]) - mean; s2 += d0 * d0 + d1 * d1; }
            const float rstd = 1.0f / sqrtf(wave_sum_dpp(s2) * (1.0f / GMW) + LN_EPS);
            const int tok = 16 * w + 4 * t4 + tt;
            if (lane == 0) { stats[2 * tok] = mean; stats[2 * tok + 1] = rstd; }
        }
    }
    __syncthreads();
#pragma unroll 1
    for (int g = 3 * g3; g < 3 * g3 + 3; ++g) {
    const float* lng = F.in[I_GLNG] + g * 128; const float* lnb = F.in[I_GLNB] + g * 128;
#pragma unroll
    for (int p = 0; p < 2; ++p) { const int idx = p * 512 + tid, sp = idx & 63, cg = idx >> 6;
        const v4u a = *(const GAS v4u*)(proj + (R0 + 2 * sp) * INW + C_GV + g * 128 + cg * 8), b = *(const GAS v4u*)(proj + (R0 + 2 * sp + 1) * INW + C_GV + g * 128 + cg * 8);
        const float m0 = stats[4 * sp], r0 = stats[4 * sp + 1], m1 = stats[4 * sp + 2], r1 = stats[4 * sp + 3];
#pragma unroll
        for (int e = 0; e < 8; ++e) { const float x0 = (e & 1) ? pg8::bf_hi(a[e >> 1]) : pg8::bf_lo(a[e >> 1]), x1 = (e & 1) ? pg8::bf_hi(b[e >> 1]) : pg8::bf_lo(b[e >> 1]);
            const float gg = lng[cg * 8 + e], bb = lnb[cg * 8 + e];
            *(LAS unsigned*)(vt + (cg * 8 + e) * KP + sp * 4) = pk2((x0 - m0) * r0 * gg + bb, (x1 - m1) * r1 * gg + bb); } }
    __syncthreads();
    f32x4 acc[8];
#pragma unroll
    for (int ct = 0; ct < 8; ++ct) acc[ct] = (f32x4){0.f, 0.f, 0.f, 0.f};
    const int t = 16 * w + l15;
    const float* wrow = F.in[I_GWS] + ((size_t)g * 128 + t) * 128;
#pragma unroll
    for (int ks = 0; ks < 4; ++ks) {
        if (32 * ks <= 16 * w + 15) {
            const int s0 = 32 * ks + 8 * fq;
            const f32x4 w0 = *(const GAS f32x4*)(wrow + s0), w1 = *(const GAS f32x4*)(wrow + s0 + 4);
            v4u wf; wf.x = pk2(s0 + 0 <= t ? w0.x : 0.f, s0 + 1 <= t ? w0.y : 0.f); wf.y = pk2(s0 + 2 <= t ? w0.z : 0.f, s0 + 3 <= t ? w0.w : 0.f);
            wf.z = pk2(s0 + 4 <= t ? w1.x : 0.f, s0 + 5 <= t ? w1.y : 0.f); wf.w = pk2(s0 + 6 <= t ? w1.z : 0.f, s0 + 7 <= t ? w1.w : 0.f);
            const bf16x8 wb = as_bf16x8(wf);
#pragma unroll
            for (int ct = 0; ct < 8; ++ct) {
                const bf16x8 vf = as_bf16x8(*(const LAS v4u*)(vt + (16 * ct + l15) * KP + 64 * ks + 16 * fq));
                acc[ct] = __builtin_amdgcn_mfma_f32_16x16x32_bf16(vf, wb, acc[ct], 0, 0, 0);
            }
        }
    }
    const float bs = F.in[I_GBS][g * 128 + t];
    bf16* aout = (bf16*)(F.ws + WS_AOUT);
#pragma unroll
    for (int ct = 0; ct < 8; ++ct) {
        const int c = g * 128 + 16 * ct + 4 * fq;
        const v2u uu = *(const GAS v2u*)(proj + (R0 + t) * INW + C_GU + c);
        *(GAS unsigned*)((unsigned char*)aout + (R0 + t) * ACT_PITCH + c) = pg8::pk4_fp8(8.0f * pg8::bf_lo(uu.x) * (acc[ct][0] + bs), 8.0f * pg8::bf_hi(uu.x) * (acc[ct][1] + bs), 8.0f * pg8::bf_lo(uu.y) * (acc[ct][2] + bs), 8.0f * pg8::bf_hi(uu.y) * (acc[ct][3] + bs));
    }
    __syncthreads();
    }
}

__device__ __forceinline__ void p2_mixers(Frame& F) {
    const bf16* proj = (const bf16*)(F.ws + WS_PROJ);
    const bf16* mkv = (const bf16*)(F.ws + WS_MKV);
    LAS unsigned char* lds = F.lds + RING_OFF;
    if (!(DBG_P2SKIP & 1)) for (int u = F.vcu; u < 256; u += F.G) {
        const int b = u >> 7, h = (u >> 5) & 3, qb = u & 31;
        const RowMap qm{proj + C_MQ + h * 256, (long)b * SEQ + qb * 128, 1, INW};
        const RowMap km{mkv + h * 256, (long)b * MEMLEN, 1, 2048};
        const RowMap vm{mkv + 1024 + h * 256, (long)b * MEMLEN, 1, 2048};
        attn_unit<2, false, true>(lds, qm, km, vm, (bf16*)(F.ws + WS_MOUT + h * 256), (long)b * SEQ + qb * 128, 1, ACT_PITCH, 0, nullptr, 0, F.tid);
    }
    if (!(DBG_P2SKIP & 2)) for (int u = F.vcu; u < 768; u += F.G) {
        const int g = u >> 8, b = (u >> 7) & 1, hs = (u >> 5) & 3, rn = u & 31;
        const int d = (g == 0) ? 1 : (g == 1 ? 4 : 16), nb = 32 / d, r = rn / nb, n = rn % nb;
        const int head = g * 4 + hs;
        const long q0 = (long)b * SEQ + (long)n * 128 * d + r, k0 = q0 - 128L * d;
        const RowMap qm{proj + C_DQ + head * 128, q0, d, INW};
        const RowMap km{proj + C_DK + head * 128, k0, d, INW};
        const RowMap vm{proj + C_DV + head * 128, k0, d, INW};
        float* lse = (float*)(F.ws + WS_LSE) + ((size_t)g * T + q0) * 4 + hs;
        attn_unit<1, true, false>(lds, qm, km, vm, (bf16*)(F.ws + WS_OG) + (size_t)g * T * 512 + hs * 128, q0, d, 512, n == 0 ? 128 : 0, lse, 4 * d, F.tid);
    }
    if (!(DBG_P2SKIP & 4)) for (int u = F.vcu; u < 256; u += F.G) gmlp_unit(F, u >> 2, u & 3);
}

__device__ __forceinline__ void p3_merge(Frame& F) {
    const bf16* og = (const bf16*)(F.ws + WS_OG); const float* lse = (const float*)(F.ws + WS_LSE); bf16* bout = (bf16*)(F.ws + WS_BOUT);
    const int gt = (F.vcu * NWAVES + F.wave) * 64 + F.lane, NGT = F.G * NWAVES * 64;
    for (int i = gt; i < T * 64; i += NGT) {
        const int tok = i >> 6, c8 = i & 63, hs = c8 >> 4;
        const float l0 = lse[((size_t)0 * T + tok) * 4 + hs], l1 = lse[((size_t)1 * T + tok) * 4 + hs], l2 = lse[((size_t)2 * T + tok) * 4 + hs];
        const float m = fmaxf(l0, fmaxf(l1, l2)); const float e0 = __expf(l0 - m), e1 = __expf(l1 - m), e2 = __expf(l2 - m); const float is = 1.0f / (e0 + e1 + e2);
        const float w0 = e0 * is, w1 = e1 * is, w2 = e2 * is;
        const v4u a = *(const GAS v4u*)(og + ((size_t)0 * T + tok) * 512 + c8 * 8), b = *(const GAS v4u*)(og + ((size_t)1 * T + tok) * 512 + c8 * 8), c = *(const GAS v4u*)(og + ((size_t)2 * T + tok) * 512 + c8 * 8);
        float r[8];
#pragma unroll
        for (int e = 0; e < 4; ++e) { r[2 * e] = 8.0f * (w0 * pg8::bf_lo(a[e]) + w1 * pg8::bf_lo(b[e]) + w2 * pg8::bf_lo(c[e])); r[2 * e + 1] = 8.0f * (w0 * pg8::bf_hi(a[e]) + w1 * pg8::bf_hi(b[e]) + w2 * pg8::bf_hi(c[e])); }
        v2u o; o.x = pg8::pk4_fp8(r[0], r[1], r[2], r[3]); o.y = pg8::pk4_fp8(r[4], r[5], r[6], r[7]);
        *(GAS v2u*)((unsigned char*)bout + (size_t)tok * ACT_PITCH + c8 * 8) = o;
    }
}
__device__ __forceinline__ void p6_layernorm(Frame& F) {
    const bf16* z = (const bf16*)(F.ws + WS_Z); bf16* h1b = (bf16*)(F.ws + WS_H1B);
    const float* lg = F.in[I_LNMG]; const float* lb = F.in[I_LNMB];
    const int gw = F.vcu * NWAVES + F.wave, NGW = F.G * NWAVES, lane = F.lane;
    for (int m = gw; m < T; m += NGW) {
        const GAS v4u* zr = (const GAS v4u*)(z + (size_t)m * D) + lane;
        float v[64]; float s = 0.f;
#pragma unroll
        for (int j = 0; j < 8; ++j) { const v4u q = __builtin_nontemporal_load(zr + 64 * j);
#pragma unroll
            for (int e = 0; e < 4; ++e) { v[8 * j + 2 * e] = pg8::bf_lo(q[e]); v[8 * j + 2 * e + 1] = pg8::bf_hi(q[e]); s += v[8 * j + 2 * e] + v[8 * j + 2 * e + 1]; } }
        const float mean = wave_sum_dpp(s) * (1.f / D); float s2 = 0.f;
#pragma unroll
        for (int i = 0; i < 64; ++i) { v[i] -= mean; s2 += v[i] * v[i]; }
        const float rstd = 1.f / sqrtf(wave_sum_dpp(s2) * (1.f / D) + LN_EPS);
        GAS v4u* o = (GAS v4u*)(h1b + (size_t)m * D) + lane;
#pragma unroll
        for (int j = 0; j < 8; ++j) {
            const f32x4 ga = *((const GAS f32x4*)lg + 2 * lane + 128 * j), gb = *((const GAS f32x4*)lg + 2 * lane + 128 * j + 1), ba = *((const GAS f32x4*)lb + 2 * lane + 128 * j), bb = *((const GAS f32x4*)lb + 2 * lane + 128 * j + 1);
            v4u w; w.x = pk2(v[8 * j] * rstd * ga.x + ba.x, v[8 * j + 1] * rstd * ga.y + ba.y); w.y = pk2(v[8 * j + 2] * rstd * ga.z + ba.z, v[8 * j + 3] * rstd * ga.w + ba.w);
            w.z = pk2(v[8 * j + 4] * rstd * gb.x + bb.x, v[8 * j + 5] * rstd * gb.y + bb.y); w.w = pk2(v[8 * j + 6] * rstd * gb.z + bb.z, v[8 * j + 7] * rstd * gb.w + bb.w);
            o[64 * j] = w;
        }
    }
}

__device__ __forceinline__ unsigned f2ord(float f) { const unsigned u = __builtin_bit_cast(unsigned, f); return u ^ ((unsigned)((int)u >> 31) | 0x80000000u); }
__device__ __forceinline__ float ord2f(unsigned k) { const unsigned u = (k & 0x80000000u) ? (k ^ 0x80000000u) : ~k; return __builtin_bit_cast(float, u); }

__device__ __forceinline__ void p8_topk(Frame& F) {
    const bf16* Q = (const bf16*)(F.ws + WS_Q); const bf16* SK = (const bf16*)(F.ws + WS_SK);
    int* seli = (int*)(F.ws + WS_SELI); float* selg = (float*)(F.ws + WS_SELG);
    LAS unsigned char* lds = F.lds + RING_OFF;
    const int tid = F.tid, lane = F.lane, w = F.wave, l15 = lane & 15, fq = lane >> 4, gbase = lane & 48;
    for (int u = F.vcu; u < 512; u += F.G) {
        const int tb = u >> 3, h = u & 7;
#pragma unroll
        for (int p = 0; p < 8; ++p) { const int idx = p * 512 + tid, half = idx >> 11, key = (idx >> 4) & 127, c16 = idx & 15;
            *(LAS v4u*)(lds + (half * 128 + key) * KP + c16 * 16) = *(const GAS v4u*)(SK + ((size_t)(h * 2 + half) * 128 + key) * 128 + c16 * 8); }
        __syncthreads();
        f32x4 sc[2][8];
        const bf16* qrow = Q + (size_t)(tb * 128 + 16 * w + l15) * 2048 + h * 256;
#pragma unroll
        for (int p = 0; p < 2; ++p) {
            bf16x8 qf[4];
#pragma unroll
            for (int ks = 0; ks < 4; ++ks) qf[ks] = as_bf16x8(*(const GAS v4u*)(qrow + p * 128 + 32 * ks + 8 * fq));
#pragma unroll
            for (int nt = 0; nt < 8; ++nt) { sc[p][nt] = (f32x4){0.f, 0.f, 0.f, 0.f};
#pragma unroll
                for (int ks = 0; ks < 4; ++ks) {
                    const bf16x8 kf = as_bf16x8(*(const LAS v4u*)(lds + (p * 128 + 16 * nt + l15) * KP + 64 * ks + 16 * fq));
                    sc[p][nt] = __builtin_amdgcn_mfma_f32_16x16x32_bf16(qf[ks], kf, sc[p][nt], 0, 0, 0);
                } }
        }
        __syncthreads();
#pragma unroll
        for (int i = 0; i < 4; ++i) {
            unsigned rk[2];
#pragma unroll
            for (int p = 0; p < 2; ++p) {
                unsigned v[8];
#pragma unroll
                for (int nt = 0; nt < 8; ++nt) v[nt] = (f2ord(sc[p][nt][i]) & ~127u) | (unsigned)(127 - (16 * nt + l15));
                unsigned r = 0u;
#pragma unroll 1
                for (int it = 0; it < 16; ++it) {
                    unsigned b = max(max(max(v[0], v[1]), max(v[2], v[3])), max(max(v[4], v[5]), max(v[6], v[7])));
                    b = row_max_u32(b);
                    r = (l15 == it) ? b : r;
#pragma unroll
                    for (int nt = 0; nt < 8; ++nt) v[nt] = (v[nt] == b) ? 0u : v[nt];
                }
                rk[p] = r;
            }
            const float s1 = ord2f(rk[0] & ~127u), s2 = ord2f(rk[1] & ~127u);
            const int i1 = 127 - (int)(rk[0] & 127u), i2 = 127 - (int)(rk[1] & 127u);
            unsigned c[4];
            {
                const float s1_0 = __shfl(s1, gbase), s1_1 = __shfl(s1, gbase + 1), s1_2 = __shfl(s1, gbase + 2);
#pragma unroll
                for (int j = 0; j < 4; ++j) { const float v = s1 + __shfl(s2, gbase + j); c[j] = ((l15 + 1) * (j + 1) <= 16) ? ((f2ord(v) & ~255u) | (unsigned)(255 - (l15 * 16 + j))) : 0u; }
                const int hi = l15 >= 8;
                const int b1 = l15 - 4;
                const float v1 = s1_0 + __shfl(s2, gbase + (hi ? b1 : 0));
                if (hi) c[1] = (f2ord(v1) & ~255u) | (unsigned)(255 - b1);
                const int a2 = l15 >= 12 ? 1 : 0, b2 = l15 >= 12 ? l15 - 8 : l15 + 4;
                const float v2 = (a2 ? s1_1 : s1_0) + __shfl(s2, gbase + (hi ? b2 : 0));
                if (hi) c[2] = (f2ord(v2) & ~255u) | (unsigned)(255 - (a2 * 16 + b2));
                const float v3 = s1_2 + __shfl(s2, gbase + 4);
                if (l15 == 8) c[3] = (f2ord(v3) & ~255u) | (unsigned)(255 - (2 * 16 + 4));
            }
            unsigned r = 0u;
#pragma unroll 1
            for (int it = 0; it < 16; ++it) {
                unsigned b = row_max_u32(max(max(c[0], c[1]), max(c[2], c[3])));
                r = (l15 == it) ? b : r;
#pragma unroll
                for (int j = 0; j < 4; ++j) c[j] = (c[j] == b) ? 0u : c[j];
            }
            const float best = ord2f(r & ~255u); const int ci = 255 - (int)(r & 255u);
            const int e1 = __shfl(i1, gbase + (ci >> 4)), e2 = __shfl(i2, gbase + (ci & 15));
            const float mx0 = __shfl(best, gbase);
            const float ev = __expf(best - mx0);
            const float sm = row_sum_f32(ev);
            const size_t tok = (size_t)tb * 128 + 16 * w + 4 * fq + i;
            seli[tok * 128 + h * 16 + l15] = e1 * 128 + e2; selg[tok * 128 + h * 16 + l15] = ev / sm;
        }
    }
}

typedef float f32x2v __attribute__((ext_vector_type(2)));
typedef float f32x32v __attribute__((ext_vector_type(32)));
typedef float f32x4p __attribute__((ext_vector_type(4)));
typedef unsigned u32x6v __attribute__((ext_vector_type(6)));
#define PEER_LD(p) (*(p))
#define PEER_DECL(n) v4u n##ua, n##ud, n##va, n##vd
#define PEER_LOAD(n, eid) do { const unsigned char* up_ = PU + (size_t)(eid) * 2048; const unsigned char* vp_ = PV + (size_t)(eid) * 2048; \
    n##ua = PEER_LD((const GAS v4u*)up_ + lane); n##ud = PEER_LD((const GAS v4u*)(up_ + 1024) + lane); \
    n##va = PEER_LD((const GAS v4u*)vp_ + lane); n##vd = PEER_LD((const GAS v4u*)(vp_ + 1024) + lane); } while (0)
#define PEER_RUN(n, gate) peer_expert(n##ua, n##ud, n##va, n##vd, xl, y16, gate)
typedef _Float16 h2v __attribute__((ext_vector_type(2)));
__device__ __forceinline__ void peer_expert(const v4u ua, const v4u ud, const v4u va, const v4u vd, const LAS unsigned char* xl, h2v (&y)[32], float gate) {
    float d0 = 0.f, d1 = 0.f, d2 = 0.f, d3 = 0.f;
#pragma unroll
    for (int w = 0; w < 8; ++w) {
        const v4u xq = *(const LAS v4u*)(xl + w * 1024);
        unsigned xq0 = xq.x, xq1 = xq.y, xq2 = xq.z, xq3 = xq.w;
        asm volatile("" : "+v"(xq0), "+v"(xq1), "+v"(xq2), "+v"(xq3));
        const unsigned uw = w < 4 ? ua[w & 3] : ud[w & 3];
        d0 = __builtin_amdgcn_fdot2(__builtin_amdgcn_cvt_scalef32_pk_f16_fp4(uw, 1.0f, 0), __builtin_bit_cast(h2v, xq0), d0, false);
        d1 = __builtin_amdgcn_fdot2(__builtin_amdgcn_cvt_scalef32_pk_f16_fp4(uw, 1.0f, 1), __builtin_bit_cast(h2v, xq1), d1, false);
        d2 = __builtin_amdgcn_fdot2(__builtin_amdgcn_cvt_scalef32_pk_f16_fp4(uw, 1.0f, 2), __builtin_bit_cast(h2v, xq2), d2, false);
        d3 = __builtin_amdgcn_fdot2(__builtin_amdgcn_cvt_scalef32_pk_f16_fp4(uw, 1.0f, 3), __builtin_bit_cast(h2v, xq3), d3, false);
    }
    const float dot = wave_sum_dpp((d0 + d1) + (d2 + d3)) * (1.0f / 128.0f);
    const float a = pg8::gelu_tanh(dot) * gate * (1.0f / PV_SCALE);
    const h2v a2 = {(_Float16)a, (_Float16)a};
#pragma unroll
    for (int w = 0; w < 4; ++w) {
        y[4 * w + 0] = a2 * __builtin_amdgcn_cvt_scalef32_pk_f16_fp4(va[w], 1.0f, 0) + y[4 * w + 0]; y[4 * w + 1] = a2 * __builtin_amdgcn_cvt_scalef32_pk_f16_fp4(va[w], 1.0f, 1) + y[4 * w + 1];
        y[4 * w + 2] = a2 * __builtin_amdgcn_cvt_scalef32_pk_f16_fp4(va[w], 1.0f, 2) + y[4 * w + 2]; y[4 * w + 3] = a2 * __builtin_amdgcn_cvt_scalef32_pk_f16_fp4(va[w], 1.0f, 3) + y[4 * w + 3];
    }
#pragma unroll
    for (int w = 0; w < 4; ++w) {
        y[16 + 4 * w + 0] = a2 * __builtin_amdgcn_cvt_scalef32_pk_f16_fp4(vd[w], 1.0f, 0) + y[16 + 4 * w + 0]; y[16 + 4 * w + 1] = a2 * __builtin_amdgcn_cvt_scalef32_pk_f16_fp4(vd[w], 1.0f, 1) + y[16 + 4 * w + 1];
        y[16 + 4 * w + 2] = a2 * __builtin_amdgcn_cvt_scalef32_pk_f16_fp4(vd[w], 1.0f, 2) + y[16 + 4 * w + 2]; y[16 + 4 * w + 3] = a2 * __builtin_amdgcn_cvt_scalef32_pk_f16_fp4(vd[w], 1.0f, 3) + y[16 + 4 * w + 3];
    }
}
__device__ __forceinline__ int sel_id(int id0, int id1, int e) { return (e < 64) ? __builtin_amdgcn_readlane(id0, e & 63) : __builtin_amdgcn_readlane(id1, e & 63); }
__device__ __forceinline__ float sel_gate(float g0, float g1, int e) { return __builtin_bit_cast(float, (e < 64) ? __builtin_amdgcn_readlane(__builtin_bit_cast(int, g0), e & 63) : __builtin_amdgcn_readlane(__builtin_bit_cast(int, g1), e & 63)); }
template <bool HALF>
__device__ __forceinline__ void peer_item(Frame& F, const int tok, const int half, const int ti) {
    const bf16* h1b = (const bf16*)(F.ws + WS_H1B);
    const unsigned char* PU = F.ws + WS_PU; const unsigned char* PV = F.ws + WS_PV;
    const int* seli = (const int*)(F.ws + WS_SELI); const float* selg = (const float*)(F.ws + WS_SELG);
    const GAS float* lg0 = (const GAS float*)F.in[I_LNFG]; const GAS float* lb0 = (const GAS float*)F.in[I_LNFB];
    unsigned lseed = 0u; asm volatile("" : "+v"(lseed)); const int lane = (int)__builtin_amdgcn_mbcnt_hi(~0u, __builtin_amdgcn_mbcnt_lo(~0u, lseed));
    h2v y16[32];
    f32x2v y[32];
    LAS unsigned char* xl = F.lds + RING_OFF + F.wave * 8192 + lane * 16;
    { LAS unsigned char* xw_ = xl; const GAS bf16* xr = (const GAS bf16*)(h1b + (size_t)tok * D) + lane;
#pragma unroll
      for (int k = 0; k < 32; ++k) { const h2v xp = {(_Float16)__builtin_bit_cast(float, (unsigned)xr[(2 * k) * 64] << 16), (_Float16)__builtin_bit_cast(float, (unsigned)xr[(2 * k + 1) * 64] << 16)};
          *(LAS h2v*)(xw_ + (k >> 2) * 1024 + (k & 3) * 4) = xp; y16[k] = (h2v){(_Float16)0.f, (_Float16)0.f}; } }
    asm volatile("" : "+v"(xl));
    const int id0 = seli[(size_t)tok * 128 + (HALF ? half * 64 : 0) + lane], id1 = HALF ? 0 : seli[(size_t)tok * 128 + 64 + lane];
    const float g0 = selg[(size_t)tok * 128 + (HALF ? half * 64 : 0) + lane], g1 = HALF ? 0.f : selg[(size_t)tok * 128 + 64 + lane];
    constexpr int NE = HALF ? 64 : DBG_NEXPERTS;
#define PEER_ID(e) (HALF ? __builtin_amdgcn_readlane(id0, (e) & 63) : sel_id(id0, id1, (e)))
#define PEER_GT(e) (HALF ? __builtin_bit_cast(float, __builtin_amdgcn_readlane(__builtin_bit_cast(int, g0), (e) & 63)) : sel_gate(g0, g1, (e)))
    PEER_DECL(s0); PEER_DECL(s1); PEER_DECL(s2);
    PEER_LOAD(s0, PEER_ID(0));
    PEER_LOAD(s1, PEER_ID(1));
#pragma unroll 1
    for (int e = 0; e < NE - 2; e += 3) {
        PEER_LOAD(s2, PEER_ID(e + 2));
        PEER_RUN(s0, PEER_GT(e));
        PEER_LOAD(s0, PEER_ID(e + 3));
        PEER_RUN(s1, PEER_GT(e + 1));
        PEER_LOAD(s1, PEER_ID((e + 4) & (NE - 1)));
        PEER_RUN(s2, PEER_GT(e + 2));
    }
    if (HALF) { PEER_RUN(s0, PEER_GT(63)); }
    else if (DBG_NEXPERTS == 128) { PEER_RUN(s0, PEER_GT(126)); PEER_RUN(s1, PEER_GT(127)); }
#undef PEER_ID
#undef PEER_GT
#pragma unroll
    for (int k = 0; k < 32; ++k) y[k] = __builtin_convertvector(y16[k], f32x2v);
    if (HALF) {
        gu64* yp = (gu64*)(F.ws + WS_YP) + (size_t)(ti * 2 + half) * 2048 + lane;
#pragma unroll
        for (int k = 0; k < 32; ++k) __hip_atomic_store(yp + k * 64, __builtin_bit_cast(unsigned long long, y[k]), __ATOMIC_RELAXED, __HIP_MEMORY_SCOPE_AGENT);
        asm volatile("s_waitcnt vmcnt(0)" ::: "memory");
        unsigned old = 0u;
        if (lane == 0) old = __hip_atomic_fetch_add(F.ctl + CW_DONE + ti, 1u, __ATOMIC_RELAXED, __HIP_MEMORY_SCOPE_AGENT);
        old = (unsigned)__builtin_amdgcn_readfirstlane((int)old);
        if (old == 0u) return;
        __builtin_amdgcn_fence(__ATOMIC_ACQUIRE, "agent");
        const GAS f32x2v* op = (const GAS f32x2v*)(F.ws + WS_YP) + (size_t)(ti * 2 + (half ^ 1)) * 2048 + lane;
#pragma unroll
        for (int k = 0; k < 32; ++k) y[k] = y[k] + op[k * 64];
    }
    float s = 0.f;
    asm volatile("" : "+v"(xl));
#pragma unroll
    for (int k = 0; k < 32; ++k) { const f32x2v xw = __builtin_convertvector(*(const LAS h2v*)(xl + (k >> 2) * 1024 + (k & 3) * 4), f32x2v); y[k] = xw * ALPHA + y[k]; s += y[k].x + y[k].y; }
    const float mean = wave_sum_dpp(s) * (1.f / D); float s2 = 0.f;
#pragma unroll
    for (int k = 0; k < 32; ++k) { y[k] = y[k] - mean; s2 += y[k].x * y[k].x + y[k].y * y[k].y; }
    const float rstd = 1.f / sqrtf(wave_sum_dpp(s2) * (1.f / D) + LN_EPS);
    GAS float* orow = (GAS float*)(F.out + (size_t)tok * D) + lane;
    const GAS float* lgp = lg0 + lane; const GAS float* lbp = lb0 + lane;
#pragma unroll
    for (int k = 0; k < 32; ++k) {
        const float o0 = y[k].x * rstd * lgp[(2 * k) * 64] + lbp[(2 * k) * 64], o1 = y[k].y * rstd * lgp[(2 * k + 1) * 64] + lbp[(2 * k + 1) * 64];
        orow[(2 * k) * 64] = o0; orow[(2 * k + 1) * 64] = o1;
    }
}
__device__ __forceinline__ void p9_peer(Frame& F) {
    const int gw = F.vcu * NWAVES + F.wave, NGW = F.G * NWAVES;
    const int rounds = T / NGW > 1 ? T / NGW - 1 : 0;
    const int n_static = rounds * NGW;
#pragma unroll 1
    for (int tok = gw; tok < n_static; tok += NGW) peer_item<false>(F, tok, 0, 0);
    const int n_items = 2 * (T - n_static), per = (n_items + P11_NSH - 1) / P11_NSH;
    int sh = gw % P11_NSH;
#pragma unroll 1
    for (int tries = 0; tries < P11_NSH;) {
        unsigned t = 0u;
        if (F.lane == 0) t = __hip_atomic_fetch_add(F.ctl + CW_P11 + sh * 32, 1u, __ATOMIC_RELAXED, __HIP_MEMORY_SCOPE_AGENT);
        t = (unsigned)__builtin_amdgcn_readfirstlane((int)t);
        const int item = sh * per + (int)t;
        if ((int)t >= per || item >= n_items) { sh = (sh + 1 == P11_NSH) ? 0 : sh + 1; ++tries; continue; }
        peer_item<true>(F, n_static + (item >> 1), item & 1, item >> 1);
    }
}

struct Args { const float* in[23]; float* out; unsigned char* ws; int ph_lo, ph_hi, li, pad; };
__global__ void __launch_bounds__(NWAVES * 64, 2) fwd_kernel(Args args) {
    extern __shared__ __attribute__((aligned(16))) unsigned char lds[];
    Frame F;
    F.lds = (LAS unsigned char*)lds;
    F.MISC = (volatile LAS unsigned*)(F.lds + MISC_OFF);
    F.tid = threadIdx.x; F.lane = F.tid & 63; F.wave = __builtin_amdgcn_readfirstlane(F.tid >> 6);
    F.G = gridDim.x; { const int bx = blockIdx.x; F.vcu = (F.G % 8 == 0) ? (bx % 8) * (F.G / 8) + bx / 8 : bx; }
    F.ws = args.ws; F.out = args.out;
    F.ctl = (gu32*)(args.ws + WS_CTL);
#pragma unroll
    for (int i = 0; i < 23; ++i) F.in[i] = args.in[i];
    for (int u = F.tid; u < (LDS_BYTES - LDSCTL_OFF) / 4; u += NWAVES * 64) ((LAS unsigned*)(F.lds + LDSCTL_OFF))[u] = 0u;
    __syncthreads();
    XcdBarrier bar; bar.bar = (unsigned*)(F.ctl + CW_BAR); bar.x = 0; bar.st = nullptr;
    if (N_LAUNCHES == 1) bar = xcd_barrier_post((unsigned*)(F.ctl + CW_BAR), F.MISC + 8);
#define PROBE_ON (DBG_PROBE_A >= 0 || DBG_PROBE_B >= 0)
    int n_stamp = 0;
#define STAMP() do { if (PROBE_ON && blockIdx.x == 0 && F.tid == 0) { ((unsigned long long*)(args.ws + 8192))[n_stamp] = __builtin_amdgcn_s_memrealtime(); } ++n_stamp; } while (0)
    STAMP();
#define GRID_BAR() do { if (N_LAUNCHES == 1) xcd_barrier(bar); STAMP(); if (PROBE_ON && blockIdx.x == 0 && F.tid == 0) ((unsigned long long*)(args.ws + 8192 + 512))[n_stamp - 1] = __builtin_amdgcn_s_memtime(); } while (0)
    const int lo = args.ph_lo, hi = args.ph_hi;
#ifndef PHASE_MASK
#define PHASE_MASK 0xfff
#endif
#define IN(k) (((PHASE_MASK >> (k)) & 1) && lo <= (k) && (k) < hi)
#define BOTH(k) (IN(k) && IN((k) + 1))
    unsigned char* ws = args.ws;

    if (IN(0)) { p0_prologue(F); if (BOTH(0)) GRID_BAR(); }

    if (IN(1)) {
        pg8::Gemm g{(const pg8::bf16_t*)(ws + WS_XA), (const pg8::bf16_t*)(ws + WS_WALL), MALL, NALL, D / 2, 127, 121, P1_PITCH / 2};
        const int nconv = (F.G % 8 == 0 && F.G >= 64) ? F.G / 8 : 0, GG = F.G - nconv;
        pg8::SchedP1 S; S.init(GG, (int)blockIdx.x);
        pg8::EpiProj E{(pg8::bf16_t*)(ws + WS_PROJ), (pg8::bf16_t*)(ws + WS_GATES), (pg8::bf16_t*)(ws + WS_MKV), F.in[I_BGATE], (const float*)(ws + WS_ROPE)};
        if ((int)blockIdx.x < GG) pg8::gemm_phase<pg8::EpiProj, pg8::SchedP1, PG8_ALIGN, PG8_SP2, 1>(F.lds + RING_OFF, g, S, E);
        if ((int)blockIdx.x < GG) {
            pg8::Gemm g4{(const pg8::bf16_t*)(ws + WS_XA4), (const pg8::bf16_t*)(ws + WS_WG4), T, GATEW, D / 4, 126, 120, P1B_PITCH / 2};
            pg8::StaticOrder S4; S4.init(T, GATEW, GG, (int)blockIdx.x);
            pg8::EpiGate E4{E};
            pg8::gemm_phase<pg8::EpiGate, pg8::StaticOrder, PG8_ALIGN, PG8_SP2, 2>(F.lds + RING_OFF, g4, S4, E4);
        }
        peer_tables_convert(F);
        if (BOTH(1)) GRID_BAR();
    }

    if (IN(2)) { p2_mixers(F); if (BOTH(2)) GRID_BAR(); }

    if (IN(3)) { p3_merge(F); if (BOTH(3)) GRID_BAR(); }

    if (IN(4)) {
        pg8::StaticOrder S; S.init(T, D, F.G, (int)blockIdx.x);
        pg8::Gemm g{(const pg8::bf16_t*)(ws + WS_AOUT), (const pg8::bf16_t*)(ws + WS_WBRA), T, D, ACT_PITCH / 2, 124, 121};
        pg8::EpiMerge3 E{(const unsigned char*)(ws + WS_GATES), (pg8::bf16_t*)(ws + WS_MERGEDB)};
        pg8::gemm_phase<pg8::EpiMerge3, pg8::StaticOrder, PG8_ALIGN, PG8_SP2, 1>(F.lds + RING_OFF, g, S, E);
        if (BOTH(4)) GRID_BAR();
    }

    if (IN(7)) {
        pg8::Gemm g{(const pg8::bf16_t*)(ws + (DBG_P5A == 1 ? WS_XA : (DBG_P5A == 2 ? WS_PROJ : (DBG_P5A == 3 ? WS_AOUT : (DBG_P5A == 4 ? WS_GATES : (DBG_P5A == 5 ? WS_GATES + 128 * MiB : WS_MERGEDB)))))), (const pg8::bf16_t*)(ws + WS_WOUT), T, D, D / 2, 124, 121};
        pg8::StaticOrder S; S.init(T, D, F.G, (int)blockIdx.x);
        pg8::EpiResid E{F.in[I_X], (pg8::bf16_t*)(ws + WS_Z), ALPHA};
        pg8::gemm_phase<pg8::EpiResid, pg8::StaticOrder, PG8_ALIGN, PG8_SP2, 1>(F.lds + RING_OFF, g, S, E);
        if (BOTH(7)) GRID_BAR();
    }

    if (IN(8)) { p6_layernorm(F); if (BOTH(8)) GRID_BAR(); }

    if (IN(9)) {
        pg8::Gemm g{(const pg8::bf16_t*)(ws + WS_H1B), (const pg8::bf16_t*)(ws + WS_WQ), T, 2048, D};
        pg8::StaticOrder S; S.init(T, 2048, F.G, (int)blockIdx.x);
        pg8::EpiPlain E{(pg8::bf16_t*)(ws + WS_Q), 2048};
        pg8::gemm_phase<pg8::EpiPlain, pg8::StaticOrder, PG8_ALIGN, PG8_SP2>(F.lds + RING_OFF, g, S, E);
        if (BOTH(9)) GRID_BAR();
    }

    if (IN(10)) { p8_topk(F); if (BOTH(10)) GRID_BAR(); }

    if (IN(11)) { p9_peer(F); }
#undef IN
#undef BOTH
#undef GRID_BAR
}

extern "C" void kernel_launch(void* const* d_in, const int* in_sizes, int n_in, void* d_out, int out_size, void* d_ws, size_t ws_size, hipStream_t stream) {
    static int grid = 0;
    if (grid == 0) {
        if (n_in != 23 || in_sizes[0] != T * D || out_size != T * D || ws_size < WS_END) { fprintf(stderr, "kernel_launch: unexpected shapes (n_in %d, in0 %d, out %d, ws %zu); nothing launched\n", n_in, n_in > 0 ? in_sizes[0] : -1, out_size, ws_size); grid = -1; return; }
        int dev = 0, cus = 0, per_cu = 0;
        if (hipGetDevice(&dev) != hipSuccess || hipDeviceGetAttribute(&cus, hipDeviceAttributeMultiprocessorCount, dev) != hipSuccess) { grid = -1; return; }
        if (hipFuncSetAttribute((const void*)fwd_kernel, hipFuncAttributeMaxDynamicSharedMemorySize, LDS_BYTES) != hipSuccess) { fprintf(stderr, "kernel_launch: hipFuncSetAttribute failed\n"); grid = -1; return; }
        if (hipOccupancyMaxActiveBlocksPerMultiprocessor(&per_cu, (const void*)fwd_kernel, NWAVES * 64, LDS_BYTES) != hipSuccess || per_cu < 1)
            fprintf(stderr, "kernel_launch: note: occupancy query reports %d workgroups per CU\n", per_cu);
        (void)hipGetLastError();
        grid = cus;
    }
    if (grid < 0) return;
    if (hipMemsetAsync((char*)d_ws + WS_CTL, 0, CTL_ZERO_BYTES, stream) != hipSuccess) return;
    Args a{};
    for (int i = 0; i < 23; ++i) a.in[i] = (const float*)d_in[i];
    a.out = (float*)d_out; a.ws = (unsigned char*)d_ws; a.pad = 0;
    for (int li = 0; li < N_LAUNCHES; ++li) {
        a.ph_lo = (N_LAUNCHES == 1) ? 0 : li; a.ph_hi = (N_LAUNCHES == 1) ? N_PHASES : li + 1; a.li = li;
        hipLaunchKernelGGL(fwd_kernel, dim3(grid), dim3(NWAVES * 64), LDS_BYTES, stream, a);
        if (hipPeekAtLastError() != hipSuccess) break;
    }
}
```

```cpp
#include <hip/hip_runtime.h>
#include <cstdio>
#include <cstdint>
#ifndef DBG_NEXPERTS
#define DBG_NEXPERTS 128
#endif
#ifndef DBG_MIXSCALE
#define DBG_MIXSCALE 1.0f
#endif
#ifndef DBG_BR
#define DBG_BR 7
#endif
#ifndef DBG_P5A
#define DBG_P5A 0
#endif
#ifndef DBG_P4SRC
#define DBG_P4SRC 0
#endif
#ifndef DBG_ZALT
#define DBG_ZALT 0
#endif
#ifndef DBG_GATEPLAIN
#define DBG_GATEPLAIN 0
#endif
#ifndef DBG_PROBE_A
#define DBG_PROBE_A -1
#endif
#ifndef DBG_PROBE_B
#define DBG_PROBE_B -1
#endif
#ifndef DBG_P2SKIP
#define DBG_P2SKIP 0
#endif
#ifndef DBG_HALFMMA
#define DBG_HALFMMA 0
#endif
#ifndef DBG_PEER_NT
#define DBG_PEER_NT 0
#endif
namespace pg8 {
#define PG8_LAS __attribute__((address_space(3)))
typedef unsigned short bf16_t;
typedef short bf16x8 __attribute__((ext_vector_type(8)));
typedef float f32x4 __attribute__((ext_vector_type(4)));
typedef unsigned u32x4 __attribute__((ext_vector_type(4)));
constexpr int BM = 256, BK = 64, HALF = 128, HTB = HALF * BK * 2  , STAGE_BYTES = 8 * HTB, NXCD = 8, WGM = 8;

__host__ __device__ __forceinline__ int lds_byte(int r, int c) { const int st = (r >> 4) * 2 + (c >> 5), rr = r & 15, cc = c & 31, ob = rr * 64 + cc * 2; return st * 1024 + (ob ^ (((ob >> 9) & 1) << 5)); }
__host__ __device__ __forceinline__ void stage_rc(int b, int& R, int& C) { const int st = b / 1024, sb = b % 1024, swz = sb ^ (((sb >> 9) & 1) << 5); R = (st >> 1) * 16 + swz / 64; C = (st & 1) * 32 + (swz % 64) / 2; }
__host__ __device__ __forceinline__ int perm32(int rho) { const int n = rho >> 4, i = rho & 15; return 8 * (i >> 2) + 4 * n + (i & 3); }

struct Unit { int pm, pn; };
struct Gemm { const bf16_t* A; const bf16_t* Bt; int M, N, K; int sA, sB; int ld; };

struct StaticOrder {
    int nM, nN, nwg, G, c;
    __host__ __device__ void init(int M, int N, int G_, int c_) { nM = M / BM; nN = N / BM; nwg = nM * nN; G = G_; c = c_; }
    __host__ __device__ bool next(int i, Unit& u) const {
        const long L = (long)i * G + c; if (L >= nwg) return false;
        int wgid = (int)L; { const int q = nwg / NXCD, r = nwg % NXCD, xcd = wgid % NXCD, off = wgid / NXCD; wgid = (xcd < r ? xcd * (q + 1) : r * (q + 1) + (xcd - r) * q) + off; }
        const int nig = WGM * nN, gid = wgid / nig, fm = gid * WGM, gsz = (nM - fm) < WGM ? (nM - fm) : WGM;
        u.pm = fm + ((wgid % nig) % gsz); u.pn = (wgid % nig) / gsz; return true;
    }
    __device__ __forceinline__ void a_ready(const Unit&) const {}
    __device__ __forceinline__ void done(const Unit&) const {}
};

__device__ __forceinline__ unsigned pk4_fp8(float a, float b, float c, float d) { a = __builtin_amdgcn_fmed3f(a, -448.f, 448.f); b = __builtin_amdgcn_fmed3f(b, -448.f, 448.f); c = __builtin_amdgcn_fmed3f(c, -448.f, 448.f); d = __builtin_amdgcn_fmed3f(d, -448.f, 448.f);
    int w = 0; w = __builtin_amdgcn_cvt_pk_fp8_f32(a, b, w, false); w = __builtin_amdgcn_cvt_pk_fp8_f32(c, d, w, true); return (unsigned)w; }
typedef __bf16 bf16x2_t __attribute__((ext_vector_type(2)));
typedef float f32x2_t __attribute__((ext_vector_type(2)));
__device__ __forceinline__ unsigned cvt_pk_bf16(float lo, float hi) { const bf16x2_t r = __builtin_convertvector((f32x2_t){lo, hi}, bf16x2_t); return __builtin_bit_cast(unsigned, r); }
typedef float f32x2 __attribute__((ext_vector_type(2)));
typedef float f32x4u __attribute__((ext_vector_type(4), aligned(16)));
__device__ __forceinline__ float gelu_tanh(float x) {
    const float u = x * (1.5957691216f + 0.0713548163f * x * x);
    const float e = __builtin_amdgcn_exp2f(-1.4426950409f * u);
    return x * __builtin_amdgcn_rcpf(1.0f + e);
}
__device__ __forceinline__ float sigmoid_f(float x) { return __builtin_amdgcn_rcpf(1.0f + __builtin_amdgcn_exp2f(-1.4426950409f * x)); }
__device__ __forceinline__ u32x4 pack8(const f32x4& v0, const f32x4& v1) { u32x4 w; w.x = cvt_pk_bf16(v0[0], v0[1]); w.y = cvt_pk_bf16(v0[2], v0[3]); w.z = cvt_pk_bf16(v1[0], v1[1]); w.w = cvt_pk_bf16(v1[2], v1[3]); return w; }
__device__ __forceinline__ float bf_lo(unsigned w) { return __builtin_bit_cast(float, w << 16); }
__device__ __forceinline__ float bf_hi(unsigned w) { return __builtin_bit_cast(float, w & 0xffff0000u); }

struct EpiProj {
    static constexpr bool PERM = true, AFTER_DRAIN = false, MIDK = false; static constexpr int T1 = -1, T2 = -1;
    bf16_t* proj; bf16_t* gates; bf16_t* mkv; const float* bgate; const float* rope;
    template <int KIND> __device__ __forceinline__ void tile(const f32x4 (&acc)[2][2][4][2], bf16_t* base, int ldc, int row0, int cb, float sc, const float* bias) const {
        f32x4 bv[2][2];
        if (KIND == 3) {
#pragma unroll
            for (int bj = 0; bj < 2; ++bj)
#pragma unroll
                for (int n = 0; n < 2; ++n) bv[bj][n] = *(const f32x4*)(bias + bj * HALF + 4 * n);
        }
#pragma unroll
        for (int ai = 0; ai < 2; ++ai)
#pragma unroll
            for (int m = 0; m < 4; ++m) {
                const int row = row0 + ai * HALF + m * 16;
                bf16_t* rowp = base + (size_t)row * ldc;
                f32x4 r0, r1;
                if (KIND == 1) { const float* rp = rope + (size_t)row * 128 + cb; r0 = *(const f32x4*)rp; r1 = *(const f32x4*)(rp + 4); }
#pragma unroll
                for (int bj = 0; bj < 2; ++bj) {
                    f32x4 v0 = acc[ai][bj][m][0], v1 = acc[ai][bj][m][1];
                    if (KIND == 0) {
#pragma unroll
                        for (int j = 0; j < 4; ++j) { v0[j] = gelu_tanh(v0[j]); v1[j] = gelu_tanh(v1[j]); }
                    } else if (KIND == 1) {
                        f32x4 a0, a1;
                        a0[0] = v0[0] * r0[0] - v0[1] * r0[1]; a0[1] = v0[1] * r0[0] + v0[0] * r0[1];
                        a0[2] = v0[2] * r0[2] - v0[3] * r0[3]; a0[3] = v0[3] * r0[2] + v0[2] * r0[3];
                        a1[0] = v1[0] * r1[0] - v1[1] * r1[1]; a1[1] = v1[1] * r1[0] + v1[0] * r1[1];
                        a1[2] = v1[2] * r1[2] - v1[3] * r1[3]; a1[3] = v1[3] * r1[2] + v1[2] * r1[3];
                        v0 = a0 * sc; v1 = a1 * sc;
                    } else if (KIND == 2) { v0 = v0 * sc; v1 = v1 * sc;
                    } else if (KIND == 3) {
                        v0 = v0 + bv[bj][0]; v1 = v1 + bv[bj][1];
#pragma unroll
                        for (int j = 0; j < 4; ++j) { v0[j] = sigmoid_f(v0[j]); v1[j] = sigmoid_f(v1[j]); }
                    }
                    if (KIND == 3) { typedef unsigned u32x2 __attribute__((ext_vector_type(2))); u32x2 w8; w8.x = pk4_fp8(v0[0], v0[1], v0[2], v0[3]); w8.y = pk4_fp8(v1[0], v1[1], v1[2], v1[3]);
                        __builtin_nontemporal_store(w8, (u32x2*)((unsigned char*)base + (size_t)row * ldc + bj * HALF)); }
                    else __builtin_nontemporal_store(pack8(v0, v1), (u32x4*)(rowp + bj * HALF));
                }
            }
    }
    __device__ __forceinline__ void operator()(const f32x4 (&acc)[2][2][4][2], const Unit& u, int wr, int wc, int fr, int fq) const {
        int row0 = u.pm * BM + wr * 64 + fr, cw = wc * 32 + 8 * fq;
        asm volatile("" : "+v"(row0), "+v"(cw));
        if (u.pm >= 32) { tile<2>(acc, mkv + (u.pn - 82) * BM + cw, 2048, row0 - 8192, 0, 1.0f, nullptr); }
        else if (u.pn < 12) { tile<0>(acc, proj + u.pn * BM + cw, 8704, row0, 0, 1.0f, nullptr); }
        else if (u.pn < 24) { tile<1>(acc, proj + u.pn * BM + cw, 8704, row0, cw, u.pn < 18 ? 0.08838834764831845f : 1.0f, nullptr); }
        else if (u.pn < 34) { tile<2>(acc, proj + u.pn * BM + cw, 8704, row0, 0, u.pn >= 30 ? 0.0625f : 1.0f, nullptr); }
        else { const int cg = (u.pn - 34) * BM + cw; tile<3>(acc, (bf16_t*)((unsigned char*)gates + cg), 12288, row0, 0, 1.0f, bgate + cg); }
    }
};
struct EpiGate {
    static constexpr bool PERM = true, AFTER_DRAIN = false, MIDK = false; static constexpr int T1 = -1, T2 = -1;
    EpiProj P;
    __device__ __forceinline__ void operator()(const f32x4 (&acc)[2][2][4][2], const Unit& u, int wr, int wc, int fr, int fq) const { Unit v = u; v.pn = u.pn + 34; P(acc, v, wr, wc, fr, fq); }
};

template <int STEP> struct EpiMerge {
    static constexpr bool PERM = true, AFTER_DRAIN = false, MIDK = false; static constexpr int T1 = -1, T2 = -1;
    const unsigned char* gates; bf16_t* merged; bf16_t* mergedb;
    __device__ __forceinline__ void operator()(const f32x4 (&acc)[2][2][4][2], const Unit& u, int wr, int wc, int fr, int fq) const {
        typedef unsigned u32x2 __attribute__((ext_vector_type(2))); typedef float f32x2e __attribute__((ext_vector_type(2)));
        const int row0 = u.pm * BM + wr * 64 + fr, col0 = u.pn * BM + wc * 32 + 8 * fq;
#pragma unroll
        for (int ai = 0; ai < 2; ++ai)
#pragma unroll
            for (int m = 0; m < 4; ++m) {
                const size_t row = (size_t)(row0 + ai * HALF + m * 16);
#pragma unroll
                for (int bj = 0; bj < 2; ++bj) {
                    const int col = col0 + bj * HALF;
                    const u32x2 g = *(const u32x2*)(gates + row * 12288 + col);
                    const f32x2e g0 = __builtin_amdgcn_cvt_pk_f32_fp8((int)g.x, false), g1 = __builtin_amdgcn_cvt_pk_f32_fp8((int)g.x, true), g2 = __builtin_amdgcn_cvt_pk_f32_fp8((int)g.y, false), g3 = __builtin_amdgcn_cvt_pk_f32_fp8((int)g.y, true);
                    f32x4 v0 = acc[ai][bj][m][0], v1 = acc[ai][bj][m][1];
                    if (!((DBG_BR >> STEP) & 1)) { v0 = v0 * 0.f; v1 = v1 * 0.f; }
                    v0[0] *= g0.x; v0[1] *= g0.y; v0[2] *= g1.x; v0[3] *= g1.y; v1[0] *= g2.x; v1[1] *= g2.y; v1[2] *= g3.x; v1[3] *= g3.y;
                    bf16_t* mp = merged + row * 4096 + col;
                    if (STEP > 0) { const u32x4 pm = *(const u32x4*)mp; v0[0] += bf_lo(pm.x); v0[1] += bf_hi(pm.x); v0[2] += bf_lo(pm.y); v0[3] += bf_hi(pm.y); v1[0] += bf_lo(pm.z); v1[1] += bf_hi(pm.z); v1[2] += bf_lo(pm.w); v1[3] += bf_hi(pm.w); }
                    if (STEP < 2) *(u32x4*)mp = pack8(v0, v1);
                    else { v0 = v0 * 8.0f; v1 = v1 * 8.0f; u32x2 w8; w8.x = pk4_fp8(v0[0], v0[1], v0[2], v0[3]); w8.y = pk4_fp8(v1[0], v1[1], v1[2], v1[3]);
                        *(u32x2*)((unsigned char*)mergedb + row * 4096 + col) = w8; }
                }
            }
    }
};

struct EpiMerge3 {
    static constexpr bool PERM = true, AFTER_DRAIN = false, MIDK = true; static constexpr int T1 = 12, T2 = 16;
    const unsigned char* gates; bf16_t* mergedb;
    typedef unsigned u32x2 __attribute__((ext_vector_type(2))); typedef float f32x2e __attribute__((ext_vector_type(2)));
    static __device__ __forceinline__ void gate8(const unsigned char* p, f32x4& a, f32x4& b) {
        const u32x2 g = *(const u32x2*)p;
        const f32x2e g0 = __builtin_amdgcn_cvt_pk_f32_fp8((int)g.x, false), g1 = __builtin_amdgcn_cvt_pk_f32_fp8((int)g.x, true), g2 = __builtin_amdgcn_cvt_pk_f32_fp8((int)g.y, false), g3 = __builtin_amdgcn_cvt_pk_f32_fp8((int)g.y, true);
        a = (f32x4){fmaxf(g0.x, 0.001953125f), fmaxf(g0.y, 0.001953125f), fmaxf(g1.x, 0.001953125f), fmaxf(g1.y, 0.001953125f)};
        b = (f32x4){fmaxf(g2.x, 0.001953125f), fmaxf(g2.y, 0.001953125f), fmaxf(g3.x, 0.001953125f), fmaxf(g3.y, 0.001953125f)};
    }
    static __device__ __forceinline__ void gate8w(const u32x2 g, f32x4& a, f32x4& b) {
        const f32x2e g0 = __builtin_amdgcn_cvt_pk_f32_fp8((int)g.x, false), g1 = __builtin_amdgcn_cvt_pk_f32_fp8((int)g.x, true), g2 = __builtin_amdgcn_cvt_pk_f32_fp8((int)g.y, false), g3 = __builtin_amdgcn_cvt_pk_f32_fp8((int)g.y, true);
        a = (f32x4){fmaxf(g0.x, 0.001953125f), fmaxf(g0.y, 0.001953125f), fmaxf(g1.x, 0.001953125f), fmaxf(g1.y, 0.001953125f)};
        b = (f32x4){fmaxf(g2.x, 0.001953125f), fmaxf(g2.y, 0.001953125f), fmaxf(g3.x, 0.001953125f), fmaxf(g3.y, 0.001953125f)};
    }
    __device__ __forceinline__ void midk(f32x4 (&acc)[2][2][4][2], const Unit& u, int t, int wr, int wc, int fr, int fq) const {
        int row0 = u.pm * BM + wr * 64 + fr, col0 = u.pn * BM + wc * 32 + 8 * fq; const int b = (t == T1) ? 0 : 1;
        asm volatile("" : "+v"(row0), "+v"(col0));
#pragma unroll
        for (int ai = 0; ai < 2; ++ai) {
            u32x2 gn[4][2], gd[4][2];
#pragma unroll
            for (int m = 0; m < 4; ++m)
#pragma unroll
                for (int bj = 0; bj < 2; ++bj) {
                    const unsigned char* gp = gates + (size_t)(row0 + ai * HALF + m * 16) * 12288 + b * 4096 + col0 + bj * HALF;
                    gn[m][bj] = *(const u32x2*)gp; gd[m][bj] = *(const u32x2*)(gp + 4096);
                }
            __builtin_amdgcn_sched_barrier(0);
#pragma unroll
            for (int m = 0; m < 4; ++m)
#pragma unroll
                for (int bj = 0; bj < 2; ++bj) {
                    f32x4 n0, n1, d0, d1; gate8w(gn[m][bj], n0, n1); gate8w(gd[m][bj], d0, d1);
#pragma unroll
                    for (int j = 0; j < 4; ++j) { acc[ai][bj][m][0][j] *= n0[j] * __builtin_amdgcn_rcpf(d0[j]); acc[ai][bj][m][1][j] *= n1[j] * __builtin_amdgcn_rcpf(d1[j]); }
                }
            __builtin_amdgcn_sched_barrier(0);
        }
    }
    __device__ __forceinline__ void operator()(const f32x4 (&acc)[2][2][4][2], const Unit& u, int wr, int wc, int fr, int fq) const {
        int row0 = u.pm * BM + wr * 64 + fr, col0 = u.pn * BM + wc * 32 + 8 * fq;
        asm volatile("" : "+v"(row0), "+v"(col0));
#pragma unroll
        for (int ai = 0; ai < 2; ++ai) {
            u32x2 gw[4][2];
#pragma unroll
            for (int m = 0; m < 4; ++m)
#pragma unroll
                for (int bj = 0; bj < 2; ++bj) gw[m][bj] = *(const u32x2*)(gates + (size_t)(row0 + ai * HALF + m * 16) * 12288 + 8192 + col0 + bj * HALF);
            __builtin_amdgcn_sched_barrier(0);
#pragma unroll
            for (int m = 0; m < 4; ++m) {
                const size_t row = (size_t)(row0 + ai * HALF + m * 16);
#pragma unroll
                for (int bj = 0; bj < 2; ++bj) {
                    const int col = col0 + bj * HALF;
                    f32x4 g0, g1; gate8w(gw[m][bj], g0, g1);
                    const f32x4 v0 = acc[ai][bj][m][0] * g0 * 8.0f, v1 = acc[ai][bj][m][1] * g1 * 8.0f;
                    u32x2 w8; w8.x = pk4_fp8(v0[0], v0[1], v0[2], v0[3]); w8.y = pk4_fp8(v1[0], v1[1], v1[2], v1[3]);
                    *(u32x2*)((unsigned char*)mergedb + row * 4096 + col) = w8;
                }
            }
            __builtin_amdgcn_sched_barrier(0);
        }
    }
};

struct EpiResid {
    static constexpr bool PERM = true, AFTER_DRAIN = false, MIDK = false; static constexpr int T1 = -1, T2 = -1;
    const float* x; bf16_t* z; float alpha;
    __device__ __forceinline__ void operator()(const f32x4 (&acc)[2][2][4][2], const Unit& u, int wr, int wc, int fr, int fq) const {
        int row0 = u.pm * BM + wr * 64 + fr, col0 = u.pn * BM + wc * 32 + 8 * fq;
        asm volatile("" : "+v"(row0), "+v"(col0));
#pragma unroll
        for (int ai = 0; ai < 2; ++ai)
#pragma unroll
            for (int mh = 0; mh < 2; ++mh) {
                f32x4 xv[2][2][2];
#pragma unroll
                for (int mm = 0; mm < 2; ++mm)
#pragma unroll
                    for (int bj = 0; bj < 2; ++bj) {
                        const size_t o = (size_t)(row0 + ai * HALF + (2 * mh + mm) * 16) * 4096 + col0 + bj * HALF;
                        xv[mm][bj][0] = __builtin_nontemporal_load((const f32x4*)(x + o)); xv[mm][bj][1] = __builtin_nontemporal_load((const f32x4*)(x + o + 4));
                    }
                __builtin_amdgcn_sched_barrier(0);
#pragma unroll
                for (int mm = 0; mm < 2; ++mm)
#pragma unroll
                    for (int bj = 0; bj < 2; ++bj) {
                        const int m = 2 * mh + mm;
                        const size_t o = (size_t)(row0 + ai * HALF + m * 16) * 4096 + col0 + bj * HALF;
                        *(u32x4*)(z + o) = pack8(xv[mm][bj][0] * alpha + acc[ai][bj][m][0] * DBG_MIXSCALE, xv[mm][bj][1] * alpha + acc[ai][bj][m][1] * DBG_MIXSCALE);
                    }
                __builtin_amdgcn_sched_barrier(0);
            }
    }
};

struct EpiPlain {
    static constexpr bool PERM = true, AFTER_DRAIN = false, MIDK = false; static constexpr int T1 = -1, T2 = -1;
    bf16_t* O; int ldc;
    __device__ __forceinline__ void operator()(const f32x4 (&acc)[2][2][4][2], const Unit& u, int wr, int wc, int fr, int fq) const {
        const int row0 = u.pm * BM + wr * 64 + fr, col0 = u.pn * BM + wc * 32 + 8 * fq;
#pragma unroll
        for (int ai = 0; ai < 2; ++ai)
#pragma unroll
            for (int m = 0; m < 4; ++m) {
                bf16_t* rowp = O + (size_t)(row0 + ai * HALF + m * 16) * ldc + col0;
#pragma unroll
                for (int bj = 0; bj < 2; ++bj) *(u32x4*)(rowp + bj * HALF) = pack8(acc[ai][bj][m][0], acc[ai][bj][m][1]);
            }
    }
};

struct SchedP1 {
    StaticOrder so;
    __host__ __device__ void init(int G_, int c_) { so.init(8192, 34 * 256, G_, c_); }
    __host__ __device__ bool next(int i, Unit& u) const {
        if (so.next(i, u)) return true;
        const long L = (long)i * so.G + so.c - so.nwg; if (L < 0 || L >= 16) return false;
        u.pm = 32 + (int)(L >> 3); u.pn = 82 + (int)(L & 7); return true;
    }
    __device__ __forceinline__ void a_ready(const Unit&) const {}
    __device__ __forceinline__ void done(const Unit&) const {}
};

typedef int i32x8 __attribute__((ext_vector_type(8)));
typedef int i32x4v __attribute__((ext_vector_type(4)));
__device__ __forceinline__ i32x8 cat8(const bf16x8& lo, const bf16x8& hi) { return __builtin_shufflevector(__builtin_bit_cast(i32x4v, lo), __builtin_bit_cast(i32x4v, hi), 0, 1, 2, 3, 4, 5, 6, 7); }
template <class Epi, class Sched, bool ALIGN_EPI = false, bool SP2 = false, int FP8 = 0>
__device__ __forceinline__ void gemm_phase(PG8_LAS unsigned char* lds, const Gemm g, const Sched& S, const Epi& E) {
    const int tid = threadIdx.x, wid = __builtin_amdgcn_readfirstlane(tid >> 6), lane = tid & 63, wr = wid >> 2, wc = wid & 3, fr = lane & 15, fq = lane >> 4;
    const int K = g.ld ? g.ld : g.K, nt = g.K / BK;
    unsigned voffA[2], voffB[2];
#pragma unroll
    for (int i = 0; i < 2; ++i) { int R, C; stage_rc(tid * 16 + i * 8192, R, C); const int Rb = Epi::PERM ? ((R & ~31) + perm32(R & 31)) : R;
        voffA[i] = (unsigned)(R * K + C) * 2u; voffB[i] = (unsigned)(Rb * K + C) * 2u; }
    const size_t kstep = (size_t)(BK * 2);
    const size_t hstep = (size_t)HALF * K * 2;
    const size_t tstep = 2 * hstep;
    const unsigned ldsw = (unsigned)wid * 1024u;
    const int aoff = lds_byte(wr * 64 + fr, fq * 8), boff = lds_byte(wc * 32 + fr, fq * 8);
#define PG8_SA(b, h) (((b) * 2 + (h)) * HTB)
#define PG8_SB(b, h) ((4 + (b) * 2 + (h)) * HTB)
#define PG8_STAGE(bufoff, gbase, voff) do { _Pragma("unroll") for (int _i = 0; _i < 2; ++_i) \
        __builtin_amdgcn_global_load_lds((const unsigned*)((const char*)(gbase) + (voff)[_i]), (PG8_LAS unsigned*)(lds + (bufoff) + ldsw + _i * 8192), 16, 0, 0); } while (0)
#define PG8_LDA(dst, b, h) do { _Pragma("unroll") for (int m = 0; m < 4; ++m) _Pragma("unroll") for (int k = 0; k < 2; ++k) dst[m][k] = *(const PG8_LAS bf16x8*)(lds + PG8_SA(b, h) + aoff + m * 2048 + k * 1024); } while (0)
#define PG8_LDB(dst, b, h) do { _Pragma("unroll") for (int n = 0; n < 2; ++n) _Pragma("unroll") for (int k = 0; k < 2; ++k) dst[n][k] = *(const PG8_LAS bf16x8*)(lds + PG8_SB(b, h) + boff + n * 2048 + k * 1024); } while (0)
#define PG8_MMA(ai, bj, At, Bt) do { __builtin_amdgcn_s_setprio(1); \
        if constexpr (FP8 == 2) { _Pragma("unroll") for (int k = 0; k < 2; ++k) _Pragma("unroll") for (int m = 0; m < 4; ++m) _Pragma("unroll") for (int n = 0; n < 2; ++n) \
            asm volatile("v_mfma_scale_f32_16x16x128_f8f6f4 %0, %1, %2, %0, %3, %4 op_sel_hi:[0,0,0] cbsz:4 blgp:4" : "+v"(acc[ai][bj][m][n]) : "v"(Bt[n][k]), "v"(At[m][k]), "v"(sclB), "v"(sclA)); } \
        else if constexpr (FP8 == 1) { _Pragma("unroll") for (int m = 0; m < (DBG_HALFMMA ? 2 : 4); ++m) _Pragma("unroll") for (int n = 0; n < 2; ++n) \
            asm volatile("v_mfma_scale_f32_16x16x128_f8f6f4 %0, %1, %2, %0, %3, %4 op_sel_hi:[0,0,0]" : "+v"(acc[ai][bj][m][n]) : "v"(cat8(Bt[n][0], Bt[n][1])), "v"(cat8(At[m][0], At[m][1])), "v"(sclB), "v"(sclA)); } \
        else { _Pragma("unroll") for (int m = 0; m < 4; ++m) _Pragma("unroll") for (int n = 0; n < 2; ++n) _Pragma("unroll") for (int k = 0; k < 2; ++k) \
            acc[ai][bj][m][n] = __builtin_amdgcn_mfma_f32_16x16x32_bf16(Bt[n][k], At[m][k], acc[ai][bj][m][n], 0, 0, 0); } \
        __builtin_amdgcn_s_setprio(0); } while (0)
#define PG8_WAIT_V(n) asm volatile("s_waitcnt vmcnt(" #n ")" ::: "memory")
#define PG8_WAIT_L(n) asm volatile("s_waitcnt lgkmcnt(" #n ")" ::: "memory")
#define PG8_BAR __builtin_amdgcn_s_barrier()
#define PG8_SCHED __builtin_amdgcn_sched_barrier(0)
    Unit cur, nxt; int ui = 0;
    if (!S.next(0, cur)) return;
    int sclA = g.sA, sclB = g.sB;
    if constexpr (FP8) asm volatile("" : "+v"(sclA), "+v"(sclB));
    f32x4 acc[2][2][4][2];
#pragma unroll
    for (int a = 0; a < 2; ++a)
#pragma unroll
        for (int b = 0; b < 2; ++b)
#pragma unroll
            for (int m = 0; m < 4; ++m)
#pragma unroll
                for (int n = 0; n < 2; ++n) acc[a][b][m][n] = (f32x4){0.f, 0.f, 0.f, 0.f};
    bf16x8 At[4][2], B0[2][2], B1[2][2];
    const char* cA = (const char*)g.A + (size_t)cur.pm * tstep; const char* cB = (const char*)g.Bt + (size_t)cur.pn * tstep;
    S.a_ready(cur);
    if constexpr (SP2) {
        PG8_STAGE(PG8_SB(0, 0), cB, voffB); PG8_STAGE(PG8_SB(0, 1), cB + hstep, voffB); PG8_STAGE(PG8_SA(0, 0), cA, voffA); PG8_STAGE(PG8_SA(0, 1), cA + hstep, voffA);
        if (wr == 1) PG8_BAR;
        PG8_WAIT_V(2); PG8_BAR;
        PG8_STAGE(PG8_SB(1, 0), cB + kstep, voffB); PG8_STAGE(PG8_SA(1, 0), cA + kstep, voffA); PG8_STAGE(PG8_SB(1, 1), cB + hstep + kstep, voffB);
        PG8_WAIT_V(6); PG8_BAR;
    } else {
        PG8_STAGE(PG8_SB(0, 0), cB, voffB); PG8_STAGE(PG8_SA(0, 0), cA, voffA); PG8_STAGE(PG8_SB(0, 1), cB + hstep, voffB); PG8_STAGE(PG8_SA(0, 1), cA + hstep, voffA);
        if (wr == 1) PG8_BAR;
        PG8_WAIT_V(4); PG8_BAR;
        PG8_STAGE(PG8_SB(1, 0), cB + kstep, voffB); PG8_STAGE(PG8_SA(1, 0), cA + kstep, voffA); PG8_STAGE(PG8_SB(1, 1), cB + hstep + kstep, voffB);
        PG8_WAIT_V(6); PG8_BAR;
    }
    for (;;) {
        const bool has_next = S.next(ui + 1, nxt);
        const char* nA = has_next ? (const char*)g.A + (size_t)nxt.pm * tstep : cA; const char* nB = has_next ? (const char*)g.Bt + (size_t)nxt.pn * tstep : cB;
        for (int t = 0; t < nt; t += 2) {
            const bool last = (t == nt - 2);
            const char* a1 = cA + (size_t)(t + 1) * kstep;
            const char* a2 = last ? nA : cA + (size_t)(t + 2) * kstep; const char* b2 = last ? nB : cB + (size_t)(t + 2) * kstep;
            const char* a3 = a2 + kstep; const char* b3 = b2 + kstep;
            if (last && has_next) S.a_ready(nxt);
            if constexpr (Epi::MIDK) { if (t == Epi::T1 || t == Epi::T2) { if constexpr (FP8) asm volatile("s_nop 15\n\ts_nop 15" ::: "memory"); E.midk(acc, cur, t, wr, wc, fr, fq); } }
            if constexpr (SP2) {
            PG8_LDB(B0, 0, 0); PG8_LDB(B1, 0, 1); PG8_SCHED; PG8_LDA(At, 0, 0); PG8_STAGE(PG8_SA(1, 1), a1 + hstep, voffA);
            PG8_WAIT_V(8); PG8_WAIT_L(0); PG8_BAR; PG8_MMA(0, 0, At, B0); PG8_MMA(0, 1, At, B1); PG8_BAR; PG8_SCHED;
            PG8_LDA(At, 0, 1); PG8_STAGE(PG8_SB(0, 0), b2, voffB); PG8_STAGE(PG8_SB(0, 1), b2 + hstep, voffB); PG8_STAGE(PG8_SA(0, 0), a2, voffA);
            PG8_WAIT_V(8); PG8_WAIT_L(0); PG8_BAR; PG8_MMA(1, 0, At, B0); PG8_MMA(1, 1, At, B1); PG8_BAR; PG8_SCHED;
            PG8_LDB(B0, 1, 0); PG8_LDB(B1, 1, 1); PG8_SCHED; PG8_LDA(At, 1, 0); PG8_STAGE(PG8_SA(0, 1), a2 + hstep, voffA);
            PG8_WAIT_V(8); PG8_WAIT_L(0); PG8_BAR; PG8_MMA(0, 0, At, B0); PG8_MMA(0, 1, At, B1); PG8_BAR; PG8_SCHED;
            PG8_LDA(At, 1, 1); PG8_STAGE(PG8_SB(1, 0), b3, voffB); PG8_STAGE(PG8_SB(1, 1), b3 + hstep, voffB); PG8_STAGE(PG8_SA(1, 0), a3, voffA);
            PG8_WAIT_V(8); PG8_WAIT_L(0); PG8_BAR; PG8_MMA(1, 0, At, B0); PG8_MMA(1, 1, At, B1); PG8_BAR; PG8_SCHED;
            } else {
            PG8_LDB(B0, 0, 0); PG8_SCHED; PG8_LDA(At, 0, 0); PG8_STAGE(PG8_SA(1, 1), a1 + hstep, voffA);
            PG8_WAIT_L(8); PG8_BAR; PG8_WAIT_L(0); PG8_MMA(0, 0, At, B0); PG8_BAR; PG8_SCHED;
            PG8_LDB(B1, 0, 1); PG8_STAGE(PG8_SB(0, 0), b2, voffB);
            PG8_BAR; PG8_WAIT_L(0); PG8_MMA(0, 1, At, B1); PG8_BAR;
            PG8_LDA(At, 0, 1); PG8_STAGE(PG8_SA(0, 0), a2, voffA);
            PG8_BAR; PG8_WAIT_L(0); PG8_MMA(1, 0, At, B0); PG8_BAR; PG8_SCHED;
            PG8_STAGE(PG8_SB(0, 1), b2 + hstep, voffB);
            PG8_WAIT_V(6); PG8_BAR; PG8_MMA(1, 1, At, B1); PG8_BAR;
            PG8_LDB(B0, 1, 0); PG8_SCHED; PG8_LDA(At, 1, 0); PG8_STAGE(PG8_SA(0, 1), a2 + hstep, voffA);
            PG8_WAIT_L(8); PG8_BAR; PG8_WAIT_L(0); PG8_MMA(0, 0, At, B0); PG8_BAR; PG8_SCHED;
            PG8_LDB(B1, 1, 1); PG8_STAGE(PG8_SB(1, 0), b3, voffB);
            PG8_BAR; PG8_WAIT_L(0); PG8_MMA(0, 1, At, B1); PG8_BAR;
            PG8_LDA(At, 1, 1); PG8_STAGE(PG8_SA(1, 0), a3, voffA);
            PG8_BAR; PG8_WAIT_L(0); PG8_MMA(1, 0, At, B0); PG8_BAR; PG8_SCHED;
            PG8_STAGE(PG8_SB(1, 1), b3 + hstep, voffB);
            PG8_WAIT_V(6); PG8_BAR; PG8_MMA(1, 1, At, B1); PG8_BAR;
            }
        }
        if constexpr (ALIGN_EPI) { if (wr == 0) PG8_BAR; }
        if constexpr (FP8) asm volatile("s_nop 15\n\ts_nop 15" ::: "memory");
        if constexpr (!Epi::AFTER_DRAIN) { E(acc, cur, wr, wc, fr, fq); S.done(cur); }
        if (!has_next) break;
#pragma unroll
        for (int a = 0; a < 2; ++a)
#pragma unroll
            for (int b = 0; b < 2; ++b)
#pragma unroll
                for (int m = 0; m < 4; ++m)
#pragma unroll
                    for (int n = 0; n < 2; ++n) acc[a][b][m][n] = (f32x4){0.f, 0.f, 0.f, 0.f};
        cur = nxt; cA = nA; cB = nB; ++ui;
        if constexpr (ALIGN_EPI) { if (wr == 1) PG8_BAR; }
    }
    PG8_WAIT_V(0);
    if constexpr (!ALIGN_EPI) { if (wr == 0) PG8_BAR; }
    PG8_BAR;
    if constexpr (Epi::AFTER_DRAIN) { E.fused(acc, cur, wr, wc, fr, fq, lds, wid, lane); S.done(cur); }
#undef PG8_SA
#undef PG8_SB
#undef PG8_STAGE
#undef PG8_LDA
#undef PG8_LDB
#undef PG8_MMA
#undef PG8_WAIT_V
#undef PG8_WAIT_L
#undef PG8_BAR
#undef PG8_SCHED
}
}
#ifndef PG8_SP2
#define PG8_SP2 true
#endif
#ifndef PG8_ALIGN
#define PG8_ALIGN true
#endif
constexpr int NWAVES = 8;
#ifndef MK_N_LAUNCHES
#define MK_N_LAUNCHES 1
#endif
constexpr int N_PHASES = 12;
constexpr int N_LAUNCHES = MK_N_LAUNCHES;

constexpr int BATCH = 2, SEQ = 4096, T = BATCH * SEQ, D = 4096;
constexpr int GMW = 1536, INW = 8704, GATEW = 12288, MEMLEN = 256, MROWS = BATCH * MEMLEN;
constexpr int NALL = INW + GATEW + 2048;
constexpr int MALL = T + MROWS;
constexpr int PEER_E = 16384;
constexpr int ACT_PITCH = 3072;
constexpr int P1_PITCH = D;
constexpr float LN_EPS = 1e-5f;
constexpr float ALPHA = 1.189207115002721f;
constexpr int C_GU = 0, C_GV = 1536, C_DQ = 3072, C_DK = 4608, C_DV = 6144, C_MQ = 7680;

constexpr size_t MiB = 1u << 20;
constexpr size_t WS_CTL = 0, CTL_ZERO_BYTES = 1 * MiB;
constexpr size_t WS_WALL = 1 * MiB;
constexpr size_t WS_XA = 181 * MiB;
constexpr size_t WS_AOUT = 1 * MiB;
constexpr size_t WS_OG = 25 * MiB;
constexpr size_t WS_BOUT = 1 * MiB + 1536;
constexpr size_t WS_MOUT = 1 * MiB + 2048;
constexpr size_t WS_LSE = 73 * MiB;
constexpr size_t WS_MERGEDB = 80 * MiB;
constexpr size_t WS_WBRA = 249 * MiB;
constexpr size_t WS_WBRB = 261 * MiB;
constexpr size_t WS_WBRM = 265 * MiB;
constexpr size_t WS_WOUT = 273 * MiB;
constexpr size_t WS_WQ = 305 * MiB;
constexpr size_t WS_SK = 321 * MiB;
constexpr size_t WS_ROPE = 322 * MiB;
constexpr size_t WS_MKV = 326 * MiB;
constexpr size_t WS_PROJ = 328 * MiB;
constexpr size_t WS_MERGED = 328 * MiB;
constexpr size_t WS_Q = 328 * MiB;
constexpr size_t WS_SELI = 360 * MiB;
constexpr size_t WS_SELG = 364 * MiB;
constexpr size_t WS_GATES = 464 * MiB;
constexpr size_t WS_Z = (DBG_ZALT ? 328 : 464) * MiB;
constexpr size_t WS_H1B = (DBG_ZALT ? 1 : 592) * MiB;
constexpr size_t WS_PU = 656 * MiB;
constexpr size_t WS_PV = 704 * MiB;
constexpr size_t WS_XA4 = 752 * MiB;
constexpr size_t WS_WG4 = 768 * MiB;
constexpr int P1B_PITCH = D / 2;
constexpr size_t WS_END = 792 * MiB;
static_assert(WS_WALL + (size_t)NALL * D * 2 == WS_XA && WS_XA + (size_t)MALL * D * 2 == WS_WBRA, "ws map A");
static_assert(WS_PROJ + (size_t)T * INW * 2 == WS_GATES && WS_GATES + (size_t)T * GATEW * 2 == WS_PU, "ws map B");
static_assert(DBG_ZALT || (WS_Z + (size_t)T * D * 4 == WS_H1B && WS_H1B + (size_t)T * D * 2 == WS_PU), "ws map C");
constexpr int CW_TMO = 0, CW_CODE = 1;
constexpr int CW_ROWS = 16384;
constexpr float PV_SCALE = 3.36f;
constexpr int CW_P11 = 32768, P11_NSH = 16;
constexpr int CW_DONE = 65536;
constexpr size_t WS_YP = 80 * MiB;
constexpr int CW_BAR = 4096;

constexpr int RING_OFF = 0, RING_BYTES = 131072;
constexpr int LDSCTL_OFF = RING_BYTES, MISC_OFF = LDSCTL_OFF + 320;
constexpr int LDS_BYTES = 147456;
static_assert(MISC_OFF + 128 <= LDS_BYTES, "LDS map");

#define GAS __attribute__((address_space(1)))
#define LAS __attribute__((address_space(3)))
typedef unsigned short bf16;
typedef unsigned v4u __attribute__((ext_vector_type(4)));
typedef float f32x4 __attribute__((ext_vector_type(4)));
typedef short bf16x8 __attribute__((ext_vector_type(8)));
typedef GAS unsigned gu32;
typedef GAS unsigned long long gu64;
#define RLX_AGENT __ATOMIC_RELAXED, __HIP_MEMORY_SCOPE_AGENT
#define LDS_WAIT() asm volatile("s_waitcnt lgkmcnt(0)" ::: "memory")
#define VM_WAIT() asm volatile("s_waitcnt vmcnt(0)" ::: "memory")
__device__ __forceinline__ unsigned long long rt() { return __builtin_amdgcn_s_memrealtime(); }
__device__ __forceinline__ unsigned f2bf(float f) { unsigned u = __builtin_bit_cast(unsigned, f); return (u + 0x7fffu + ((u >> 16) & 1u)) >> 16; }
__device__ __forceinline__ unsigned pk2(float lo, float hi) { return f2bf(lo) | (f2bf(hi) << 16); }

#define XB_TMO      128
#define XB_XCNT(j)  (256  + 64 * (j))
#define XB_XSUB(j)  (1280 + 64 * (j))
#define XB_XGEN(j)  (2304 + 64 * (j))
#define XB_TOP      3328
#define XB_TOPGEN   3392
#define XCD_BAR_WORDS 3456
#define XB_SPIN_CAP (1u << 18)

__device__ __forceinline__ unsigned xb_ld(unsigned* p)              { return __hip_atomic_load(p, __ATOMIC_RELAXED, __HIP_MEMORY_SCOPE_AGENT); }
__device__ __forceinline__ unsigned xb_add(unsigned* p, unsigned v) { return __hip_atomic_fetch_add(p, v, __ATOMIC_RELAXED, __HIP_MEMORY_SCOPE_AGENT); }
__device__ __forceinline__ unsigned xb_xcc_id() { return (unsigned)__builtin_amdgcn_s_getreg((3 << 11) | 20) & 0xFu; }
#define XB_SPIN(cond, bar) do { unsigned _sp = 0; while (cond) { __builtin_amdgcn_s_sleep(1); \
    if ((++_sp & 255u) == 0u) { if (xb_ld(&(bar)[XB_TMO])) break; if (_sp > XB_SPIN_CAP) { atomicAdd(&(bar)[XB_TMO], 1u); break; } } } } while (0)

struct XcdBarrier {
    unsigned* bar; unsigned x;
    volatile LAS unsigned* st;
};

__device__ __forceinline__ XcdBarrier xcd_barrier_post(unsigned* bar, volatile LAS unsigned* st) {
    XcdBarrier b; b.bar = bar; b.x = xb_xcc_id(); b.st = st;
    if (threadIdx.x == 0) (void)xb_add(&bar[XB_XCNT(b.x)], 1u);
    return b;
}
__device__ __forceinline__ void xcd_barrier_complete(unsigned* bar, unsigned x, unsigned& nloc, unsigned& nx) {
    const unsigned G = gridDim.x * gridDim.y * gridDim.z;
    unsigned sum, cnt, mine, sp = 0u;
    for (;;) {
        sum = 0u; cnt = 0u; mine = 0u;
#pragma unroll
        for (unsigned j = 0; j < 16; ++j) { const unsigned c = xb_ld(&bar[XB_XCNT(j)]); sum += c; cnt += (c > 0u) ? 1u : 0u; mine = (j == x) ? c : mine; }
        if (sum == G) break;
        __builtin_amdgcn_s_sleep(1);
        if ((++sp & 255u) == 0u) { if (xb_ld(&bar[XB_TMO])) break; if (sp > XB_SPIN_CAP) { atomicAdd(&bar[XB_TMO], 1u); break; } }
    }
    nloc = mine > 0u ? mine : 1u; nx = cnt > 0u ? cnt : 1u;
}

__device__ __forceinline__ void xcd_barrier(const XcdBarrier& b) {
    asm volatile("s_waitcnt vmcnt(0)" ::: "memory");
    __syncthreads();
    if (threadIdx.x == 0) {
        unsigned* bar = b.bar;
        __builtin_amdgcn_s_waitcnt(0);
        unsigned nloc = b.st[0], nx = b.st[1];
        if (nloc == 0u) { xcd_barrier_complete(bar, b.x, nloc, nx); b.st[0] = nloc; b.st[1] = nx; }
        const unsigned old = xb_add(&bar[XB_XSUB(b.x)], 1u);
        const unsigned gen = old / nloc;
        if (old + 1u == (gen + 1u) * nloc) {
            __builtin_amdgcn_fence(__ATOMIC_RELEASE, "agent");
            asm volatile("s_waitcnt vmcnt(0)" ::: "memory");
            const unsigned og = xb_add(&bar[XB_TOP], 1u);
            const unsigned tg = og / nx;
            if (og + 1u == (tg + 1u) * nx) xb_add(&bar[XB_TOPGEN], 1u);
            else XB_SPIN(xb_ld(&bar[XB_TOPGEN]) == tg, bar);
            __builtin_amdgcn_fence(__ATOMIC_ACQUIRE, "agent");
            xb_add(&bar[XB_XGEN(b.x)], 1u);
            asm volatile("s_waitcnt vmcnt(0)" ::: "memory");
        } else {
            XB_SPIN(xb_ld(&bar[XB_XGEN(b.x)]) == gen, bar);
            __builtin_amdgcn_fence(__ATOMIC_ACQUIRE, "agent");
            asm volatile("s_waitcnt vmcnt(0)" ::: "memory");
        }
    }
    __syncthreads();
}

struct Frame {
    LAS unsigned char* lds;
    volatile LAS unsigned* MISC;
    gu32* ctl;
    int tid, lane, wave;
    int vcu, G;
    const float* in[23];
    float* out;
    unsigned char* ws;
};
enum { I_X = 0, I_MEM, I_POS, I_WIN, I_GLNG, I_GLNB, I_GWS, I_GBS, I_WMKV, I_WGATE, I_BGATE, I_WBRA, I_WBRB, I_WBRM, I_WOUT, I_LNMG, I_LNMB, I_WQ, I_SK, I_PU, I_PV, I_LNFG, I_LNFB };

__device__ __forceinline__ float wave_sum(float v) {
#pragma unroll
    for (int o = 1; o < 64; o <<= 1) v += __shfl_xor(v, o);
    return v;
}
__device__ __forceinline__ float wave_max(float v) {
#pragma unroll
    for (int o = 1; o < 64; o <<= 1) v = fmaxf(v, __shfl_xor(v, o));
    return v;
}

typedef unsigned v2u __attribute__((ext_vector_type(2)));
#define DPP_QX1 0xB1
#define DPP_QX2 0x4E
#define DPP_RHM 0x141
#define DPP_RM  0x140
__device__ __forceinline__ unsigned row_max_u32(unsigned k) {
    k = max(k, (unsigned)__builtin_amdgcn_update_dpp(0, (int)k, DPP_QX1, 0xF, 0xF, false));
    k = max(k, (unsigned)__builtin_amdgcn_update_dpp(0, (int)k, DPP_QX2, 0xF, 0xF, false));
    k = max(k, (unsigned)__builtin_amdgcn_update_dpp(0, (int)k, DPP_RHM, 0xF, 0xF, false));
    k = max(k, (unsigned)__builtin_amdgcn_update_dpp(0, (int)k, DPP_RM, 0xF, 0xF, false));
    return k;
}
__device__ __forceinline__ float row_sum_f32(float v) {
    v += __builtin_bit_cast(float, __builtin_amdgcn_update_dpp(0, __builtin_bit_cast(int, v), DPP_QX1, 0xF, 0xF, false));
    v += __builtin_bit_cast(float, __builtin_amdgcn_update_dpp(0, __builtin_bit_cast(int, v), DPP_QX2, 0xF, 0xF, false));
    v += __builtin_bit_cast(float, __builtin_amdgcn_update_dpp(0, __builtin_bit_cast(int, v), DPP_RHM, 0xF, 0xF, false));
    v += __builtin_bit_cast(float, __builtin_amdgcn_update_dpp(0, __builtin_bit_cast(int, v), DPP_RM, 0xF, 0xF, false));
    return v;
}
__device__ __forceinline__ float wave_sum_dpp(float v) {
    v = row_sum_f32(v);
    const float a = __builtin_bit_cast(float, __builtin_amdgcn_readlane(__builtin_bit_cast(int, v), 0)), b = __builtin_bit_cast(float, __builtin_amdgcn_readlane(__builtin_bit_cast(int, v), 16));
    const float c = __builtin_bit_cast(float, __builtin_amdgcn_readlane(__builtin_bit_cast(int, v), 32)), d = __builtin_bit_cast(float, __builtin_amdgcn_readlane(__builtin_bit_cast(int, v), 48));
    return (a + b) + (c + d);
}
using pg8::pk4_fp8;
template <bool ROT, int FP8 = 0>
__device__ __forceinline__ void p0_transpose_finish(const float (&tv)[32], int K, bf16* WT, int row_off, LAS float* scr, int k0, int n0, int lane, int pitch = 0) {
    if (pitch == 0) pitch = K;
#pragma unroll
    for (int i = 0; i < 32; ++i) scr[(2 * i + (lane >> 5)) * 33 + (lane & 31)] = tv[i];
    LDS_WAIT(); asm volatile("" ::: "memory");
    const int c = lane & 7;
#pragma unroll
    for (int j = 0; j < 4; ++j) { const int n = (lane >> 3) + 8 * j; const LAS float* s = scr + (8 * c) * 33 + n;
        int nn = n0 + n;
        if (ROT && nn >= C_DQ && nn < C_DV) { const int hb = nn & ~127, d = nn & 127; nn = hb + ((d & 63) << 1) + (d >> 6); }
        if (FP8 == 2) { unsigned q = 0u;
            q = __builtin_amdgcn_cvt_scalef32_pk_fp4_f32(q, s[0 * 33] * 128.f, s[1 * 33] * 128.f, 1.0f, 0); q = __builtin_amdgcn_cvt_scalef32_pk_fp4_f32(q, s[2 * 33] * 128.f, s[3 * 33] * 128.f, 1.0f, 1);
            q = __builtin_amdgcn_cvt_scalef32_pk_fp4_f32(q, s[4 * 33] * 128.f, s[5 * 33] * 128.f, 1.0f, 2); q = __builtin_amdgcn_cvt_scalef32_pk_fp4_f32(q, s[6 * 33] * 128.f, s[7 * 33] * 128.f, 1.0f, 3);
            *(GAS unsigned*)((unsigned char*)WT + (size_t)(row_off + nn) * pitch + (k0 + 8 * c) / 2) = q; }
        else if (FP8 == 1) { v2u o8; o8.x = pk4_fp8(s[0 * 33] * 64.f, s[1 * 33] * 64.f, s[2 * 33] * 64.f, s[3 * 33] * 64.f); o8.y = pk4_fp8(s[4 * 33] * 64.f, s[5 * 33] * 64.f, s[6 * 33] * 64.f, s[7 * 33] * 64.f);
            *(GAS v2u*)((unsigned char*)WT + (size_t)(row_off + nn) * pitch + k0 + 8 * c) = o8; }
        else { v4u o; o.x = pk2(s[0 * 33], s[1 * 33]); o.y = pk2(s[2 * 33], s[3 * 33]); o.z = pk2(s[4 * 33], s[5 * 33]); o.w = pk2(s[6 * 33], s[7 * 33]);
            *(GAS v4u*)(WT + (size_t)(row_off + nn) * K + k0 + 8 * c) = o; } }
    LDS_WAIT(); asm volatile("" ::: "memory");
}
__device__ __forceinline__ void p0_convert(const float* src, bf16* dst, size_t n, int gw, int NGW, int lane) {
    const size_t nchunk = n / 512;
    for (size_t ch = gw; ch < nchunk; ch += NGW) {
        const GAS f32x4* s = (const GAS f32x4*)(src + ch * 512) + 2 * lane;
        const f32x4 a = s[0], b = s[1];
        v4u o; o.x = pk2(a.x, a.y); o.y = pk2(a.z, a.w); o.z = pk2(b.x, b.y); o.w = pk2(b.z, b.w);
        *((GAS v4u*)(dst + ch * 512) + lane) = o;
    }
}
__device__ __forceinline__ void p0_convert_fp8(const float* src, unsigned char* dst, size_t n, float scale, int gw, int NGW, int lane) {
    const size_t nchunk = n / 1024;
    for (size_t ch = gw; ch < nchunk; ch += NGW) {
        const GAS f32x4* s = (const GAS f32x4*)(src + ch * 1024) + 4 * lane;
        v4u o;
#pragma unroll
        for (int j = 0; j < 4; ++j) { const f32x4 a = s[j] * scale; int w = 0; w = __builtin_amdgcn_cvt_pk_fp8_f32(a.x, a.y, w, false); w = __builtin_amdgcn_cvt_pk_fp8_f32(a.z, a.w, w, true); o[j] = (unsigned)w; }
        *((GAS v4u*)(dst + ch * 1024) + lane) = o;
    }
}
__device__ __forceinline__ unsigned fp6_code(float x) {
    const unsigned xb = __builtin_bit_cast(unsigned, x), ab = xb & 0x7fffffffu;
    const float ax = __builtin_bit_cast(float, ab);
    const unsigned rb = (ab + 0x0007ffffu + ((ab >> 20) & 1u)) >> 20;
    const unsigned cn = min(rb - (126u << 3), 31u);
    const unsigned cs = (unsigned)__builtin_rintf(ax * 8.f);
    const unsigned c = (ax < 1.f) ? cs : cn;
    return ((xb >> 26) & 32u) | c;
}
__device__ __forceinline__ void p0_convert_fp6_row(const float* src, unsigned char* dst, int r, float scale, int lane) {
    {
        const GAS float* sr = (const GAS float*)(src + (size_t)r * D) + lane;
        unsigned d[14];
#pragma unroll
        for (int i = 0; i < 14; ++i) d[i] = 0u;
#pragma unroll
        for (int g = 0; g < 2; ++g) {
            float a[32];
#pragma unroll
            for (int j = 0; j < 32; ++j) a[j] = __builtin_nontemporal_load(sr + (32 * g + j) * 64);
#pragma unroll
            for (int j = 0; j < 32; ++j) {
                const unsigned c = fp6_code(a[j] * scale);
                const int bp = 6 * j, dw = 6 * g + (bp >> 5), off = bp & 31;
                d[dw] |= c << off;
                if (off > 26) d[dw + 1] |= c >> (32 - off);
            }
        }
        unsigned char* rowp = dst + (size_t)r * 3072;
        __builtin_nontemporal_store((v4u){d[0], d[1], d[2], d[3]}, (GAS v4u*)rowp + lane); __builtin_nontemporal_store((v2u){d[4], d[5]}, (GAS v2u*)(rowp + 1024) + lane);
        __builtin_nontemporal_store((v2u){d[6], d[7]}, (GAS v2u*)(rowp + 1536) + lane); __builtin_nontemporal_store((v4u){d[8], d[9], d[10], d[11]}, (GAS v4u*)(rowp + 2048) + lane);
    }
}
__device__ __forceinline__ void p0_convert_fp4_row(const float* src, unsigned char* dst, int r, float scale, int lane) {
    const GAS float* sr = (const GAS float*)(src + (size_t)r * D) + lane;
    unsigned d[8];
#pragma unroll
    for (int i = 0; i < 8; ++i) d[i] = 0u;
#pragma unroll
    for (int g = 0; g < 2; ++g) {
        float a[32];
#pragma unroll
        for (int j = 0; j < 32; ++j) a[j] = __builtin_nontemporal_load(sr + (32 * g + j) * 64);
#pragma unroll
        for (int w = 0; w < 4; ++w) {
            unsigned q = 0u;
            q = __builtin_amdgcn_cvt_scalef32_pk_fp4_f32(q, a[8 * w + 0] * scale, a[8 * w + 1] * scale, 1.0f, 0);
            q = __builtin_amdgcn_cvt_scalef32_pk_fp4_f32(q, a[8 * w + 2] * scale, a[8 * w + 3] * scale, 1.0f, 1);
            q = __builtin_amdgcn_cvt_scalef32_pk_fp4_f32(q, a[8 * w + 4] * scale, a[8 * w + 5] * scale, 1.0f, 2);
            q = __builtin_amdgcn_cvt_scalef32_pk_fp4_f32(q, a[8 * w + 6] * scale, a[8 * w + 7] * scale, 1.0f, 3);
            d[4 * g + w] = q;
        }
    }
    unsigned char* rowp = dst + (size_t)r * 2048;
    __builtin_nontemporal_store((v4u){d[0], d[1], d[2], d[3]}, (GAS v4u*)rowp + lane); __builtin_nontemporal_store((v4u){d[4], d[5], d[6], d[7]}, (GAS v4u*)(rowp + 1024) + lane);
}
__device__ __forceinline__ void p0_convert_fp8_rows(const float* src, unsigned char* dst, int nrows, int pitch, int gw, int NGW, int lane, unsigned char* dst4 = nullptr) {
    const int nchunk = nrows * (D / 1024);
    for (int ch = gw; ch < nchunk; ch += NGW) {
        const int r = ch / (D / 1024), q = ch % (D / 1024);
        const GAS f32x4* s = (const GAS f32x4*)(src + (size_t)r * D + q * 1024) + 4 * lane;
        v4u o; v2u o4;
#pragma unroll
        for (int j = 0; j < 4; ++j) { const f32x4 a = __builtin_nontemporal_load(s + j); o[j] = pk4_fp8(a.x, a.y, a.z, a.w);
            if (dst4) { unsigned w = (j & 1) ? o4[j >> 1] : 0u;
                if (j & 1) { w = __builtin_amdgcn_cvt_scalef32_pk_fp4_f32(w, a.x * 2.0f, a.y * 2.0f, 1.0f, 2); w = __builtin_amdgcn_cvt_scalef32_pk_fp4_f32(w, a.z * 2.0f, a.w * 2.0f, 1.0f, 3); }
                else { w = __builtin_amdgcn_cvt_scalef32_pk_fp4_f32(w, a.x * 2.0f, a.y * 2.0f, 1.0f, 0); w = __builtin_amdgcn_cvt_scalef32_pk_fp4_f32(w, a.z * 2.0f, a.w * 2.0f, 1.0f, 1); }
                o4[j >> 1] = w; } }
        *((GAS v4u*)(dst + (size_t)r * pitch + q * 1024) + lane) = o;
        if (dst4) *((GAS v2u*)(dst4 + (size_t)r * P1B_PITCH + q * 512) + lane) = o4;
    }
}
__device__ __forceinline__ void sincos_d(double a, float& sn, float& cs) {
    const double k = rint(a * 0.63661977236758134308);
    double y = fma(-k, 1.57079632679489655800e+00, a); y = fma(-k, 6.12323399573676603587e-17, y);
    const double y2 = y * y;
    double s = y2 * (-2.50521083854417187751e-08) + 2.75573192239858906526e-06; s = s * y2 - 1.98412698412698412698e-04; s = s * y2 + 8.33333333333333333333e-03; s = s * y2 - 1.66666666666666666667e-01; s = y + y * y2 * s;
    double c = y2 * (2.08767569878680989792e-09) - 2.75573192239858906526e-07; c = c * y2 + 2.48015873015873015873e-05; c = c * y2 - 1.38888888888888888889e-03; c = c * y2 + 4.16666666666666666667e-02; c = c * y2 - 0.5; c = c * y2 + 1.0;
    const int q = ((int)(long long)k) & 3;
    const double ss = (q & 1) ? c : s, cc = (q & 1) ? s : c;
    sn = (float)((q & 2) ? -ss : ss); cs = (float)(((q + 1) & 2) ? -cc : cc);
}
constexpr int P0_I_IN = (D / 64) * (INW / 32), P0_I_GT = (D / 64) * (GATEW / 32), P0_I_MK = (D / 64) * (2048 / 32);
constexpr int P0_I_BA = (1536 / 64) * (D / 32), P0_I_BB = (512 / 64) * (D / 32), P0_I_BM = (1024 / 64) * (D / 32), P0_I_WO = (D / 64) * (D / 32), P0_I_Q = (D / 64) * (2048 / 32);
constexpr int P0_NITEMS = P0_I_IN + P0_I_GT + P0_I_MK + P0_I_BA + P0_I_BB + P0_I_BM + P0_I_WO + P0_I_Q;
struct P0It { const float* W; int N, k0, n0, kind; };
__device__ __forceinline__ bool p0_decode(const Frame& F, int it, int it1, P0It& d) {
    if (it >= it1) return false;
    int r = it;
    if (r < P0_I_IN) { d.W = F.in[I_WIN]; d.N = INW; d.kind = 0; }
    else if ((r -= P0_I_IN) < P0_I_GT) { d.W = F.in[I_WGATE]; d.N = GATEW; d.kind = 1; }
    else if ((r -= P0_I_GT) < P0_I_MK) { d.W = F.in[I_WMKV]; d.N = 2048; d.kind = 2; }
    else if ((r -= P0_I_MK) < P0_I_BA) { d.W = F.in[I_WBRA]; d.N = D; d.kind = 3; }
    else if ((r -= P0_I_BA) < P0_I_BB) { d.W = F.in[I_WBRB]; d.N = D; d.kind = 4; }
    else if ((r -= P0_I_BB) < P0_I_BM) { d.W = F.in[I_WBRM]; d.N = D; d.kind = 5; }
    else if ((r -= P0_I_BM) < P0_I_WO) { d.W = F.in[I_WOUT]; d.N = D; d.kind = 6; }
    else { r -= P0_I_WO; d.W = F.in[I_WQ]; d.N = 2048; d.kind = 7; }
    const int nblk = d.N / 32; d.k0 = 64 * (r / nblk); d.n0 = 32 * (r % nblk);
    return true;
}
__device__ __forceinline__ void p0_item_load(const P0It& d, int lane, float (&tv)[32]) {
    const GAS float* p = (const GAS float*)d.W + (size_t)(d.k0 + (lane >> 5)) * d.N + d.n0 + (lane & 31);
#pragma unroll
    for (int i = 0; i < 32; ++i) tv[i] = __builtin_nontemporal_load(p + (size_t)(2 * i) * d.N);
}
__device__ __forceinline__ void p0_item_finish(Frame& F, const P0It& d, const float (&tv)[32], LAS float* scr) {
    bf16* WALL = (bf16*)(F.ws + WS_WALL);
    switch (d.kind) {
    case 0: p0_transpose_finish<true, 1>(tv, D, WALL, 0, scr, d.k0, d.n0, F.lane, P1_PITCH); break;
    case 1: p0_transpose_finish<false, 2>(tv, D, (bf16*)(F.ws + WS_WG4), 0, scr, d.k0, d.n0, F.lane, P1B_PITCH); break;
    case 2: p0_transpose_finish<false, 1>(tv, D, WALL, INW + GATEW, scr, d.k0, d.n0, F.lane, P1_PITCH); break;
    case 3: p0_transpose_finish<false, 1>(tv, 1536, (bf16*)(F.ws + WS_WBRA), 0, scr, d.k0, d.n0, F.lane, ACT_PITCH); break;
    case 4: p0_transpose_finish<false, 1>(tv, 512, (bf16*)(F.ws + WS_WBRA + 1536), 0, scr, d.k0, d.n0, F.lane, ACT_PITCH); break;
    case 5: p0_transpose_finish<false, 1>(tv, 1024, (bf16*)(F.ws + WS_WBRA + 2048), 0, scr, d.k0, d.n0, F.lane, ACT_PITCH); break;
    case 6: p0_transpose_finish<false, 1>(tv, D, (bf16*)(F.ws + WS_WOUT), 0, scr, d.k0, d.n0, F.lane); break;
    default: p0_transpose_finish<false, 0>(tv, D, (bf16*)(F.ws + WS_WQ), 0, scr, d.k0, d.n0, F.lane); break;
    }
}
__device__ __forceinline__ void p0_weight_items(Frame& F, int it0, int it1, int gw, int NGW) {
    LAS float* scr = (LAS float*)(F.lds + RING_OFF + F.wave * 16384);
    P0It cur, nxt; float ta[32], tb[32];
    int it = it0 + gw;
    if (!p0_decode(F, it, it1, cur)) return;
    p0_item_load(cur, F.lane, ta);
#pragma unroll 1
    for (;;) {
        bool more = p0_decode(F, it + NGW, it1, nxt);
        if (more) p0_item_load(nxt, F.lane, tb);
        p0_item_finish(F, cur, ta, scr);
        if (!more) break;
        more = p0_decode(F, it + 2 * NGW, it1, cur);
        if (more) p0_item_load(cur, F.lane, ta);
        p0_item_finish(F, nxt, tb, scr);
        if (!more) break;
        it += 2 * NGW;
    }
}
__device__ __forceinline__ void p0_prologue(Frame& F) {
    const int gw = F.vcu * NWAVES + F.wave, NGW = F.G * NWAVES;
    p0_weight_items(F, 0, P0_NITEMS, gw, NGW);
    bf16* XA = (bf16*)(F.ws + WS_XA);
    p0_convert_fp8_rows(F.in[I_X], (unsigned char*)XA, T, P1_PITCH, gw, NGW, F.lane, F.ws + WS_XA4);
    p0_convert_fp8_rows(F.in[I_MEM], (unsigned char*)XA + (size_t)T * P1_PITCH, MROWS, P1_PITCH, gw, NGW, F.lane);
    p0_convert(F.in[I_SK], (bf16*)(F.ws + WS_SK), (size_t)8 * 2 * 128 * 128, gw, NGW, F.lane);
    {
        float* rope = (float*)(F.ws + WS_ROPE);
        const int* pos = (const int*)F.in[I_POS];
        const int gt = (F.vcu * NWAVES + F.wave) * 64 + F.lane, NGT = NGW * 64;
        for (int i = gt; i < T * 64; i += NGT) {
            const int m = i >> 6, j = i & 63;
            const double inv = exp2(-(double)j * (13.287712379549449 / 64.0));
            float sn, cs; sincos_d((double)pos[m] * inv, sn, cs);
            { typedef float f32x2g __attribute__((ext_vector_type(2))); *(GAS f32x2g*)(rope + (size_t)i * 2) = (f32x2g){cs, sn}; }
        }
    }
}

__device__ __forceinline__ void peer_tables_convert(Frame& F) {
    gu32* ctr = F.ctl + CW_ROWS;
    for (;;) {
        unsigned r0 = 0u;
        if (F.lane == 0) r0 = __hip_atomic_fetch_add(ctr, 4u, RLX_AGENT);
        r0 = (unsigned)__builtin_amdgcn_readfirstlane((int)r0);
        if (r0 >= 2u * PEER_E) break;
#pragma unroll 1
        for (unsigned r = r0; r < r0 + 4u; ++r) {
            if (r < (unsigned)PEER_E) p0_convert_fp4_row(F.in[I_PU], F.ws + WS_PU, (int)r, 128.0f, F.lane);
            else p0_convert_fp4_row(F.in[I_PV], F.ws + WS_PV, (int)(r - PEER_E), PV_SCALE, F.lane);
        }
    }
}
__device__ __forceinline__ bf16x8 as_bf16x8(v4u v) { return __builtin_bit_cast(bf16x8, v); }
constexpr int KP = 272;
constexpr int VP = 528;

struct RowMap { const bf16* base; long row0; int rstride; int pitch; };
__device__ __forceinline__ const bf16* rm_ptr(const RowMap& r, int i) { return r.base + (r.row0 + (long)i * r.rstride) * (long)r.pitch; }

template <int NCH, bool BAND, bool OUT8>
__device__ __forceinline__ void attn_unit(LAS unsigned char* lds, const RowMap qm, const RowMap km, const RowMap vm, bf16* obase, long orow0, int orstride, int opitch, int kmin, float* lse_out, int lse_stride, int tid) {
    const int lane = tid & 63, w = __builtin_amdgcn_readfirstlane(tid >> 6), l15 = lane & 15, fq = lane >> 4;
    const int qi = 16 * w + l15;
    f32x4 s[16];
#pragma unroll
    for (int kt = 0; kt < 16; ++kt) s[kt] = (f32x4){0.f, 0.f, 0.f, 0.f};
    const bf16* qp = rm_ptr(qm, qi);
    v4u kreg[8], va[4], vb[4];
#define ATT_LOAD_K(ch) do { _Pragma("unroll") for (int p = 0; p < 8; ++p) { const int idx = p * 512 + tid, key = idx >> 4, c16 = idx & 15; \
        kreg[p] = (v4u){0u, 0u, 0u, 0u}; if (key >= kmin) kreg[p] = *(const GAS v4u*)(rm_ptr(km, key) + (ch) * 128 + c16 * 8); } } while (0)
#define ATT_WRITE_K() do { _Pragma("unroll") for (int p = 0; p < 8; ++p) { const int idx = p * 512 + tid, key = idx >> 4, c16 = idx & 15; *(LAS v4u*)(lds + key * KP + c16 * 16) = kreg[p]; } } while (0)
#define ATT_LOAD_V(ch) do { _Pragma("unroll") for (int p = 0; p < 4; ++p) { const int idx = p * 512 + tid, kp = idx & 127, dg = idx >> 7; \
        va[p] = (v4u){0u, 0u, 0u, 0u}; vb[p] = (v4u){0u, 0u, 0u, 0u}; \
        if (2 * kp >= kmin) { va[p] = *(const GAS v4u*)(rm_ptr(vm, 2 * kp) + (ch) * 128 + dg * 8); vb[p] = *(const GAS v4u*)(rm_ptr(vm, 2 * kp + 1) + (ch) * 128 + dg * 8); } } } while (0)
#define ATT_WRITE_VT() do { _Pragma("unroll") for (int p = 0; p < 4; ++p) { const int idx = p * 512 + tid, kp = idx & 127, dg = idx >> 7; \
        _Pragma("unroll") for (int e = 0; e < 8; ++e) { const unsigned lo = (va[p][e >> 1] >> (16 * (e & 1))) & 0xffffu, hi = (vb[p][e >> 1] >> (16 * (e & 1))) & 0xffffu; \
            *(LAS unsigned*)(lds + (dg * 8 + e) * VP + kp * 4) = lo | (hi << 16); } } } while (0)
    ATT_LOAD_K(0);
#pragma unroll
    for (int ch = 0; ch < NCH; ++ch) {
        ATT_WRITE_K();
        bf16x8 qf[4];
#pragma unroll
        for (int ks = 0; ks < 4; ++ks) qf[ks] = as_bf16x8(*(const GAS v4u*)(qp + ch * 128 + 32 * ks + 8 * fq));
        __syncthreads();
        if (ch + 1 < NCH) ATT_LOAD_K(ch + 1); else ATT_LOAD_V(0);
#pragma unroll
        for (int kt = 0; kt < 16; ++kt)
#pragma unroll
            for (int ks = 0; ks < 4; ++ks) {
                const bf16x8 kf = as_bf16x8(*(const LAS v4u*)(lds + (16 * kt + l15) * KP + 64 * ks + 16 * fq));
                s[kt] = __builtin_amdgcn_mfma_f32_16x16x32_bf16(kf, qf[ks], s[kt], 0, 0, 0);
            }
        __syncthreads();
    }
    float mx = -3.0e38f;
#pragma unroll
    for (int kt = 0; kt < 16; ++kt)
#pragma unroll
        for (int i = 0; i < 4; ++i) {
            if (BAND) { const int kj = 16 * kt + 4 * fq + i; const bool ok = (kj >= qi) && (kj <= qi + 128) && (kj >= kmin); s[kt][i] = ok ? s[kt][i] : -1.0e30f; }
            mx = fmaxf(mx, s[kt][i]);
        }
    mx = fmaxf(mx, __shfl_xor(mx, 16)); mx = fmaxf(mx, __shfl_xor(mx, 32));
    float sum = 0.f;
#pragma unroll
    for (int kt = 0; kt < 16; ++kt)
#pragma unroll
        for (int i = 0; i < 4; ++i) { const float p = __builtin_amdgcn_exp2f((s[kt][i] - mx) * 1.4426950409f); s[kt][i] = p; sum += p; }
    sum += __shfl_xor(sum, 16); sum += __shfl_xor(sum, 32);
    const float inv = 1.0f / sum;
    if (lse_out && fq == 0) lse_out[(long)qi * lse_stride] = mx + __logf(sum);
    bf16x8 pf[8];
#pragma unroll
    for (int kk = 0; kk < 8; ++kk) { v4u t; t.x = pg8::cvt_pk_bf16(s[2 * kk][0], s[2 * kk][1]); t.y = pg8::cvt_pk_bf16(s[2 * kk][2], s[2 * kk][3]);
        t.z = pg8::cvt_pk_bf16(s[2 * kk + 1][0], s[2 * kk + 1][1]); t.w = pg8::cvt_pk_bf16(s[2 * kk + 1][2], s[2 * kk + 1][3]); pf[kk] = as_bf16x8(t); }
    bf16* op = obase + (orow0 + (long)qi * orstride) * (long)opitch;
#pragma unroll
    for (int ch = 0; ch < NCH; ++ch) {
        ATT_WRITE_VT();
        __syncthreads();
        if (ch + 1 < NCH) ATT_LOAD_V(ch + 1);
        f32x4 o[8];
#pragma unroll
        for (int nt = 0; nt < 8; ++nt) o[nt] = (f32x4){0.f, 0.f, 0.f, 0.f};
#pragma unroll
        for (int nt = 0; nt < 8; ++nt)
#pragma unroll
            for (int kk = 0; kk < 8; ++kk) {
                const LAS unsigned char* vp = lds + (16 * nt + l15) * VP + 64 * kk + 8 * fq;
                const v2u v0 = *(const LAS v2u*)vp, v1 = *(const LAS v2u*)(vp + 32);
                const bf16x8 vf = as_bf16x8((v4u){v0.x, v0.y, v1.x, v1.y});
                o[nt] = __builtin_amdgcn_mfma_f32_16x16x32_bf16(vf, pf[kk], o[nt], 0, 0, 0);
            }
#pragma unroll
        for (int nt = 0; nt < 8; ++nt) {
            if (OUT8) { const float i8 = inv * 8.0f; *(GAS unsigned*)((unsigned char*)obase + (orow0 + (long)qi * orstride) * (long)opitch + ch * 128 + 16 * nt + 4 * fq) = pg8::pk4_fp8(o[nt][0] * i8, o[nt][1] * i8, o[nt][2] * i8, o[nt][3] * i8); }
            else { v2u t; t.x = pg8::cvt_pk_bf16(o[nt][0] * inv, o[nt][1] * inv); t.y = pg8::cvt_pk_bf16(o[nt][2] * inv, o[nt][3] * inv);
            *(GAS v2u*)(op + ch * 128 + 16 * nt + 4 * fq) = t; } }
        __syncthreads();
    }
#undef ATT_LOAD_K
#undef ATT_WRITE_K
#undef ATT_LOAD_V
#undef ATT_WRITE_VT
}

__device__ __forceinline__ void gmlp_unit(Frame& F, int n, int g3) {
    const int tid = F.tid, lane = F.lane, w = F.wave, l15 = lane & 15, fq = lane >> 4;
    const bf16* proj = (const bf16*)(F.ws + WS_PROJ);
    LAS unsigned char* vt = F.lds + RING_OFF;
    LAS float* stats = (LAS float*)(F.lds + RING_OFF + 128 * KP);
    const long R0 = (long)n * 128;
#pragma unroll 1
    for (int t4 = 0; t4 < 4; ++t4) {
        v4u q[4][3];
#pragma unroll
        for (int tt = 0; tt < 4; ++tt) { const GAS v4u* rp = (const GAS v4u*)(proj + (R0 + 16 * w + 4 * t4 + tt) * INW + C_GV) + lane;
#pragma unroll
            for (int j = 0; j < 3; ++j) q[tt][j] = rp[64 * j]; }
#pragma unroll
        for (int tt = 0; tt < 4; ++tt) {
            float sm = 0.f;
#pragma unroll
            for (int j = 0; j < 3; ++j)
#pragma unroll
                for (int e = 0; e < 4; ++e) sm += pg8::bf_lo(q[tt][j][e]) + pg8::bf_hi(q[tt][j][e]);
            const float mean = wave_sum_dpp(sm) * (1.0f / GMW); float s2 = 0.f;
#pragma unroll
            for (int j = 0; j < 3; ++j)
#pragma unroll
                for (int e = 0; e < 4; ++e) { const float d0 = pg8::bf_lo(q[tt][j][e]) - mean, d1 = pg8::bf_hi(q[tt][j][e]) - mean; s2 += d0 * d0 + d1 * d1; }
            const float rstd = 1.0f / sqrtf(wave_sum_dpp(s2) * (1.0f / GMW) + LN_EPS);
            const int tok = 16 * w + 4 * t4 + tt;
            if (lane == 0) { stats[2 * tok] = mean; stats[2 * tok + 1] = rstd; }
        }
    }
    __syncthreads();
#pragma unroll 1
    for (int g = 3 * g3; g < 3 * g3 + 3; ++g) {
    const float* lng = F.in[I_GLNG] + g * 128; const float* lnb = F.in[I_GLNB] + g * 128;
#pragma unroll
    for (int p = 0; p < 2; ++p) { const int idx = p * 512 + tid, sp = idx & 63, cg = idx >> 6;
        const v4u a = *(const GAS v4u*)(proj + (R0 + 2 * sp) * INW + C_GV + g * 128 + cg * 8), b = *(const GAS v4u*)(proj + (R0 + 2 * sp + 1) * INW + C_GV + g * 128 + cg * 8);
        const float m0 = stats[4 * sp], r0 = stats[4 * sp + 1], m1 = stats[4 * sp + 2], r1 = stats[4 * sp + 3];
#pragma unroll
        for (int e = 0; e < 8; ++e) { const float x0 = (e & 1) ? pg8::bf_hi(a[e >> 1]) : pg8::bf_lo(a[e >> 1]), x1 = (e & 1) ? pg8::bf_hi(b[e >> 1]) : pg8::bf_lo(b[e >> 1]);
            const float gg = lng[cg * 8 + e], bb = lnb[cg * 8 + e];
            *(LAS unsigned*)(vt + (cg * 8 + e) * KP + sp * 4) = pk2((x0 - m0) * r0 * gg + bb, (x1 - m1) * r1 * gg + bb); } }
    __syncthreads();
    f32x4 acc[8];
#pragma unroll
    for (int ct = 0; ct < 8; ++ct) acc[ct] = (f32x4){0.f, 0.f, 0.f, 0.f};
    const int t = 16 * w + l15;
    const float* wrow = F.in[I_GWS] + ((size_t)g * 128 + t) * 128;
#pragma unroll
    for (int ks = 0; ks < 4; ++ks) {
        if (32 * ks <= 16 * w + 15) {
            const int s0 = 32 * ks + 8 * fq;
            const f32x4 w0 = *(const GAS f32x4*)(wrow + s0), w1 = *(const GAS f32x4*)(wrow + s0 + 4);
            v4u wf; wf.x = pk2(s0 + 0 <= t ? w0.x : 0.f, s0 + 1 <= t ? w0.y : 0.f); wf.y = pk2(s0 + 2 <= t ? w0.z : 0.f, s0 + 3 <= t ? w0.w : 0.f);
            wf.z = pk2(s0 + 4 <= t ? w1.x : 0.f, s0 + 5 <= t ? w1.y : 0.f); wf.w = pk2(s0 + 6 <= t ? w1.z : 0.f, s0 + 7 <= t ? w1.w : 0.f);
            const bf16x8 wb = as_bf16x8(wf);
#pragma unroll
            for (int ct = 0; ct < 8; ++ct) {
                const bf16x8 vf = as_bf16x8(*(const LAS v4u*)(vt + (16 * ct + l15) * KP + 64 * ks + 16 * fq));
                acc[ct] = __builtin_amdgcn_mfma_f32_16x16x32_bf16(vf, wb, acc[ct], 0, 0, 0);
            }
        }
    }
    const float bs = F.in[I_GBS][g * 128 + t];
    bf16* aout = (bf16*)(F.ws + WS_AOUT);
#pragma unroll
    for (int ct = 0; ct < 8; ++ct) {
        const int c = g * 128 + 16 * ct + 4 * fq;
        const v2u uu = *(const GAS v2u*)(proj + (R0 + t) * INW + C_GU + c);
        *(GAS unsigned*)((unsigned char*)aout + (R0 + t) * ACT_PITCH + c) = pg8::pk4_fp8(8.0f * pg8::bf_lo(uu.x) * (acc[ct][0] + bs), 8.0f * pg8::bf_hi(uu.x) * (acc[ct][1] + bs), 8.0f * pg8::bf_lo(uu.y) * (acc[ct][2] + bs), 8.0f * pg8::bf_hi(uu.y) * (acc[ct][3] + bs));
    }
    __syncthreads();
    }
}

__device__ __forceinline__ void p2_mixers(Frame& F) {
    const bf16* proj = (const bf16*)(F.ws + WS_PROJ);
    const bf16* mkv = (const bf16*)(F.ws + WS_MKV);
    LAS unsigned char* lds = F.lds + RING_OFF;
    if (!(DBG_P2SKIP & 1)) for (int u = F.vcu; u < 256; u += F.G) {
        const int b = u >> 7, h = (u >> 5) & 3, qb = u & 31;
        const RowMap qm{proj + C_MQ + h * 256, (long)b * SEQ + qb * 128, 1, INW};
        const RowMap km{mkv + h * 256, (long)b * MEMLEN, 1, 2048};
        const RowMap vm{mkv + 1024 + h * 256, (long)b * MEMLEN, 1, 2048};
        attn_unit<2, false, true>(lds, qm, km, vm, (bf16*)(F.ws + WS_MOUT + h * 256), (long)b * SEQ + qb * 128, 1, ACT_PITCH, 0, nullptr, 0, F.tid);
    }
    if (!(DBG_P2SKIP & 2)) for (int u = F.vcu; u < 768; u += F.G) {
        const int g = u >> 8, b = (u >> 7) & 1, hs = (u >> 5) & 3, rn = u & 31;
        const int d = (g == 0) ? 1 : (g == 1 ? 4 : 16), nb = 32 / d, r = rn / nb, n = rn % nb;
        const int head = g * 4 + hs;
        const long q0 = (long)b * SEQ + (long)n * 128 * d + r, k0 = q0 - 128L * d;
        const RowMap qm{proj + C_DQ + head * 128, q0, d, INW};
        const RowMap km{proj + C_DK + head * 128, k0, d, INW};
        const RowMap vm{proj + C_DV + head * 128, k0, d, INW};
        float* lse = (float*)(F.ws + WS_LSE) + ((size_t)g * T + q0) * 4 + hs;
        attn_unit<1, true, false>(lds, qm, km, vm, (bf16*)(F.ws + WS_OG) + (size_t)g * T * 512 + hs * 128, q0, d, 512, n == 0 ? 128 : 0, lse, 4 * d, F.tid);
    }
    if (!(DBG_P2SKIP & 4)) for (int u = F.vcu; u < 256; u += F.G) gmlp_unit(F, u >> 2, u & 3);
}

__device__ __forceinline__ void p3_merge(Frame& F) {
    const bf16* og = (const bf16*)(F.ws + WS_OG); const float* lse = (const float*)(F.ws + WS_LSE); bf16* bout = (bf16*)(F.ws + WS_BOUT);
    const int gt = (F.vcu * NWAVES + F.wave) * 64 + F.lane, NGT = F.G * NWAVES * 64;
    for (int i = gt; i < T * 64; i += NGT) {
        const int tok = i >> 6, c8 = i & 63, hs = c8 >> 4;
        const float l0 = lse[((size_t)0 * T + tok) * 4 + hs], l1 = lse[((size_t)1 * T + tok) * 4 + hs], l2 = lse[((size_t)2 * T + tok) * 4 + hs];
        const float m = fmaxf(l0, fmaxf(l1, l2)); const float e0 = __expf(l0 - m), e1 = __expf(l1 - m), e2 = __expf(l2 - m); const float is = 1.0f / (e0 + e1 + e2);
        const float w0 = e0 * is, w1 = e1 * is, w2 = e2 * is;
        const v4u a = *(const GAS v4u*)(og + ((size_t)0 * T + tok) * 512 + c8 * 8), b = *(const GAS v4u*)(og + ((size_t)1 * T + tok) * 512 + c8 * 8), c = *(const GAS v4u*)(og + ((size_t)2 * T + tok) * 512 + c8 * 8);
        float r[8];
#pragma unroll
        for (int e = 0; e < 4; ++e) { r[2 * e] = 8.0f * (w0 * pg8::bf_lo(a[e]) + w1 * pg8::bf_lo(b[e]) + w2 * pg8::bf_lo(c[e])); r[2 * e + 1] = 8.0f * (w0 * pg8::bf_hi(a[e]) + w1 * pg8::bf_hi(b[e]) + w2 * pg8::bf_hi(c[e])); }
        v2u o; o.x = pg8::pk4_fp8(r[0], r[1], r[2], r[3]); o.y = pg8::pk4_fp8(r[4], r[5], r[6], r[7]);
        *(GAS v2u*)((unsigned char*)bout + (size_t)tok * ACT_PITCH + c8 * 8) = o;
    }
}
__device__ __forceinline__ void p6_layernorm(Frame& F) {
    const bf16* z = (const bf16*)(F.ws + WS_Z); bf16* h1b = (bf16*)(F.ws + WS_H1B);
    const float* lg = F.in[I_LNMG]; const float* lb = F.in[I_LNMB];
    const int gw = F.vcu * NWAVES + F.wave, NGW = F.G * NWAVES, lane = F.lane;
    for (int m = gw; m < T; m += NGW) {
        const GAS v4u* zr = (const GAS v4u*)(z + (size_t)m * D) + lane;
        float v[64]; float s = 0.f;
#pragma unroll
        for (int j = 0; j < 8; ++j) { const v4u q = __builtin_nontemporal_load(zr + 64 * j);
#pragma unroll
            for (int e = 0; e < 4; ++e) { v[8 * j + 2 * e] = pg8::bf_lo(q[e]); v[8 * j + 2 * e + 1] = pg8::bf_hi(q[e]); s += v[8 * j + 2 * e] + v[8 * j + 2 * e + 1]; } }
        const float mean = wave_sum_dpp(s) * (1.f / D); float s2 = 0.f;
#pragma unroll
        for (int i = 0; i < 64; ++i) { v[i] -= mean; s2 += v[i] * v[i]; }
        const float rstd = 1.f / sqrtf(wave_sum_dpp(s2) * (1.f / D) + LN_EPS);
        GAS v4u* o = (GAS v4u*)(h1b + (size_t)m * D) + lane;
#pragma unroll
        for (int j = 0; j < 8; ++j) {
            const f32x4 ga = *((const GAS f32x4*)lg + 2 * lane + 128 * j), gb = *((const GAS f32x4*)lg + 2 * lane + 128 * j + 1), ba = *((const GAS f32x4*)lb + 2 * lane + 128 * j), bb = *((const GAS f32x4*)lb + 2 * lane + 128 * j + 1);
            v4u w; w.x = pk2(v[8 * j] * rstd * ga.x + ba.x, v[8 * j + 1] * rstd * ga.y + ba.y); w.y = pk2(v[8 * j + 2] * rstd * ga.z + ba.z, v[8 * j + 3] * rstd * ga.w + ba.w);
            w.z = pk2(v[8 * j + 4] * rstd * gb.x + bb.x, v[8 * j + 5] * rstd * gb.y + bb.y); w.w = pk2(v[8 * j + 6] * rstd * gb.z + bb.z, v[8 * j + 7] * rstd * gb.w + bb.w);
            o[64 * j] = w;
        }
    }
}

__device__ __forceinline__ unsigned f2ord(float f) { const unsigned u = __builtin_bit_cast(unsigned, f); return u ^ ((unsigned)((int)u >> 31) | 0x80000000u); }
__device__ __forceinline__ float ord2f(unsigned k) { const unsigned u = (k & 0x80000000u) ? (k ^ 0x80000000u) : ~k; return __builtin_bit_cast(float, u); }

__device__ __forceinline__ void p8_topk(Frame& F) {
    const bf16* Q = (const bf16*)(F.ws + WS_Q); const bf16* SK = (const bf16*)(F.ws + WS_SK);
    int* seli = (int*)(F.ws + WS_SELI); float* selg = (float*)(F.ws + WS_SELG);
    LAS unsigned char* lds = F.lds + RING_OFF;
    const int tid = F.tid, lane = F.lane, w = F.wave, l15 = lane & 15, fq = lane >> 4, gbase = lane & 48;
    for (int u = F.vcu; u < 512; u += F.G) {
        const int tb = u >> 3, h = u & 7;
#pragma unroll
        for (int p = 0; p < 8; ++p) { const int idx = p * 512 + tid, half = idx >> 11, key = (idx >> 4) & 127, c16 = idx & 15;
            *(LAS v4u*)(lds + (half * 128 + key) * KP + c16 * 16) = *(const GAS v4u*)(SK + ((size_t)(h * 2 + half) * 128 + key) * 128 + c16 * 8); }
        __syncthreads();
        f32x4 sc[2][8];
        const bf16* qrow = Q + (size_t)(tb * 128 + 16 * w + l15) * 2048 + h * 256;
#pragma unroll
        for (int p = 0; p < 2; ++p) {
            bf16x8 qf[4];
#pragma unroll
            for (int ks = 0; ks < 4; ++ks) qf[ks] = as_bf16x8(*(const GAS v4u*)(qrow + p * 128 + 32 * ks + 8 * fq));
#pragma unroll
            for (int nt = 0; nt < 8; ++nt) { sc[p][nt] = (f32x4){0.f, 0.f, 0.f, 0.f};
#pragma unroll
                for (int ks = 0; ks < 4; ++ks) {
                    const bf16x8 kf = as_bf16x8(*(const LAS v4u*)(lds + (p * 128 + 16 * nt + l15) * KP + 64 * ks + 16 * fq));
                    sc[p][nt] = __builtin_amdgcn_mfma_f32_16x16x32_bf16(qf[ks], kf, sc[p][nt], 0, 0, 0);
                } }
        }
        __syncthreads();
#pragma unroll
        for (int i = 0; i < 4; ++i) {
            unsigned rk[2];
#pragma unroll
            for (int p = 0; p < 2; ++p) {
                unsigned v[8];
#pragma unroll
                for (int nt = 0; nt < 8; ++nt) v[nt] = (f2ord(sc[p][nt][i]) & ~127u) | (unsigned)(127 - (16 * nt + l15));
                unsigned r = 0u;
#pragma unroll 1
                for (int it = 0; it < 16; ++it) {
                    unsigned b = max(max(max(v[0], v[1]), max(v[2], v[3])), max(max(v[4], v[5]), max(v[6], v[7])));
                    b = row_max_u32(b);
                    r = (l15 == it) ? b : r;
#pragma unroll
                    for (int nt = 0; nt < 8; ++nt) v[nt] = (v[nt] == b) ? 0u : v[nt];
                }
                rk[p] = r;
            }
            const float s1 = ord2f(rk[0] & ~127u), s2 = ord2f(rk[1] & ~127u);
            const int i1 = 127 - (int)(rk[0] & 127u), i2 = 127 - (int)(rk[1] & 127u);
            unsigned c[4];
            {
                const float s1_0 = __shfl(s1, gbase), s1_1 = __shfl(s1, gbase + 1), s1_2 = __shfl(s1, gbase + 2);
#pragma unroll
                for (int j = 0; j < 4; ++j) { const float v = s1 + __shfl(s2, gbase + j); c[j] = ((l15 + 1) * (j + 1) <= 16) ? ((f2ord(v) & ~255u) | (unsigned)(255 - (l15 * 16 + j))) : 0u; }
                const int hi = l15 >= 8;
                const int b1 = l15 - 4;
                const float v1 = s1_0 + __shfl(s2, gbase + (hi ? b1 : 0));
                if (hi) c[1] = (f2ord(v1) & ~255u) | (unsigned)(255 - b1);
                const int a2 = l15 >= 12 ? 1 : 0, b2 = l15 >= 12 ? l15 - 8 : l15 + 4;
                const float v2 = (a2 ? s1_1 : s1_0) + __shfl(s2, gbase + (hi ? b2 : 0));
                if (hi) c[2] = (f2ord(v2) & ~255u) | (unsigned)(255 - (a2 * 16 + b2));
                const float v3 = s1_2 + __shfl(s2, gbase + 4);
                if (l15 == 8) c[3] = (f2ord(v3) & ~255u) | (unsigned)(255 - (2 * 16 + 4));
            }
            unsigned r = 0u;
#pragma unroll 1
            for (int it = 0; it < 16; ++it) {
                unsigned b = row_max_u32(max(max(c[0], c[1]), max(c[2], c[3])));
                r = (l15 == it) ? b : r;
#pragma unroll
                for (int j = 0; j < 4; ++j) c[j] = (c[j] == b) ? 0u : c[j];
            }
            const float best = ord2f(r & ~255u); const int ci = 255 - (int)(r & 255u);
            const int e1 = __shfl(i1, gbase + (ci >> 4)), e2 = __shfl(i2, gbase + (ci & 15));
            const float mx0 = __shfl(best, gbase);
            const float ev = __expf(best - mx0);
            const float sm = row_sum_f32(ev);
            const size_t tok = (size_t)tb * 128 + 16 * w + 4 * fq + i;
            seli[tok * 128 + h * 16 + l15] = e1 * 128 + e2; selg[tok * 128 + h * 16 + l15] = ev / sm;
        }
    }
}

typedef float f32x2v __attribute__((ext_vector_type(2)));
typedef float f32x32v __attribute__((ext_vector_type(32)));
typedef float f32x4p __attribute__((ext_vector_type(4)));
typedef unsigned u32x6v __attribute__((ext_vector_type(6)));
#define PEER_LD(p) (*(p))
#define PEER_DECL(n) v4u n##ua, n##ud, n##va, n##vd
#define PEER_LOAD(n, eid) do { const unsigned char* up_ = PU + (size_t)(eid) * 2048; const unsigned char* vp_ = PV + (size_t)(eid) * 2048; \
    n##ua = PEER_LD((const GAS v4u*)up_ + lane); n##ud = PEER_LD((const GAS v4u*)(up_ + 1024) + lane); \
    n##va = PEER_LD((const GAS v4u*)vp_ + lane); n##vd = PEER_LD((const GAS v4u*)(vp_ + 1024) + lane); } while (0)
#define PEER_RUN(n, gate) peer_expert(n##ua, n##ud, n##va, n##vd, xl, y16, gate)
typedef _Float16 h2v __attribute__((ext_vector_type(2)));
__device__ __forceinline__ void peer_expert(const v4u ua, const v4u ud, const v4u va, const v4u vd, const LAS unsigned char* xl, h2v (&y)[32], float gate) {
    float d0 = 0.f, d1 = 0.f, d2 = 0.f, d3 = 0.f;
#pragma unroll
    for (int w = 0; w < 8; ++w) {
        const v4u xq = *(const LAS v4u*)(xl + w * 1024);
        unsigned xq0 = xq.x, xq1 = xq.y, xq2 = xq.z, xq3 = xq.w;
        asm volatile("" : "+v"(xq0), "+v"(xq1), "+v"(xq2), "+v"(xq3));
        const unsigned uw = w < 4 ? ua[w & 3] : ud[w & 3];
        d0 = __builtin_amdgcn_fdot2(__builtin_amdgcn_cvt_scalef32_pk_f16_fp4(uw, 1.0f, 0), __builtin_bit_cast(h2v, xq0), d0, false);
        d1 = __builtin_amdgcn_fdot2(__builtin_amdgcn_cvt_scalef32_pk_f16_fp4(uw, 1.0f, 1), __builtin_bit_cast(h2v, xq1), d1, false);
        d2 = __builtin_amdgcn_fdot2(__builtin_amdgcn_cvt_scalef32_pk_f16_fp4(uw, 1.0f, 2), __builtin_bit_cast(h2v, xq2), d2, false);
        d3 = __builtin_amdgcn_fdot2(__builtin_amdgcn_cvt_scalef32_pk_f16_fp4(uw, 1.0f, 3), __builtin_bit_cast(h2v, xq3), d3, false);
    }
    const float dot = wave_sum_dpp((d0 + d1) + (d2 + d3)) * (1.0f / 128.0f);
    const float a = pg8::gelu_tanh(dot) * gate * (1.0f / PV_SCALE);
    const h2v a2 = {(_Float16)a, (_Float16)a};
#pragma unroll
    for (int w = 0; w < 4; ++w) {
        y[4 * w + 0] = a2 * __builtin_amdgcn_cvt_scalef32_pk_f16_fp4(va[w], 1.0f, 0) + y[4 * w + 0]; y[4 * w + 1] = a2 * __builtin_amdgcn_cvt_scalef32_pk_f16_fp4(va[w], 1.0f, 1) + y[4 * w + 1];
        y[4 * w + 2] = a2 * __builtin_amdgcn_cvt_scalef32_pk_f16_fp4(va[w], 1.0f, 2) + y[4 * w + 2]; y[4 * w + 3] = a2 * __builtin_amdgcn_cvt_scalef32_pk_f16_fp4(va[w], 1.0f, 3) + y[4 * w + 3];
    }
#pragma unroll
    for (int w = 0; w < 4; ++w) {
        y[16 + 4 * w + 0] = a2 * __builtin_amdgcn_cvt_scalef32_pk_f16_fp4(vd[w], 1.0f, 0) + y[16 + 4 * w + 0]; y[16 + 4 * w + 1] = a2 * __builtin_amdgcn_cvt_scalef32_pk_f16_fp4(vd[w], 1.0f, 1) + y[16 + 4 * w + 1];
        y[16 + 4 * w + 2] = a2 * __builtin_amdgcn_cvt_scalef32_pk_f16_fp4(vd[w], 1.0f, 2) + y[16 + 4 * w + 2]; y[16 + 4 * w + 3] = a2 * __builtin_amdgcn_cvt_scalef32_pk_f16_fp4(vd[w], 1.0f, 3) + y[16 + 4 * w + 3];
    }
}
__device__ __forceinline__ int sel_id(int id0, int id1, int e) { return (e < 64) ? __builtin_amdgcn_readlane(id0, e & 63) : __builtin_amdgcn_readlane(id1, e & 63); }
__device__ __forceinline__ float sel_gate(float g0, float g1, int e) { return __builtin_bit_cast(float, (e < 64) ? __builtin_amdgcn_readlane(__builtin_bit_cast(int, g0), e & 63) : __builtin_amdgcn_readlane(__builtin_bit_cast(int, g1), e & 63)); }
template <bool HALF>
__device__ __forceinline__ void peer_item(Frame& F, const int tok, const int half, const int ti) {
    const bf16* h1b = (const bf16*)(F.ws + WS_H1B);
    const unsigned char* PU = F.ws + WS_PU; const unsigned char* PV = F.ws + WS_PV;
    const int* seli = (const int*)(F.ws + WS_SELI); const float* selg = (const float*)(F.ws + WS_SELG);
    const GAS float* lg0 = (const GAS float*)F.in[I_LNFG]; const GAS float* lb0 = (const GAS float*)F.in[I_LNFB];
    unsigned lseed = 0u; asm volatile("" : "+v"(lseed)); const int lane = (int)__builtin_amdgcn_mbcnt_hi(~0u, __builtin_amdgcn_mbcnt_lo(~0u, lseed));
    h2v y16[32];
    f32x2v y[32];
    LAS unsigned char* xl = F.lds + RING_OFF + F.wave * 8192 + lane * 16;
    { LAS unsigned char* xw_ = xl; const GAS bf16* xr = (const GAS bf16*)(h1b + (size_t)tok * D) + lane;
#pragma unroll
      for (int k = 0; k < 32; ++k) { const h2v xp = {(_Float16)__builtin_bit_cast(float, (unsigned)xr[(2 * k) * 64] << 16), (_Float16)__builtin_bit_cast(float, (unsigned)xr[(2 * k + 1) * 64] << 16)};
          *(LAS h2v*)(xw_ + (k >> 2) * 1024 + (k & 3) * 4) = xp; y16[k] = (h2v){(_Float16)0.f, (_Float16)0.f}; } }
    asm volatile("" : "+v"(xl));
    const int ida = seli[(size_t)tok * 128 + lane], idb = seli[(size_t)tok * 128 + 64 + lane];
    const float g0 = selg[(size_t)tok * 128 + lane], g1 = selg[(size_t)tok * 128 + 64 + lane];
    int id0, id1, sl0, sl1;
    {   const unsigned k0 = (unsigned)ida * 128u + (unsigned)lane, k1 = (unsigned)idb * 128u + 64u + (unsigned)lane;
        int r0 = 0, r1 = 0;
#pragma unroll 8
        for (int j = 0; j < 64; ++j) {
            const unsigned a = (unsigned)__builtin_amdgcn_readlane((int)k0, j), b = (unsigned)__builtin_amdgcn_readlane((int)k1, j);
            r0 += (int)(a < k0) + (int)(b < k0); r1 += (int)(a < k1) + (int)(b < k1);
        }
        LAS unsigned* sk = (LAS unsigned*)(F.lds + RING_OFF + 65536 + F.wave * 512);
        sk[r0] = k0; sk[r1] = k1;
        asm volatile("s_waitcnt lgkmcnt(0)" ::: "memory");
        const unsigned s0k = sk[lane], s1k = sk[64 + lane];
        asm volatile("s_waitcnt lgkmcnt(0)" ::: "memory");
        id0 = (int)(s0k >> 7); id1 = (int)(s1k >> 7); sl0 = (int)(s0k & 127u); sl1 = (int)(s1k & 127u);
    }
    constexpr int NE = HALF ? 64 : DBG_NEXPERTS;
    const int idh = half ? id1 : id0, slh = half ? sl1 : sl0;
#define PEER_ID(e) (HALF ? __builtin_amdgcn_readlane(idh, (e) & 63) : sel_id(id0, id1, (e)))
#define PEER_GT(e) sel_gate(g0, g1, (HALF ? __builtin_amdgcn_readlane(slh, (e) & 63) : sel_id(sl0, sl1, (e))))
    PEER_DECL(s0); PEER_DECL(s1); PEER_DECL(s2);
    PEER_LOAD(s0, PEER_ID(0));
    PEER_LOAD(s1, PEER_ID(1));
#pragma unroll 1
    for (int e = 0; e < NE - 2; e += 3) {
        PEER_LOAD(s2, PEER_ID(e + 2));
        PEER_RUN(s0, PEER_GT(e));
        PEER_LOAD(s0, PEER_ID(e + 3));
        PEER_RUN(s1, PEER_GT(e + 1));
        PEER_LOAD(s1, PEER_ID((e + 4) & (NE - 1)));
        PEER_RUN(s2, PEER_GT(e + 2));
    }
    if (HALF) { PEER_RUN(s0, PEER_GT(63)); }
    else if (DBG_NEXPERTS == 128) { PEER_RUN(s0, PEER_GT(126)); PEER_RUN(s1, PEER_GT(127)); }
#undef PEER_ID
#undef PEER_GT
#pragma unroll
    for (int k = 0; k < 32; ++k) y[k] = __builtin_convertvector(y16[k], f32x2v);
    if (HALF) {
        gu64* yp = (gu64*)(F.ws + WS_YP) + (size_t)(ti * 2 + half) * 2048 + lane;
#pragma unroll
        for (int k = 0; k < 32; ++k) __hip_atomic_store(yp + k * 64, __builtin_bit_cast(unsigned long long, y[k]), __ATOMIC_RELAXED, __HIP_MEMORY_SCOPE_AGENT);
        asm volatile("s_waitcnt vmcnt(0)" ::: "memory");
        unsigned old = 0u;
        if (lane == 0) old = __hip_atomic_fetch_add(F.ctl + CW_DONE + ti, 1u, __ATOMIC_RELAXED, __HIP_MEMORY_SCOPE_AGENT);
        old = (unsigned)__builtin_amdgcn_readfirstlane((int)old);
        if (old == 0u) return;
        __builtin_amdgcn_fence(__ATOMIC_ACQUIRE, "agent");
        const GAS f32x2v* op = (const GAS f32x2v*)(F.ws + WS_YP) + (size_t)(ti * 2 + (half ^ 1)) * 2048 + lane;
#pragma unroll
        for (int k = 0; k < 32; ++k) y[k] = y[k] + op[k * 64];
    }
    float s = 0.f;
    asm volatile("" : "+v"(xl));
#pragma unroll
    for (int k = 0; k < 32; ++k) { const f32x2v xw = __builtin_convertvector(*(const LAS h2v*)(xl + (k >> 2) * 1024 + (k & 3) * 4), f32x2v); y[k] = xw * ALPHA + y[k]; s += y[k].x + y[k].y; }
    const float mean = wave_sum_dpp(s) * (1.f / D); float s2 = 0.f;
#pragma unroll
    for (int k = 0; k < 32; ++k) { y[k] = y[k] - mean; s2 += y[k].x * y[k].x + y[k].y * y[k].y; }
    const float rstd = 1.f / sqrtf(wave_sum_dpp(s2) * (1.f / D) + LN_EPS);
    GAS float* orow = (GAS float*)(F.out + (size_t)tok * D) + lane;
    const GAS float* lgp = lg0 + lane; const GAS float* lbp = lb0 + lane;
#pragma unroll
    for (int k = 0; k < 32; ++k) {
        const float o0 = y[k].x * rstd * lgp[(2 * k) * 64] + lbp[(2 * k) * 64], o1 = y[k].y * rstd * lgp[(2 * k + 1) * 64] + lbp[(2 * k + 1) * 64];
        orow[(2 * k) * 64] = o0; orow[(2 * k + 1) * 64] = o1;
    }
}
__device__ __forceinline__ void p9_peer(Frame& F) {
    const int gw = F.vcu * NWAVES + F.wave, NGW = F.G * NWAVES;
    const int rounds = T / NGW > 1 ? T / NGW - 1 : 0;
    const int n_static = rounds * NGW;
#pragma unroll 1
    for (int tok = gw; tok < n_static; tok += NGW) peer_item<false>(F, tok, 0, 0);
    const int n_items = 2 * (T - n_static), per = (n_items + P11_NSH - 1) / P11_NSH;
    int sh = gw % P11_NSH;
#pragma unroll 1
    for (int tries = 0; tries < P11_NSH;) {
        unsigned t = 0u;
        if (F.lane == 0) t = __hip_atomic_fetch_add(F.ctl + CW_P11 + sh * 32, 1u, __ATOMIC_RELAXED, __HIP_MEMORY_SCOPE_AGENT);
        t = (unsigned)__builtin_amdgcn_readfirstlane((int)t);
        const int item = sh * per + (int)t;
        if ((int)t >= per || item >= n_items) { sh = (sh + 1 == P11_NSH) ? 0 : sh + 1; ++tries; continue; }
        peer_item<true>(F, n_static + (item >> 1), item & 1, item >> 1);
    }
}

struct Args { const float* in[23]; float* out; unsigned char* ws; int ph_lo, ph_hi, li, pad; };
__global__ void __launch_bounds__(NWAVES * 64, 2) fwd_kernel(Args args) {
    extern __shared__ __attribute__((aligned(16))) unsigned char lds[];
    Frame F;
    F.lds = (LAS unsigned char*)lds;
    F.MISC = (volatile LAS unsigned*)(F.lds + MISC_OFF);
    F.tid = threadIdx.x; F.lane = F.tid & 63; F.wave = __builtin_amdgcn_readfirstlane(F.tid >> 6);
    F.G = gridDim.x; { const int bx = blockIdx.x; F.vcu = (F.G % 8 == 0) ? (bx % 8) * (F.G / 8) + bx / 8 : bx; }
    F.ws = args.ws; F.out = args.out;
    F.ctl = (gu32*)(args.ws + WS_CTL);
#pragma unroll
    for (int i = 0; i < 23; ++i) F.in[i] = args.in[i];
    for (int u = F.tid; u < (LDS_BYTES - LDSCTL_OFF) / 4; u += NWAVES * 64) ((LAS unsigned*)(F.lds + LDSCTL_OFF))[u] = 0u;
    __syncthreads();
    XcdBarrier bar; bar.bar = (unsigned*)(F.ctl + CW_BAR); bar.x = 0; bar.st = nullptr;
    if (N_LAUNCHES == 1) bar = xcd_barrier_post((unsigned*)(F.ctl + CW_BAR), F.MISC + 8);
#define PROBE_ON (DBG_PROBE_A >= 0 || DBG_PROBE_B >= 0)
    int n_stamp = 0;
#define STAMP() do { if (PROBE_ON && blockIdx.x == 0 && F.tid == 0) { ((unsigned long long*)(args.ws + 8192))[n_stamp] = __builtin_amdgcn_s_memrealtime(); } ++n_stamp; } while (0)
    STAMP();
#define GRID_BAR() do { if (N_LAUNCHES == 1) xcd_barrier(bar); STAMP(); if (PROBE_ON && blockIdx.x == 0 && F.tid == 0) ((unsigned long long*)(args.ws + 8192 + 512))[n_stamp - 1] = __builtin_amdgcn_s_memtime(); } while (0)
    const int lo = args.ph_lo, hi = args.ph_hi;
#ifndef PHASE_MASK
#define PHASE_MASK 0xfff
#endif
#define IN(k) (((PHASE_MASK >> (k)) & 1) && lo <= (k) && (k) < hi)
#define BOTH(k) (IN(k) && IN((k) + 1))
    unsigned char* ws = args.ws;

    if (IN(0)) { p0_prologue(F); if (BOTH(0)) GRID_BAR(); }

    if (IN(1)) {
        pg8::Gemm g{(const pg8::bf16_t*)(ws + WS_XA), (const pg8::bf16_t*)(ws + WS_WALL), MALL, NALL, D / 2, 127, 121, P1_PITCH / 2};
        const int nconv = (F.G % 8 == 0 && F.G >= 64) ? F.G / 8 : 0, GG = F.G - nconv;
        pg8::SchedP1 S; S.init(GG, (int)blockIdx.x);
        pg8::EpiProj E{(pg8::bf16_t*)(ws + WS_PROJ), (pg8::bf16_t*)(ws + WS_GATES), (pg8::bf16_t*)(ws + WS_MKV), F.in[I_BGATE], (const float*)(ws + WS_ROPE)};
        if ((int)blockIdx.x < GG) pg8::gemm_phase<pg8::EpiProj, pg8::SchedP1, PG8_ALIGN, PG8_SP2, 1>(F.lds + RING_OFF, g, S, E);
        if ((int)blockIdx.x < GG) {
            pg8::Gemm g4{(const pg8::bf16_t*)(ws + WS_XA4), (const pg8::bf16_t*)(ws + WS_WG4), T, GATEW, D / 4, 126, 120, P1B_PITCH / 2};
            pg8::StaticOrder S4; S4.init(T, GATEW, GG, (int)blockIdx.x);
            pg8::EpiGate E4{E};
            pg8::gemm_phase<pg8::EpiGate, pg8::StaticOrder, PG8_ALIGN, PG8_SP2, 2>(F.lds + RING_OFF, g4, S4, E4);
        }
        peer_tables_convert(F);
        if (BOTH(1)) GRID_BAR();
    }

    if (IN(2)) { p2_mixers(F); if (BOTH(2)) GRID_BAR(); }

    if (IN(3)) { p3_merge(F); if (BOTH(3)) GRID_BAR(); }

    if (IN(4)) {
        pg8::StaticOrder S; S.init(T, D, F.G, (int)blockIdx.x);
        pg8::Gemm g{(const pg8::bf16_t*)(ws + WS_AOUT), (const pg8::bf16_t*)(ws + WS_WBRA), T, D, ACT_PITCH / 2, 124, 121};
        pg8::EpiMerge3 E{(const unsigned char*)(ws + WS_GATES), (pg8::bf16_t*)(ws + WS_MERGEDB)};
        pg8::gemm_phase<pg8::EpiMerge3, pg8::StaticOrder, PG8_ALIGN, PG8_SP2, 1>(F.lds + RING_OFF, g, S, E);
        if (BOTH(4)) GRID_BAR();
    }

    if (IN(7)) {
        pg8::Gemm g{(const pg8::bf16_t*)(ws + (DBG_P5A == 1 ? WS_XA : (DBG_P5A == 2 ? WS_PROJ : (DBG_P5A == 3 ? WS_AOUT : (DBG_P5A == 4 ? WS_GATES : (DBG_P5A == 5 ? WS_GATES + 128 * MiB : WS_MERGEDB)))))), (const pg8::bf16_t*)(ws + WS_WOUT), T, D, D / 2, 124, 121};
        pg8::StaticOrder S; S.init(T, D, F.G, (int)blockIdx.x);
        pg8::EpiResid E{F.in[I_X], (pg8::bf16_t*)(ws + WS_Z), ALPHA};
        pg8::gemm_phase<pg8::EpiResid, pg8::StaticOrder, PG8_ALIGN, PG8_SP2, 1>(F.lds + RING_OFF, g, S, E);
        if (BOTH(7)) GRID_BAR();
    }

    if (IN(8)) { p6_layernorm(F); if (BOTH(8)) GRID_BAR(); }

    if (IN(9)) {
        pg8::Gemm g{(const pg8::bf16_t*)(ws + WS_H1B), (const pg8::bf16_t*)(ws + WS_WQ), T, 2048, D};
        pg8::StaticOrder S; S.init(T, 2048, F.G, (int)blockIdx.x);
        pg8::EpiPlain E{(pg8::bf16_t*)(ws + WS_Q), 2048};
        pg8::gemm_phase<pg8::EpiPlain, pg8::StaticOrder, PG8_ALIGN, PG8_SP2>(F.lds + RING_OFF, g, S, E);
        if (BOTH(9)) GRID_BAR();
    }

    if (IN(10)) { p8_topk(F); if (BOTH(10)) GRID_BAR(); }

    if (IN(11)) { p9_peer(F); }
#undef IN
#undef BOTH
#undef GRID_BAR
}

extern "C" void kernel_launch(void* const* d_in, const int* in_sizes, int n_in, void* d_out, int out_size, void* d_ws, size_t ws_size, hipStream_t stream) {
    static int grid = 0;
    if (grid == 0) {
        if (n_in != 23 || in_sizes[0] != T * D || out_size != T * D || ws_size < WS_END) { fprintf(stderr, "kernel_launch: unexpected shapes (n_in %d, in0 %d, out %d, ws %zu); nothing launched\n", n_in, n_in > 0 ? in_sizes[0] : -1, out_size, ws_size); grid = -1; return; }
        int dev = 0, cus = 0, per_cu = 0;
        if (hipGetDevice(&dev) != hipSuccess || hipDeviceGetAttribute(&cus, hipDeviceAttributeMultiprocessorCount, dev) != hipSuccess) { grid = -1; return; }
        if (hipFuncSetAttribute((const void*)fwd_kernel, hipFuncAttributeMaxDynamicSharedMemorySize, LDS_BYTES) != hipSuccess) { fprintf(stderr, "kernel_launch: hipFuncSetAttribute failed\n"); grid = -1; return; }
        if (hipOccupancyMaxActiveBlocksPerMultiprocessor(&per_cu, (const void*)fwd_kernel, NWAVES * 64, LDS_BYTES) != hipSuccess || per_cu < 1)
            fprintf(stderr, "kernel_launch: note: occupancy query reports %d workgroups per CU\n", per_cu);
        (void)hipGetLastError();
        grid = cus;
    }
    if (grid < 0) return;
    if (hipMemsetAsync((char*)d_ws + WS_CTL, 0, CTL_ZERO_BYTES, stream) != hipSuccess) return;
    Args a{};
    for (int i = 0; i < 23; ++i) a.in[i] = (const float*)d_in[i];
    a.out = (float*)d_out; a.ws = (unsigned char*)d_ws; a.pad = 0;
    for (int li = 0; li < N_LAUNCHES; ++li) {
        a.ph_lo = (N_LAUNCHES == 1) ? 0 : li; a.ph_hi = (N_LAUNCHES == 1) ? N_PHASES : li + 1; a.li = li;
        hipLaunchKernelGGL(fwd_kernel, dim3(grid), dim3(NWAVES * 64), LDS_BYTES, stream, a);
        if (hipPeekAtLastError() != hipSuccess) break;
    }
}
```

```cpp
#include <hip/hip_runtime.h>
#include <cstdio>
#include <cstdint>
#ifndef DBG_NEXPERTS
#define DBG_NEXPERTS 128
#endif
#ifndef DBG_MIXSCALE
#define DBG_MIXSCALE 1.0f
#endif
#ifndef DBG_BR
#define DBG_BR 7
#endif
#ifndef DBG_P5A
#define DBG_P5A 0
#endif
#ifndef DBG_P4SRC
#define DBG_P4SRC 0
#endif
#ifndef DBG_ZALT
#define DBG_ZALT 0
#endif
#ifndef DBG_GATEPLAIN
#define DBG_GATEPLAIN 0
#endif
#ifndef DBG_PROBE_A
#define DBG_PROBE_A -1
#endif
#ifndef DBG_PROBE_B
#define DBG_PROBE_B -1
#endif
#ifndef DBG_P2SKIP
#define DBG_P2SKIP 0
#endif
#ifndef DBG_HALFMMA
#define DBG_HALFMMA 0
#endif
#ifndef DBG_PEER_NT
#define DBG_PEER_NT 0
#endif
namespace pg8 {
#define PG8_LAS __attribute__((address_space(3)))
typedef unsigned short bf16_t;
typedef short bf16x8 __attribute__((ext_vector_type(8)));
typedef float f32x4 __attribute__((ext_vector_type(4)));
typedef unsigned u32x4 __attribute__((ext_vector_type(4)));
constexpr int BM = 256, BK = 64, HALF = 128, HTB = HALF * BK * 2  , STAGE_BYTES = 8 * HTB, NXCD = 8, WGM = 8;

__host__ __device__ __forceinline__ int lds_byte(int r, int c) { const int st = (r >> 4) * 2 + (c >> 5), rr = r & 15, cc = c & 31, ob = rr * 64 + cc * 2; return st * 1024 + (ob ^ (((ob >> 9) & 1) << 5)); }
__host__ __device__ __forceinline__ void stage_rc(int b, int& R, int& C) { const int st = b / 1024, sb = b % 1024, swz = sb ^ (((sb >> 9) & 1) << 5); R = (st >> 1) * 16 + swz / 64; C = (st & 1) * 32 + (swz % 64) / 2; }
__host__ __device__ __forceinline__ int perm32(int rho) { const int n = rho >> 4, i = rho & 15; return 8 * (i >> 2) + 4 * n + (i & 3); }

struct Unit { int pm, pn; };
struct Gemm { const bf16_t* A; const bf16_t* Bt; int M, N, K; int sA, sB; int ld; };

struct StaticOrder {
    int nM, nN, nwg, G, c;
    __host__ __device__ void init(int M, int N, int G_, int c_) { nM = M / BM; nN = N / BM; nwg = nM * nN; G = G_; c = c_; }
    __host__ __device__ bool next(int i, Unit& u) const {
        const long L = (long)i * G + c; if (L >= nwg) return false;
        int wgid = (int)L; { const int q = nwg / NXCD, r = nwg % NXCD, xcd = wgid % NXCD, off = wgid / NXCD; wgid = (xcd < r ? xcd * (q + 1) : r * (q + 1) + (xcd - r) * q) + off; }
        const int nig = WGM * nN, gid = wgid / nig, fm = gid * WGM, gsz = (nM - fm) < WGM ? (nM - fm) : WGM;
        u.pm = fm + ((wgid % nig) % gsz); u.pn = (wgid % nig) / gsz; return true;
    }
    __device__ __forceinline__ void a_ready(const Unit&) const {}
    __device__ __forceinline__ void done(const Unit&) const {}
};

__device__ __forceinline__ unsigned pk4_fp8(float a, float b, float c, float d) { a = __builtin_amdgcn_fmed3f(a, -448.f, 448.f); b = __builtin_amdgcn_fmed3f(b, -448.f, 448.f); c = __builtin_amdgcn_fmed3f(c, -448.f, 448.f); d = __builtin_amdgcn_fmed3f(d, -448.f, 448.f);
    int w = 0; w = __builtin_amdgcn_cvt_pk_fp8_f32(a, b, w, false); w = __builtin_amdgcn_cvt_pk_fp8_f32(c, d, w, true); return (unsigned)w; }
typedef __bf16 bf16x2_t __attribute__((ext_vector_type(2)));
typedef float f32x2_t __attribute__((ext_vector_type(2)));
__device__ __forceinline__ unsigned cvt_pk_bf16(float lo, float hi) { const bf16x2_t r = __builtin_convertvector((f32x2_t){lo, hi}, bf16x2_t); return __builtin_bit_cast(unsigned, r); }
typedef float f32x2 __attribute__((ext_vector_type(2)));
typedef float f32x4u __attribute__((ext_vector_type(4), aligned(16)));
__device__ __forceinline__ float gelu_tanh(float x) {
    const float u = x * (1.5957691216f + 0.0713548163f * x * x);
    const float e = __builtin_amdgcn_exp2f(-1.4426950409f * u);
    return x * __builtin_amdgcn_rcpf(1.0f + e);
}
__device__ __forceinline__ float sigmoid_f(float x) { return __builtin_amdgcn_rcpf(1.0f + __builtin_amdgcn_exp2f(-1.4426950409f * x)); }
__device__ __forceinline__ u32x4 pack8(const f32x4& v0, const f32x4& v1) { u32x4 w; w.x = cvt_pk_bf16(v0[0], v0[1]); w.y = cvt_pk_bf16(v0[2], v0[3]); w.z = cvt_pk_bf16(v1[0], v1[1]); w.w = cvt_pk_bf16(v1[2], v1[3]); return w; }
__device__ __forceinline__ float bf_lo(unsigned w) { return __builtin_bit_cast(float, w << 16); }
__device__ __forceinline__ float bf_hi(unsigned w) { return __builtin_bit_cast(float, w & 0xffff0000u); }

struct EpiProj {
    static constexpr bool PERM = true, AFTER_DRAIN = false, MIDK = false; static constexpr int T1 = -1, T2 = -1;
    bf16_t* proj; bf16_t* gates; bf16_t* mkv; const float* bgate; const float* rope;
    template <int KIND> __device__ __forceinline__ void tile(const f32x4 (&acc)[2][2][4][2], bf16_t* base, int ldc, int row0, int cb, float sc, const float* bias) const {
        f32x4 bv[2][2];
        if (KIND == 3) {
#pragma unroll
            for (int bj = 0; bj < 2; ++bj)
#pragma unroll
                for (int n = 0; n < 2; ++n) bv[bj][n] = *(const f32x4*)(bias + bj * HALF + 4 * n);
        }
#pragma unroll
        for (int ai = 0; ai < 2; ++ai)
#pragma unroll
            for (int m = 0; m < 4; ++m) {
                const int row = row0 + ai * HALF + m * 16;
                bf16_t* rowp = base + (size_t)row * ldc;
                f32x4 r0, r1;
                if (KIND == 1) { const float* rp = rope + (size_t)row * 128 + cb; r0 = *(const f32x4*)rp; r1 = *(const f32x4*)(rp + 4); }
#pragma unroll
                for (int bj = 0; bj < 2; ++bj) {
                    f32x4 v0 = acc[ai][bj][m][0], v1 = acc[ai][bj][m][1];
                    if (KIND == 0) {
#pragma unroll
                        for (int j = 0; j < 4; ++j) { v0[j] = gelu_tanh(v0[j]); v1[j] = gelu_tanh(v1[j]); }
                    } else if (KIND == 1) {
                        f32x4 a0, a1;
                        a0[0] = v0[0] * r0[0] - v0[1] * r0[1]; a0[1] = v0[1] * r0[0] + v0[0] * r0[1];
                        a0[2] = v0[2] * r0[2] - v0[3] * r0[3]; a0[3] = v0[3] * r0[2] + v0[2] * r0[3];
                        a1[0] = v1[0] * r1[0] - v1[1] * r1[1]; a1[1] = v1[1] * r1[0] + v1[0] * r1[1];
                        a1[2] = v1[2] * r1[2] - v1[3] * r1[3]; a1[3] = v1[3] * r1[2] + v1[2] * r1[3];
                        v0 = a0 * sc; v1 = a1 * sc;
                    } else if (KIND == 2) { v0 = v0 * sc; v1 = v1 * sc;
                    } else if (KIND == 3) {
                        v0 = v0 + bv[bj][0]; v1 = v1 + bv[bj][1];
#pragma unroll
                        for (int j = 0; j < 4; ++j) { v0[j] = sigmoid_f(v0[j]); v1[j] = sigmoid_f(v1[j]); }
                    }
                    if (KIND == 3) { typedef unsigned u32x2 __attribute__((ext_vector_type(2))); u32x2 w8; w8.x = pk4_fp8(v0[0], v0[1], v0[2], v0[3]); w8.y = pk4_fp8(v1[0], v1[1], v1[2], v1[3]);
                        __builtin_nontemporal_store(w8, (u32x2*)((unsigned char*)base + (size_t)row * ldc + bj * HALF)); }
                    else __builtin_nontemporal_store(pack8(v0, v1), (u32x4*)(rowp + bj * HALF));
                }
            }
    }
    __device__ __forceinline__ void operator()(const f32x4 (&acc)[2][2][4][2], const Unit& u, int wr, int wc, int fr, int fq) const {
        int row0 = u.pm * BM + wr * 64 + fr, cw = wc * 32 + 8 * fq;
        asm volatile("" : "+v"(row0), "+v"(cw));
        if (u.pm >= 32) { tile<2>(acc, mkv + (u.pn - 82) * BM + cw, 2048, row0 - 8192, 0, 1.0f, nullptr); }
        else if (u.pn < 12) { tile<0>(acc, proj + u.pn * BM + cw, 8704, row0, 0, 1.0f, nullptr); }
        else if (u.pn < 24) { tile<1>(acc, proj + u.pn * BM + cw, 8704, row0, cw, u.pn < 18 ? 0.08838834764831845f : 1.0f, nullptr); }
        else if (u.pn < 34) { tile<2>(acc, proj + u.pn * BM + cw, 8704, row0, 0, u.pn >= 30 ? 0.0625f : 1.0f, nullptr); }
        else { const int cg = (u.pn - 34) * BM + cw; tile<3>(acc, (bf16_t*)((unsigned char*)gates + cg), 12288, row0, 0, 1.0f, bgate + cg); }
    }
};
struct EpiGate {
    static constexpr bool PERM = true, AFTER_DRAIN = false, MIDK = false; static constexpr int T1 = -1, T2 = -1;
    EpiProj P;
    __device__ __forceinline__ void operator()(const f32x4 (&acc)[2][2][4][2], const Unit& u, int wr, int wc, int fr, int fq) const { Unit v = u; v.pn = u.pn + 34; P(acc, v, wr, wc, fr, fq); }
};

template <int STEP> struct EpiMerge {
    static constexpr bool PERM = true, AFTER_DRAIN = false, MIDK = false; static constexpr int T1 = -1, T2 = -1;
    const unsigned char* gates; bf16_t* merged; bf16_t* mergedb;
    __device__ __forceinline__ void operator()(const f32x4 (&acc)[2][2][4][2], const Unit& u, int wr, int wc, int fr, int fq) const {
        typedef unsigned u32x2 __attribute__((ext_vector_type(2))); typedef float f32x2e __attribute__((ext_vector_type(2)));
        const int row0 = u.pm * BM + wr * 64 + fr, col0 = u.pn * BM + wc * 32 + 8 * fq;
#pragma unroll
        for (int ai = 0; ai < 2; ++ai)
#pragma unroll
            for (int m = 0; m < 4; ++m) {
                const size_t row = (size_t)(row0 + ai * HALF + m * 16);
#pragma unroll
                for (int bj = 0; bj < 2; ++bj) {
                    const int col = col0 + bj * HALF;
                    const u32x2 g = *(const u32x2*)(gates + row * 12288 + col);
                    const f32x2e g0 = __builtin_amdgcn_cvt_pk_f32_fp8((int)g.x, false), g1 = __builtin_amdgcn_cvt_pk_f32_fp8((int)g.x, true), g2 = __builtin_amdgcn_cvt_pk_f32_fp8((int)g.y, false), g3 = __builtin_amdgcn_cvt_pk_f32_fp8((int)g.y, true);
                    f32x4 v0 = acc[ai][bj][m][0], v1 = acc[ai][bj][m][1];
                    if (!((DBG_BR >> STEP) & 1)) { v0 = v0 * 0.f; v1 = v1 * 0.f; }
                    v0[0] *= g0.x; v0[1] *= g0.y; v0[2] *= g1.x; v0[3] *= g1.y; v1[0] *= g2.x; v1[1] *= g2.y; v1[2] *= g3.x; v1[3] *= g3.y;
                    bf16_t* mp = merged + row * 4096 + col;
                    if (STEP > 0) { const u32x4 pm = *(const u32x4*)mp; v0[0] += bf_lo(pm.x); v0[1] += bf_hi(pm.x); v0[2] += bf_lo(pm.y); v0[3] += bf_hi(pm.y); v1[0] += bf_lo(pm.z); v1[1] += bf_hi(pm.z); v1[2] += bf_lo(pm.w); v1[3] += bf_hi(pm.w); }
                    if (STEP < 2) *(u32x4*)mp = pack8(v0, v1);
                    else { v0 = v0 * 8.0f; v1 = v1 * 8.0f; u32x2 w8; w8.x = pk4_fp8(v0[0], v0[1], v0[2], v0[3]); w8.y = pk4_fp8(v1[0], v1[1], v1[2], v1[3]);
                        *(u32x2*)((unsigned char*)mergedb + row * 4096 + col) = w8; }
                }
            }
    }
};

struct EpiMerge3 {
    static constexpr bool PERM = true, AFTER_DRAIN = false, MIDK = true; static constexpr int T1 = 12, T2 = 16;
    const unsigned char* gates; bf16_t* mergedb;
    typedef unsigned u32x2 __attribute__((ext_vector_type(2))); typedef float f32x2e __attribute__((ext_vector_type(2)));
    static __device__ __forceinline__ void gate8(const unsigned char* p, f32x4& a, f32x4& b) {
        const u32x2 g = *(const u32x2*)p;
        const f32x2e g0 = __builtin_amdgcn_cvt_pk_f32_fp8((int)g.x, false), g1 = __builtin_amdgcn_cvt_pk_f32_fp8((int)g.x, true), g2 = __builtin_amdgcn_cvt_pk_f32_fp8((int)g.y, false), g3 = __builtin_amdgcn_cvt_pk_f32_fp8((int)g.y, true);
        a = (f32x4){fmaxf(g0.x, 0.001953125f), fmaxf(g0.y, 0.001953125f), fmaxf(g1.x, 0.001953125f), fmaxf(g1.y, 0.001953125f)};
        b = (f32x4){fmaxf(g2.x, 0.001953125f), fmaxf(g2.y, 0.001953125f), fmaxf(g3.x, 0.001953125f), fmaxf(g3.y, 0.001953125f)};
    }
    static __device__ __forceinline__ void gate8w(const u32x2 g, f32x4& a, f32x4& b) {
        const f32x2e g0 = __builtin_amdgcn_cvt_pk_f32_fp8((int)g.x, false), g1 = __builtin_amdgcn_cvt_pk_f32_fp8((int)g.x, true), g2 = __builtin_amdgcn_cvt_pk_f32_fp8((int)g.y, false), g3 = __builtin_amdgcn_cvt_pk_f32_fp8((int)g.y, true);
        a = (f32x4){fmaxf(g0.x, 0.001953125f), fmaxf(g0.y, 0.001953125f), fmaxf(g1.x, 0.001953125f), fmaxf(g1.y, 0.001953125f)};
        b = (f32x4){fmaxf(g2.x, 0.001953125f), fmaxf(g2.y, 0.001953125f), fmaxf(g3.x, 0.001953125f), fmaxf(g3.y, 0.001953125f)};
    }
    __device__ __forceinline__ void midk(f32x4 (&acc)[2][2][4][2], const Unit& u, int t, int wr, int wc, int fr, int fq) const {
        int row0 = u.pm * BM + wr * 64 + fr, col0 = u.pn * BM + wc * 32 + 8 * fq; const int b = (t == T1) ? 0 : 1;
        asm volatile("" : "+v"(row0), "+v"(col0));
#pragma unroll
        for (int ai = 0; ai < 2; ++ai) {
            u32x2 gn[4][2], gd[4][2];
#pragma unroll
            for (int m = 0; m < 4; ++m)
#pragma unroll
                for (int bj = 0; bj < 2; ++bj) {
                    const unsigned char* gp = gates + (size_t)(row0 + ai * HALF + m * 16) * 12288 + b * 4096 + col0 + bj * HALF;
                    gn[m][bj] = *(const u32x2*)gp; gd[m][bj] = *(const u32x2*)(gp + 4096);
                }
            __builtin_amdgcn_sched_barrier(0);
#pragma unroll
            for (int m = 0; m < 4; ++m)
#pragma unroll
                for (int bj = 0; bj < 2; ++bj) {
                    f32x4 n0, n1, d0, d1; gate8w(gn[m][bj], n0, n1); gate8w(gd[m][bj], d0, d1);
#pragma unroll
                    for (int j = 0; j < 4; ++j) { acc[ai][bj][m][0][j] *= n0[j] * __builtin_amdgcn_rcpf(d0[j]); acc[ai][bj][m][1][j] *= n1[j] * __builtin_amdgcn_rcpf(d1[j]); }
                }
            __builtin_amdgcn_sched_barrier(0);
        }
    }
    __device__ __forceinline__ void operator()(const f32x4 (&acc)[2][2][4][2], const Unit& u, int wr, int wc, int fr, int fq) const {
        int row0 = u.pm * BM + wr * 64 + fr, col0 = u.pn * BM + wc * 32 + 8 * fq;
        asm volatile("" : "+v"(row0), "+v"(col0));
#pragma unroll
        for (int ai = 0; ai < 2; ++ai) {
            u32x2 gw[4][2];
#pragma unroll
            for (int m = 0; m < 4; ++m)
#pragma unroll
                for (int bj = 0; bj < 2; ++bj) gw[m][bj] = *(const u32x2*)(gates + (size_t)(row0 + ai * HALF + m * 16) * 12288 + 8192 + col0 + bj * HALF);
            __builtin_amdgcn_sched_barrier(0);
#pragma unroll
            for (int m = 0; m < 4; ++m) {
                const size_t row = (size_t)(row0 + ai * HALF + m * 16);
#pragma unroll
                for (int bj = 0; bj < 2; ++bj) {
                    const int col = col0 + bj * HALF;
                    f32x4 g0, g1; gate8w(gw[m][bj], g0, g1);
                    const f32x4 v0 = acc[ai][bj][m][0] * g0 * 8.0f, v1 = acc[ai][bj][m][1] * g1 * 8.0f;
                    u32x2 w8; w8.x = pk4_fp8(v0[0], v0[1], v0[2], v0[3]); w8.y = pk4_fp8(v1[0], v1[1], v1[2], v1[3]);
                    *(u32x2*)((unsigned char*)mergedb + row * 4096 + col) = w8;
                }
            }
            __builtin_amdgcn_sched_barrier(0);
        }
    }
};

struct EpiResid {
    static constexpr bool PERM = true, AFTER_DRAIN = false, MIDK = false; static constexpr int T1 = -1, T2 = -1;
    const float* x; bf16_t* z; float alpha;
    __device__ __forceinline__ void operator()(const f32x4 (&acc)[2][2][4][2], const Unit& u, int wr, int wc, int fr, int fq) const {
        int row0 = u.pm * BM + wr * 64 + fr, col0 = u.pn * BM + wc * 32 + 8 * fq;
        asm volatile("" : "+v"(row0), "+v"(col0));
#pragma unroll
        for (int ai = 0; ai < 2; ++ai)
#pragma unroll
            for (int mh = 0; mh < 2; ++mh) {
                f32x4 xv[2][2][2];
#pragma unroll
                for (int mm = 0; mm < 2; ++mm)
#pragma unroll
                    for (int bj = 0; bj < 2; ++bj) {
                        const size_t o = (size_t)(row0 + ai * HALF + (2 * mh + mm) * 16) * 4096 + col0 + bj * HALF;
                        xv[mm][bj][0] = __builtin_nontemporal_load((const f32x4*)(x + o)); xv[mm][bj][1] = __builtin_nontemporal_load((const f32x4*)(x + o + 4));
                    }
                __builtin_amdgcn_sched_barrier(0);
#pragma unroll
                for (int mm = 0; mm < 2; ++mm)
#pragma unroll
                    for (int bj = 0; bj < 2; ++bj) {
                        const int m = 2 * mh + mm;
                        const size_t o = (size_t)(row0 + ai * HALF + m * 16) * 4096 + col0 + bj * HALF;
                        *(u32x4*)(z + o) = pack8(xv[mm][bj][0] * alpha + acc[ai][bj][m][0] * DBG_MIXSCALE, xv[mm][bj][1] * alpha + acc[ai][bj][m][1] * DBG_MIXSCALE);
                    }
                __builtin_amdgcn_sched_barrier(0);
            }
    }
};

struct EpiPlain {
    static constexpr bool PERM = true, AFTER_DRAIN = false, MIDK = false; static constexpr int T1 = -1, T2 = -1;
    bf16_t* O; int ldc;
    __device__ __forceinline__ void operator()(const f32x4 (&acc)[2][2][4][2], const Unit& u, int wr, int wc, int fr, int fq) const {
        const int row0 = u.pm * BM + wr * 64 + fr, col0 = u.pn * BM + wc * 32 + 8 * fq;
#pragma unroll
        for (int ai = 0; ai < 2; ++ai)
#pragma unroll
            for (int m = 0; m < 4; ++m) {
                bf16_t* rowp = O + (size_t)(row0 + ai * HALF + m * 16) * ldc + col0;
#pragma unroll
                for (int bj = 0; bj < 2; ++bj) *(u32x4*)(rowp + bj * HALF) = pack8(acc[ai][bj][m][0], acc[ai][bj][m][1]);
            }
    }
};

struct SchedP1 {
    StaticOrder so;
    __host__ __device__ void init(int G_, int c_) { so.init(8192, 34 * 256, G_, c_); }
    __host__ __device__ bool next(int i, Unit& u) const {
        if (so.next(i, u)) return true;
        const long L = (long)i * so.G + so.c - so.nwg; if (L < 0 || L >= 16) return false;
        u.pm = 32 + (int)(L >> 3); u.pn = 82 + (int)(L & 7); return true;
    }
    __device__ __forceinline__ void a_ready(const Unit&) const {}
    __device__ __forceinline__ void done(const Unit&) const {}
};

typedef int i32x8 __attribute__((ext_vector_type(8)));
typedef int i32x4v __attribute__((ext_vector_type(4)));
__device__ __forceinline__ i32x8 cat8(const bf16x8& lo, const bf16x8& hi) { return __builtin_shufflevector(__builtin_bit_cast(i32x4v, lo), __builtin_bit_cast(i32x4v, hi), 0, 1, 2, 3, 4, 5, 6, 7); }
template <class Epi, class Sched, bool ALIGN_EPI = false, bool SP2 = false, int FP8 = 0>
__device__ __forceinline__ void gemm_phase(PG8_LAS unsigned char* lds, const Gemm g, const Sched& S, const Epi& E) {
    const int tid = threadIdx.x, wid = __builtin_amdgcn_readfirstlane(tid >> 6), lane = tid & 63, wr = wid >> 2, wc = wid & 3, fr = lane & 15, fq = lane >> 4;
    const int K = g.ld ? g.ld : g.K, nt = g.K / BK;
    unsigned voffA[2], voffB[2];
#pragma unroll
    for (int i = 0; i < 2; ++i) { int R, C; stage_rc(tid * 16 + i * 8192, R, C); const int Rb = Epi::PERM ? ((R & ~31) + perm32(R & 31)) : R;
        voffA[i] = (unsigned)(R * K + C) * 2u; voffB[i] = (unsigned)(Rb * K + C) * 2u; }
    const size_t kstep = (size_t)(BK * 2);
    const size_t hstep = (size_t)HALF * K * 2;
    const size_t tstep = 2 * hstep;
    const unsigned ldsw = (unsigned)wid * 1024u;
    const int aoff = lds_byte(wr * 64 + fr, fq * 8), boff = lds_byte(wc * 32 + fr, fq * 8);
#define PG8_SA(b, h) (((b) * 2 + (h)) * HTB)
#define PG8_SB(b, h) ((4 + (b) * 2 + (h)) * HTB)
#define PG8_STAGE(bufoff, gbase, voff) do { _Pragma("unroll") for (int _i = 0; _i < 2; ++_i) \
        __builtin_amdgcn_global_load_lds((const unsigned*)((const char*)(gbase) + (voff)[_i]), (PG8_LAS unsigned*)(lds + (bufoff) + ldsw + _i * 8192), 16, 0, 0); } while (0)
#define PG8_LDA(dst, b, h) do { _Pragma("unroll") for (int m = 0; m < 4; ++m) _Pragma("unroll") for (int k = 0; k < 2; ++k) dst[m][k] = *(const PG8_LAS bf16x8*)(lds + PG8_SA(b, h) + aoff + m * 2048 + k * 1024); } while (0)
#define PG8_LDB(dst, b, h) do { _Pragma("unroll") for (int n = 0; n < 2; ++n) _Pragma("unroll") for (int k = 0; k < 2; ++k) dst[n][k] = *(const PG8_LAS bf16x8*)(lds + PG8_SB(b, h) + boff + n * 2048 + k * 1024); } while (0)
#define PG8_MMA(ai, bj, At, Bt) do { __builtin_amdgcn_s_setprio(1); \
        if constexpr (FP8 == 2) { _Pragma("unroll") for (int k = 0; k < 2; ++k) _Pragma("unroll") for (int m = 0; m < 4; ++m) _Pragma("unroll") for (int n = 0; n < 2; ++n) \
            asm volatile("v_mfma_scale_f32_16x16x128_f8f6f4 %0, %1, %2, %0, %3, %4 op_sel_hi:[0,0,0] cbsz:4 blgp:4" : "+v"(acc[ai][bj][m][n]) : "v"(Bt[n][k]), "v"(At[m][k]), "v"(sclB), "v"(sclA)); } \
        else if constexpr (FP8 == 1) { _Pragma("unroll") for (int m = 0; m < (DBG_HALFMMA ? 2 : 4); ++m) _Pragma("unroll") for (int n = 0; n < 2; ++n) \
            asm volatile("v_mfma_scale_f32_16x16x128_f8f6f4 %0, %1, %2, %0, %3, %4 op_sel_hi:[0,0,0]" : "+v"(acc[ai][bj][m][n]) : "v"(cat8(Bt[n][0], Bt[n][1])), "v"(cat8(At[m][0], At[m][1])), "v"(sclB), "v"(sclA)); } \
        else { _Pragma("unroll") for (int m = 0; m < 4; ++m) _Pragma("unroll") for (int n = 0; n < 2; ++n) _Pragma("unroll") for (int k = 0; k < 2; ++k) \
            acc[ai][bj][m][n] = __builtin_amdgcn_mfma_f32_16x16x32_bf16(Bt[n][k], At[m][k], acc[ai][bj][m][n], 0, 0, 0); } \
        __builtin_amdgcn_s_setprio(0); } while (0)
#define PG8_WAIT_V(n) asm volatile("s_waitcnt vmcnt(" #n ")" ::: "memory")
#define PG8_WAIT_L(n) asm volatile("s_waitcnt lgkmcnt(" #n ")" ::: "memory")
#define PG8_BAR __builtin_amdgcn_s_barrier()
#define PG8_SCHED __builtin_amdgcn_sched_barrier(0)
    Unit cur, nxt; int ui = 0;
    if (!S.next(0, cur)) return;
    int sclA = g.sA, sclB = g.sB;
    if constexpr (FP8) asm volatile("" : "+v"(sclA), "+v"(sclB));
    f32x4 acc[2][2][4][2];
#pragma unroll
    for (int a = 0; a < 2; ++a)
#pragma unroll
        for (int b = 0; b < 2; ++b)
#pragma unroll
            for (int m = 0; m < 4; ++m)
#pragma unroll
                for (int n = 0; n < 2; ++n) acc[a][b][m][n] = (f32x4){0.f, 0.f, 0.f, 0.f};
    bf16x8 At[4][2], B0[2][2], B1[2][2];
    const char* cA = (const char*)g.A + (size_t)cur.pm * tstep; const char* cB = (const char*)g.Bt + (size_t)cur.pn * tstep;
    S.a_ready(cur);
    if constexpr (SP2) {
        PG8_STAGE(PG8_SB(0, 0), cB, voffB); PG8_STAGE(PG8_SB(0, 1), cB + hstep, voffB); PG8_STAGE(PG8_SA(0, 0), cA, voffA); PG8_STAGE(PG8_SA(0, 1), cA + hstep, voffA);
        if (wr == 1) PG8_BAR;
        PG8_WAIT_V(2); PG8_BAR;
        PG8_STAGE(PG8_SB(1, 0), cB + kstep, voffB); PG8_STAGE(PG8_SA(1, 0), cA + kstep, voffA); PG8_STAGE(PG8_SB(1, 1), cB + hstep + kstep, voffB);
        PG8_WAIT_V(6); PG8_BAR;
    } else {
        PG8_STAGE(PG8_SB(0, 0), cB, voffB); PG8_STAGE(PG8_SA(0, 0), cA, voffA); PG8_STAGE(PG8_SB(0, 1), cB + hstep, voffB); PG8_STAGE(PG8_SA(0, 1), cA + hstep, voffA);
        if (wr == 1) PG8_BAR;
        PG8_WAIT_V(4); PG8_BAR;
        PG8_STAGE(PG8_SB(1, 0), cB + kstep, voffB); PG8_STAGE(PG8_SA(1, 0), cA + kstep, voffA); PG8_STAGE(PG8_SB(1, 1), cB + hstep + kstep, voffB);
        PG8_WAIT_V(6); PG8_BAR;
    }
    for (;;) {
        const bool has_next = S.next(ui + 1, nxt);
        const char* nA = has_next ? (const char*)g.A + (size_t)nxt.pm * tstep : cA; const char* nB = has_next ? (const char*)g.Bt + (size_t)nxt.pn * tstep : cB;
        for (int t = 0; t < nt; t += 2) {
            const bool last = (t == nt - 2);
            const char* a1 = cA + (size_t)(t + 1) * kstep;
            const char* a2 = last ? nA : cA + (size_t)(t + 2) * kstep; const char* b2 = last ? nB : cB + (size_t)(t + 2) * kstep;
            const char* a3 = a2 + kstep; const char* b3 = b2 + kstep;
            if (last && has_next) S.a_ready(nxt);
            if constexpr (Epi::MIDK) { if (t == Epi::T1 || t == Epi::T2) { if constexpr (FP8) asm volatile("s_nop 15\n\ts_nop 15" ::: "memory"); E.midk(acc, cur, t, wr, wc, fr, fq); } }
            if constexpr (SP2) {
            PG8_LDB(B0, 0, 0); PG8_LDB(B1, 0, 1); PG8_SCHED; PG8_LDA(At, 0, 0); PG8_STAGE(PG8_SA(1, 1), a1 + hstep, voffA);
            PG8_WAIT_V(8); PG8_WAIT_L(0); PG8_BAR; PG8_MMA(0, 0, At, B0); PG8_MMA(0, 1, At, B1); PG8_BAR; PG8_SCHED;
            PG8_LDA(At, 0, 1); PG8_STAGE(PG8_SB(0, 0), b2, voffB); PG8_STAGE(PG8_SB(0, 1), b2 + hstep, voffB); PG8_STAGE(PG8_SA(0, 0), a2, voffA);
            PG8_WAIT_V(8); PG8_WAIT_L(0); PG8_BAR; PG8_MMA(1, 0, At, B0); PG8_MMA(1, 1, At, B1); PG8_BAR; PG8_SCHED;
            PG8_LDB(B0, 1, 0); PG8_LDB(B1, 1, 1); PG8_SCHED; PG8_LDA(At, 1, 0); PG8_STAGE(PG8_SA(0, 1), a2 + hstep, voffA);
            PG8_WAIT_V(8); PG8_WAIT_L(0); PG8_BAR; PG8_MMA(0, 0, At, B0); PG8_MMA(0, 1, At, B1); PG8_BAR; PG8_SCHED;
            PG8_LDA(At, 1, 1); PG8_STAGE(PG8_SB(1, 0), b3, voffB); PG8_STAGE(PG8_SB(1, 1), b3 + hstep, voffB); PG8_STAGE(PG8_SA(1, 0), a3, voffA);
            PG8_WAIT_V(8); PG8_WAIT_L(0); PG8_BAR; PG8_MMA(1, 0, At, B0); PG8_MMA(1, 1, At, B1); PG8_BAR; PG8_SCHED;
            } else {
            PG8_LDB(B0, 0, 0); PG8_SCHED; PG8_LDA(At, 0, 0); PG8_STAGE(PG8_SA(1, 1), a1 + hstep, voffA);
            PG8_WAIT_L(8); PG8_BAR; PG8_WAIT_L(0); PG8_MMA(0, 0, At, B0); PG8_BAR; PG8_SCHED;
            PG8_LDB(B1, 0, 1); PG8_STAGE(PG8_SB(0, 0), b2, voffB);
            PG8_BAR; PG8_WAIT_L(0); PG8_MMA(0, 1, At, B1); PG8_BAR;
            PG8_LDA(At, 0, 1); PG8_STAGE(PG8_SA(0, 0), a2, voffA);
            PG8_BAR; PG8_WAIT_L(0); PG8_MMA(1, 0, At, B0); PG8_BAR; PG8_SCHED;
            PG8_STAGE(PG8_SB(0, 1), b2 + hstep, voffB);
            PG8_WAIT_V(6); PG8_BAR; PG8_MMA(1, 1, At, B1); PG8_BAR;
            PG8_LDB(B0, 1, 0); PG8_SCHED; PG8_LDA(At, 1, 0); PG8_STAGE(PG8_SA(0, 1), a2 + hstep, voffA);
            PG8_WAIT_L(8); PG8_BAR; PG8_WAIT_L(0); PG8_MMA(0, 0, At, B0); PG8_BAR; PG8_SCHED;
            PG8_LDB(B1, 1, 1); PG8_STAGE(PG8_SB(1, 0), b3, voffB);
            PG8_BAR; PG8_WAIT_L(0); PG8_MMA(0, 1, At, B1); PG8_BAR;
            PG8_LDA(At, 1, 1); PG8_STAGE(PG8_SA(1, 0), a3, voffA);
            PG8_BAR; PG8_WAIT_L(0); PG8_MMA(1, 0, At, B0); PG8_BAR; PG8_SCHED;
            PG8_STAGE(PG8_SB(1, 1), b3 + hstep, voffB);
            PG8_WAIT_V(6); PG8_BAR; PG8_MMA(1, 1, At, B1); PG8_BAR;
            }
        }
        if constexpr (ALIGN_EPI) { if (wr == 0) PG8_BAR; }
        if constexpr (FP8) asm volatile("s_nop 15\n\ts_nop 15" ::: "memory");
        if constexpr (!Epi::AFTER_DRAIN) { E(acc, cur, wr, wc, fr, fq); S.done(cur); }
        if (!has_next) break;
#pragma unroll
        for (int a = 0; a < 2; ++a)
#pragma unroll
            for (int b = 0; b < 2; ++b)
#pragma unroll
                for (int m = 0; m < 4; ++m)
#pragma unroll
                    for (int n = 0; n < 2; ++n) acc[a][b][m][n] = (f32x4){0.f, 0.f, 0.f, 0.f};
        cur = nxt; cA = nA; cB = nB; ++ui;
        if constexpr (ALIGN_EPI) { if (wr == 1) PG8_BAR; }
    }
    PG8_WAIT_V(0);
    if constexpr (!ALIGN_EPI) { if (wr == 0) PG8_BAR; }
    PG8_BAR;
    if constexpr (Epi::AFTER_DRAIN) { E.fused(acc, cur, wr, wc, fr, fq, lds, wid, lane); S.done(cur); }
#undef PG8_SA
#undef PG8_SB
#undef PG8_STAGE
#undef PG8_LDA
#undef PG8_LDB
#undef PG8_MMA
#undef PG8_WAIT_V
#undef PG8_WAIT_L
#undef PG8_BAR
#undef PG8_SCHED
}
}
#ifndef PG8_SP2
#define PG8_SP2 true
#endif
#ifndef PG8_ALIGN
#define PG8_ALIGN true
#endif
constexpr int NWAVES = 8;
#ifndef MK_N_LAUNCHES
#define MK_N_LAUNCHES 1
#endif
constexpr int N_PHASES = 12;
constexpr int N_LAUNCHES = MK_N_LAUNCHES;

constexpr int BATCH = 2, SEQ = 4096, T = BATCH * SEQ, D = 4096;
constexpr int GMW = 1536, INW = 8704, GATEW = 12288, MEMLEN = 256, MROWS = BATCH * MEMLEN;
constexpr int NALL = INW + GATEW + 2048;
constexpr int MALL = T + MROWS;
constexpr int PEER_E = 16384;
constexpr int ACT_PITCH = 3072;
constexpr int P1_PITCH = D;
constexpr float LN_EPS = 1e-5f;
constexpr float ALPHA = 1.189207115002721f;
constexpr int C_GU = 0, C_GV = 1536, C_DQ = 3072, C_DK = 4608, C_DV = 6144, C_MQ = 7680;

constexpr size_t MiB = 1u << 20;
constexpr size_t WS_CTL = 0, CTL_ZERO_BYTES = 1 * MiB;
constexpr size_t WS_WALL = 1 * MiB;
constexpr size_t WS_XA = 181 * MiB;
constexpr size_t WS_AOUT = 1 * MiB;
constexpr size_t WS_OG = 25 * MiB;
constexpr size_t WS_BOUT = 1 * MiB + 1536;
constexpr size_t WS_MOUT = 1 * MiB + 2048;
constexpr size_t WS_LSE = 73 * MiB;
constexpr size_t WS_MERGEDB = 80 * MiB;
constexpr size_t WS_WBRA = 249 * MiB;
constexpr size_t WS_WBRB = 261 * MiB;
constexpr size_t WS_WBRM = 265 * MiB;
constexpr size_t WS_WOUT = 273 * MiB;
constexpr size_t WS_WQ = 305 * MiB;
constexpr size_t WS_SK = 321 * MiB;
constexpr size_t WS_ROPE = 322 * MiB;
constexpr size_t WS_MKV = 326 * MiB;
constexpr size_t WS_PROJ = 328 * MiB;
constexpr size_t WS_MERGED = 328 * MiB;
constexpr size_t WS_Q = 328 * MiB;
constexpr size_t WS_SELI = 360 * MiB;
constexpr size_t WS_SELG = 364 * MiB;
constexpr size_t WS_GATES = 464 * MiB;
constexpr size_t WS_Z = (DBG_ZALT ? 328 : 464) * MiB;
constexpr size_t WS_H1B = (DBG_ZALT ? 1 : 592) * MiB;
constexpr size_t WS_PU = 656 * MiB;
constexpr size_t WS_PV = 704 * MiB;
constexpr size_t WS_XA4 = 752 * MiB;
constexpr size_t WS_WG4 = 768 * MiB;
constexpr int P1B_PITCH = D / 2;
constexpr size_t WS_END = 792 * MiB;
static_assert(WS_WALL + (size_t)NALL * D * 2 == WS_XA && WS_XA + (size_t)MALL * D * 2 == WS_WBRA, "ws map A");
static_assert(WS_PROJ + (size_t)T * INW * 2 == WS_GATES && WS_GATES + (size_t)T * GATEW * 2 == WS_PU, "ws map B");
static_assert(DBG_ZALT || (WS_Z + (size_t)T * D * 4 == WS_H1B && WS_H1B + (size_t)T * D * 2 == WS_PU), "ws map C");
constexpr int CW_TMO = 0, CW_CODE = 1;
constexpr int CW_ROWS = 16384;
constexpr float PV_SCALE = 3.36f;
constexpr int CW_P11 = 32768, P11_NSH = 16;
constexpr int CW_DONE = 65536;
constexpr size_t WS_YP = 80 * MiB;
constexpr int CW_BAR = 4096;

constexpr int RING_OFF = 0, RING_BYTES = 131072;
constexpr int LDSCTL_OFF = RING_BYTES, MISC_OFF = LDSCTL_OFF + 320;
constexpr int LDS_BYTES = 147456;
static_assert(MISC_OFF + 128 <= LDS_BYTES, "LDS map");

#define GAS __attribute__((address_space(1)))
#define LAS __attribute__((address_space(3)))
typedef unsigned short bf16;
typedef unsigned v4u __attribute__((ext_vector_type(4)));
typedef float f32x4 __attribute__((ext_vector_type(4)));
typedef short bf16x8 __attribute__((ext_vector_type(8)));
typedef GAS unsigned gu32;
typedef GAS unsigned long long gu64;
#define RLX_AGENT __ATOMIC_RELAXED, __HIP_MEMORY_SCOPE_AGENT
#define LDS_WAIT() asm volatile("s_waitcnt lgkmcnt(0)" ::: "memory")
#define VM_WAIT() asm volatile("s_waitcnt vmcnt(0)" ::: "memory")
__device__ __forceinline__ unsigned long long rt() { return __builtin_amdgcn_s_memrealtime(); }
__device__ __forceinline__ unsigned f2bf(float f) { unsigned u = __builtin_bit_cast(unsigned, f); return (u + 0x7fffu + ((u >> 16) & 1u)) >> 16; }
__device__ __forceinline__ unsigned pk2(float lo, float hi) { return f2bf(lo) | (f2bf(hi) << 16); }

#define XB_TMO      128
#define XB_XCNT(j)  (256  + 64 * (j))
#define XB_XSUB(j)  (1280 + 64 * (j))
#define XB_XGEN(j)  (2304 + 64 * (j))
#define XB_TOP      3328
#define XB_TOPGEN   3392
#define XCD_BAR_WORDS 3456
#define XB_SPIN_CAP (1u << 18)

__device__ __forceinline__ unsigned xb_ld(unsigned* p)              { return __hip_atomic_load(p, __ATOMIC_RELAXED, __HIP_MEMORY_SCOPE_AGENT); }
__device__ __forceinline__ unsigned xb_add(unsigned* p, unsigned v) { return __hip_atomic_fetch_add(p, v, __ATOMIC_RELAXED, __HIP_MEMORY_SCOPE_AGENT); }
__device__ __forceinline__ unsigned xb_xcc_id() { return (unsigned)__builtin_amdgcn_s_getreg((3 << 11) | 20) & 0xFu; }
#define XB_SPIN(cond, bar) do { unsigned _sp = 0; while (cond) { __builtin_amdgcn_s_sleep(1); \
    if ((++_sp & 255u) == 0u) { if (xb_ld(&(bar)[XB_TMO])) break; if (_sp > XB_SPIN_CAP) { atomicAdd(&(bar)[XB_TMO], 1u); break; } } } } while (0)

struct XcdBarrier {
    unsigned* bar; unsigned x;
    volatile LAS unsigned* st;
};

__device__ __forceinline__ XcdBarrier xcd_barrier_post(unsigned* bar, volatile LAS unsigned* st) {
    XcdBarrier b; b.bar = bar; b.x = xb_xcc_id(); b.st = st;
    if (threadIdx.x == 0) (void)xb_add(&bar[XB_XCNT(b.x)], 1u);
    return b;
}
__device__ __forceinline__ void xcd_barrier_complete(unsigned* bar, unsigned x, unsigned& nloc, unsigned& nx) {
    const unsigned G = gridDim.x * gridDim.y * gridDim.z;
    unsigned sum, cnt, mine, sp = 0u;
    for (;;) {
        sum = 0u; cnt = 0u; mine = 0u;
#pragma unroll
        for (unsigned j = 0; j < 16; ++j) { const unsigned c = xb_ld(&bar[XB_XCNT(j)]); sum += c; cnt += (c > 0u) ? 1u : 0u; mine = (j == x) ? c : mine; }
        if (sum == G) break;
        __builtin_amdgcn_s_sleep(1);
        if ((++sp & 255u) == 0u) { if (xb_ld(&bar[XB_TMO])) break; if (sp > XB_SPIN_CAP) { atomicAdd(&bar[XB_TMO], 1u); break; } }
    }
    nloc = mine > 0u ? mine : 1u; nx = cnt > 0u ? cnt : 1u;
}

__device__ __forceinline__ void xcd_barrier(const XcdBarrier& b) {
    asm volatile("s_waitcnt vmcnt(0)" ::: "memory");
    __syncthreads();
    if (threadIdx.x == 0) {
        unsigned* bar = b.bar;
        __builtin_amdgcn_s_waitcnt(0);
        unsigned nloc = b.st[0], nx = b.st[1];
        if (nloc == 0u) { xcd_barrier_complete(bar, b.x, nloc, nx); b.st[0] = nloc; b.st[1] = nx; }
        const unsigned old = xb_add(&bar[XB_XSUB(b.x)], 1u);
        const unsigned gen = old / nloc;
        if (old + 1u == (gen + 1u) * nloc) {
            __builtin_amdgcn_fence(__ATOMIC_RELEASE, "agent");
            asm volatile("s_waitcnt vmcnt(0)" ::: "memory");
            const unsigned og = xb_add(&bar[XB_TOP], 1u);
            const unsigned tg = og / nx;
            if (og + 1u == (tg + 1u) * nx) xb_add(&bar[XB_TOPGEN], 1u);
            else XB_SPIN(xb_ld(&bar[XB_TOPGEN]) == tg, bar);
            __builtin_amdgcn_fence(__ATOMIC_ACQUIRE, "agent");
            xb_add(&bar[XB_XGEN(b.x)], 1u);
            asm volatile("s_waitcnt vmcnt(0)" ::: "memory");
        } else {
            XB_SPIN(xb_ld(&bar[XB_XGEN(b.x)]) == gen, bar);
            __builtin_amdgcn_fence(__ATOMIC_ACQUIRE, "agent");
            asm volatile("s_waitcnt vmcnt(0)" ::: "memory");
        }
    }
    __syncthreads();
}

struct Frame {
    LAS unsigned char* lds;
    volatile LAS unsigned* MISC;
    gu32* ctl;
    int tid, lane, wave;
    int vcu, G;
    const float* in[23];
    float* out;
    unsigned char* ws;
};
enum { I_X = 0, I_MEM, I_POS, I_WIN, I_GLNG, I_GLNB, I_GWS, I_GBS, I_WMKV, I_WGATE, I_BGATE, I_WBRA, I_WBRB, I_WBRM, I_WOUT, I_LNMG, I_LNMB, I_WQ, I_SK, I_PU, I_PV, I_LNFG, I_LNFB };

__device__ __forceinline__ float wave_sum(float v) {
#pragma unroll
    for (int o = 1; o < 64; o <<= 1) v += __shfl_xor(v, o);
    return v;
}
__device__ __forceinline__ float wave_max(float v) {
#pragma unroll
    for (int o = 1; o < 64; o <<= 1) v = fmaxf(v, __shfl_xor(v, o));
    return v;
}

typedef unsigned v2u __attribute__((ext_vector_type(2)));
#define DPP_QX1 0xB1
#define DPP_QX2 0x4E
#define DPP_RHM 0x141
#define DPP_RM  0x140
__device__ __forceinline__ unsigned row_max_u32(unsigned k) {
    k = max(k, (unsigned)__builtin_amdgcn_update_dpp(0, (int)k, DPP_QX1, 0xF, 0xF, false));
    k = max(k, (unsigned)__builtin_amdgcn_update_dpp(0, (int)k, DPP_QX2, 0xF, 0xF, false));
    k = max(k, (unsigned)__builtin_amdgcn_update_dpp(0, (int)k, DPP_RHM, 0xF, 0xF, false));
    k = max(k, (unsigned)__builtin_amdgcn_update_dpp(0, (int)k, DPP_RM, 0xF, 0xF, false));
    return k;
}
__device__ __forceinline__ float row_sum_f32(float v) {
    v += __builtin_bit_cast(float, __builtin_amdgcn_update_dpp(0, __builtin_bit_cast(int, v), DPP_QX1, 0xF, 0xF, false));
    v += __builtin_bit_cast(float, __builtin_amdgcn_update_dpp(0, __builtin_bit_cast(int, v), DPP_QX2, 0xF, 0xF, false));
    v += __builtin_bit_cast(float, __builtin_amdgcn_update_dpp(0, __builtin_bit_cast(int, v), DPP_RHM, 0xF, 0xF, false));
    v += __builtin_bit_cast(float, __builtin_amdgcn_update_dpp(0, __builtin_bit_cast(int, v), DPP_RM, 0xF, 0xF, false));
    return v;
}
__device__ __forceinline__ float wave_sum_dpp(float v) {
    v = row_sum_f32(v);
    const float a = __builtin_bit_cast(float, __builtin_amdgcn_readlane(__builtin_bit_cast(int, v), 0)), b = __builtin_bit_cast(float, __builtin_amdgcn_readlane(__builtin_bit_cast(int, v), 16));
    const float c = __builtin_bit_cast(float, __builtin_amdgcn_readlane(__builtin_bit_cast(int, v), 32)), d = __builtin_bit_cast(float, __builtin_amdgcn_readlane(__builtin_bit_cast(int, v), 48));
    return (a + b) + (c + d);
}
using pg8::pk4_fp8;
template <bool ROT, int FP8 = 0>
__device__ __forceinline__ void p0_transpose_finish(const float (&tv)[32], int K, bf16* WT, int row_off, LAS float* scr, int k0, int n0, int lane, int pitch = 0) {
    if (pitch == 0) pitch = K;
#pragma unroll
    for (int i = 0; i < 32; ++i) scr[(2 * i + (lane >> 5)) * 33 + (lane & 31)] = tv[i];
    LDS_WAIT(); asm volatile("" ::: "memory");
    const int c = lane & 7;
#pragma unroll
    for (int j = 0; j < 4; ++j) { const int n = (lane >> 3) + 8 * j; const LAS float* s = scr + (8 * c) * 33 + n;
        int nn = n0 + n;
        if (ROT && nn >= C_DQ && nn < C_DV) { const int hb = nn & ~127, d = nn & 127; nn = hb + ((d & 63) << 1) + (d >> 6); }
        if (FP8 == 2) { unsigned q = 0u;
            q = __builtin_amdgcn_cvt_scalef32_pk_fp4_f32(q, s[0 * 33] * 128.f, s[1 * 33] * 128.f, 1.0f, 0); q = __builtin_amdgcn_cvt_scalef32_pk_fp4_f32(q, s[2 * 33] * 128.f, s[3 * 33] * 128.f, 1.0f, 1);
            q = __builtin_amdgcn_cvt_scalef32_pk_fp4_f32(q, s[4 * 33] * 128.f, s[5 * 33] * 128.f, 1.0f, 2); q = __builtin_amdgcn_cvt_scalef32_pk_fp4_f32(q, s[6 * 33] * 128.f, s[7 * 33] * 128.f, 1.0f, 3);
            *(GAS unsigned*)((unsigned char*)WT + (size_t)(row_off + nn) * pitch + (k0 + 8 * c) / 2) = q; }
        else if (FP8 == 1) { v2u o8; o8.x = pk4_fp8(s[0 * 33] * 64.f, s[1 * 33] * 64.f, s[2 * 33] * 64.f, s[3 * 33] * 64.f); o8.y = pk4_fp8(s[4 * 33] * 64.f, s[5 * 33] * 64.f, s[6 * 33] * 64.f, s[7 * 33] * 64.f);
            *(GAS v2u*)((unsigned char*)WT + (size_t)(row_off + nn) * pitch + k0 + 8 * c) = o8; }
        else { v4u o; o.x = pk2(s[0 * 33], s[1 * 33]); o.y = pk2(s[2 * 33], s[3 * 33]); o.z = pk2(s[4 * 33], s[5 * 33]); o.w = pk2(s[6 * 33], s[7 * 33]);
            *(GAS v4u*)(WT + (size_t)(row_off + nn) * K + k0 + 8 * c) = o; } }
    LDS_WAIT(); asm volatile("" ::: "memory");
}
__device__ __forceinline__ void p0_convert(const float* src, bf16* dst, size_t n, int gw, int NGW, int lane) {
    const size_t nchunk = n / 512;
    for (size_t ch = gw; ch < nchunk; ch += NGW) {
        const GAS f32x4* s = (const GAS f32x4*)(src + ch * 512) + 2 * lane;
        const f32x4 a = s[0], b = s[1];
        v4u o; o.x = pk2(a.x, a.y); o.y = pk2(a.z, a.w); o.z = pk2(b.x, b.y); o.w = pk2(b.z, b.w);
        *((GAS v4u*)(dst + ch * 512) + lane) = o;
    }
}
__device__ __forceinline__ void p0_convert_fp8(const float* src, unsigned char* dst, size_t n, float scale, int gw, int NGW, int lane) {
    const size_t nchunk = n / 1024;
    for (size_t ch = gw; ch < nchunk; ch += NGW) {
        const GAS f32x4* s = (const GAS f32x4*)(src + ch * 1024) + 4 * lane;
        v4u o;
#pragma unroll
        for (int j = 0; j < 4; ++j) { const f32x4 a = s[j] * scale; int w = 0; w = __builtin_amdgcn_cvt_pk_fp8_f32(a.x, a.y, w, false); w = __builtin_amdgcn_cvt_pk_fp8_f32(a.z, a.w, w, true); o[j] = (unsigned)w; }
        *((GAS v4u*)(dst + ch * 1024) + lane) = o;
    }
}
__device__ __forceinline__ unsigned fp6_code(float x) {
    const unsigned xb = __builtin_bit_cast(unsigned, x), ab = xb & 0x7fffffffu;
    const float ax = __builtin_bit_cast(float, ab);
    const unsigned rb = (ab + 0x0007ffffu + ((ab >> 20) & 1u)) >> 20;
    const unsigned cn = min(rb - (126u << 3), 31u);
    const unsigned cs = (unsigned)__builtin_rintf(ax * 8.f);
    const unsigned c = (ax < 1.f) ? cs : cn;
    return ((xb >> 26) & 32u) | c;
}
__device__ __forceinline__ void p0_convert_fp6_row(const float* src, unsigned char* dst, int r, float scale, int lane) {
    {
        const GAS float* sr = (const GAS float*)(src + (size_t)r * D) + lane;
        unsigned d[14];
#pragma unroll
        for (int i = 0; i < 14; ++i) d[i] = 0u;
#pragma unroll
        for (int g = 0; g < 2; ++g) {
            float a[32];
#pragma unroll
            for (int j = 0; j < 32; ++j) a[j] = __builtin_nontemporal_load(sr + (32 * g + j) * 64);
#pragma unroll
            for (int j = 0; j < 32; ++j) {
                const unsigned c = fp6_code(a[j] * scale);
                const int bp = 6 * j, dw = 6 * g + (bp >> 5), off = bp & 31;
                d[dw] |= c << off;
                if (off > 26) d[dw + 1] |= c >> (32 - off);
            }
        }
        unsigned char* rowp = dst + (size_t)r * 3072;
        __builtin_nontemporal_store((v4u){d[0], d[1], d[2], d[3]}, (GAS v4u*)rowp + lane); __builtin_nontemporal_store((v2u){d[4], d[5]}, (GAS v2u*)(rowp + 1024) + lane);
        __builtin_nontemporal_store((v2u){d[6], d[7]}, (GAS v2u*)(rowp + 1536) + lane); __builtin_nontemporal_store((v4u){d[8], d[9], d[10], d[11]}, (GAS v4u*)(rowp + 2048) + lane);
    }
}
__device__ __forceinline__ void p0_convert_fp4_row(const float* src, unsigned char* dst, int r, float scale, int lane) {
    const GAS float* sr = (const GAS float*)(src + (size_t)r * D) + lane;
    unsigned d[8];
#pragma unroll
    for (int i = 0; i < 8; ++i) d[i] = 0u;
#pragma unroll
    for (int g = 0; g < 2; ++g) {
        float a[32];
#pragma unroll
        for (int j = 0; j < 32; ++j) a[j] = __builtin_nontemporal_load(sr + (32 * g + j) * 64);
#pragma unroll
        for (int w = 0; w < 4; ++w) {
            unsigned q = 0u;
            q = __builtin_amdgcn_cvt_scalef32_pk_fp4_f32(q, a[8 * w + 0] * scale, a[8 * w + 1] * scale, 1.0f, 0);
            q = __builtin_amdgcn_cvt_scalef32_pk_fp4_f32(q, a[8 * w + 2] * scale, a[8 * w + 3] * scale, 1.0f, 1);
            q = __builtin_amdgcn_cvt_scalef32_pk_fp4_f32(q, a[8 * w + 4] * scale, a[8 * w + 5] * scale, 1.0f, 2);
            q = __builtin_amdgcn_cvt_scalef32_pk_fp4_f32(q, a[8 * w + 6] * scale, a[8 * w + 7] * scale, 1.0f, 3);
            d[4 * g + w] = q;
        }
    }
    unsigned char* rowp = dst + (size_t)r * 2048;
    __builtin_nontemporal_store((v4u){d[0], d[1], d[2], d[3]}, (GAS v4u*)rowp + lane); __builtin_nontemporal_store((v4u){d[4], d[5], d[6], d[7]}, (GAS v4u*)(rowp + 1024) + lane);
}
__device__ __forceinline__ void p0_convert_fp8_rows(const float* src, unsigned char* dst, int nrows, int pitch, int gw, int NGW, int lane, unsigned char* dst4 = nullptr) {
    const int nchunk = nrows * (D / 1024);
    for (int ch = gw; ch < nchunk; ch += NGW) {
        const int r = ch / (D / 1024), q = ch % (D / 1024);
        const GAS f32x4* s = (const GAS f32x4*)(src + (size_t)r * D + q * 1024) + 4 * lane;
        v4u o; v2u o4;
#pragma unroll
        for (int j = 0; j < 4; ++j) { const f32x4 a = __builtin_nontemporal_load(s + j); o[j] = pk4_fp8(a.x, a.y, a.z, a.w);
            if (dst4) { unsigned w = (j & 1) ? o4[j >> 1] : 0u;
                if (j & 1) { w = __builtin_amdgcn_cvt_scalef32_pk_fp4_f32(w, a.x * 2.0f, a.y * 2.0f, 1.0f, 2); w = __builtin_amdgcn_cvt_scalef32_pk_fp4_f32(w, a.z * 2.0f, a.w * 2.0f, 1.0f, 3); }
                else { w = __builtin_amdgcn_cvt_scalef32_pk_fp4_f32(w, a.x * 2.0f, a.y * 2.0f, 1.0f, 0); w = __builtin_amdgcn_cvt_scalef32_pk_fp4_f32(w, a.z * 2.0f, a.w * 2.0f, 1.0f, 1); }
                o4[j >> 1] = w; } }
        *((GAS v4u*)(dst + (size_t)r * pitch + q * 1024) + lane) = o;
        if (dst4) *((GAS v2u*)(dst4 + (size_t)r * P1B_PITCH + q * 512) + lane) = o4;
    }
}
__device__ __forceinline__ void sincos_d(double a, float& sn, float& cs) {
    const double k = rint(a * 0.63661977236758134308);
    double y = fma(-k, 1.57079632679489655800e+00, a); y = fma(-k, 6.12323399573676603587e-17, y);
    const double y2 = y * y;
    double s = y2 * (-2.50521083854417187751e-08) + 2.75573192239858906526e-06; s = s * y2 - 1.98412698412698412698e-04; s = s * y2 + 8.33333333333333333333e-03; s = s * y2 - 1.66666666666666666667e-01; s = y + y * y2 * s;
    double c = y2 * (2.08767569878680989792e-09) - 2.75573192239858906526e-07; c = c * y2 + 2.48015873015873015873e-05; c = c * y2 - 1.38888888888888888889e-03; c = c * y2 + 4.16666666666666666667e-02; c = c * y2 - 0.5; c = c * y2 + 1.0;
    const int q = ((int)(long long)k) & 3;
    const double ss = (q & 1) ? c : s, cc = (q & 1) ? s : c;
    sn = (float)((q & 2) ? -ss : ss); cs = (float)(((q + 1) & 2) ? -cc : cc);
}
constexpr int P0_I_IN = (D / 64) * (INW / 32), P0_I_GT = (D / 64) * (GATEW / 32), P0_I_MK = (D / 64) * (2048 / 32);
constexpr int P0_I_BA = (1536 / 64) * (D / 32), P0_I_BB = (512 / 64) * (D / 32), P0_I_BM = (1024 / 64) * (D / 32), P0_I_WO = (D / 64) * (D / 32), P0_I_Q = (D / 64) * (2048 / 32);
constexpr int P0_NITEMS = P0_I_IN + P0_I_GT + P0_I_MK + P0_I_BA + P0_I_BB + P0_I_BM + P0_I_WO + P0_I_Q;
struct P0It { const float* W; int N, k0, n0, kind; };
__device__ __forceinline__ bool p0_decode(const Frame& F, int it, int it1, P0It& d) {
    if (it >= it1) return false;
    int r = it;
    if (r < P0_I_IN) { d.W = F.in[I_WIN]; d.N = INW; d.kind = 0; }
    else if ((r -= P0_I_IN) < P0_I_GT) { d.W = F.in[I_WGATE]; d.N = GATEW; d.kind = 1; }
    else if ((r -= P0_I_GT) < P0_I_MK) { d.W = F.in[I_WMKV]; d.N = 2048; d.kind = 2; }
    else if ((r -= P0_I_MK) < P0_I_BA) { d.W = F.in[I_WBRA]; d.N = D; d.kind = 3; }
    else if ((r -= P0_I_BA) < P0_I_BB) { d.W = F.in[I_WBRB]; d.N = D; d.kind = 4; }
    else if ((r -= P0_I_BB) < P0_I_BM) { d.W = F.in[I_WBRM]; d.N = D; d.kind = 5; }
    else if ((r -= P0_I_BM) < P0_I_WO) { d.W = F.in[I_WOUT]; d.N = D; d.kind = 6; }
    else { r -= P0_I_WO; d.W = F.in[I_WQ]; d.N = 2048; d.kind = 7; }
    const int nblk = d.N / 32; d.k0 = 64 * (r / nblk); d.n0 = 32 * (r % nblk);
    return true;
}
__device__ __forceinline__ void p0_item_load(const P0It& d, int lane, float (&tv)[32]) {
    const GAS float* p = (const GAS float*)d.W + (size_t)(d.k0 + (lane >> 5)) * d.N + d.n0 + (lane & 31);
#pragma unroll
    for (int i = 0; i < 32; ++i) tv[i] = __builtin_nontemporal_load(p + (size_t)(2 * i) * d.N);
}
__device__ __forceinline__ void p0_item_finish(Frame& F, const P0It& d, const float (&tv)[32], LAS float* scr) {
    bf16* WALL = (bf16*)(F.ws + WS_WALL);
    switch (d.kind) {
    case 0: p0_transpose_finish<true, 1>(tv, D, WALL, 0, scr, d.k0, d.n0, F.lane, P1_PITCH); break;
    case 1: p0_transpose_finish<false, 2>(tv, D, (bf16*)(F.ws + WS_WG4), 0, scr, d.k0, d.n0, F.lane, P1B_PITCH); break;
    case 2: p0_transpose_finish<false, 1>(tv, D, WALL, INW + GATEW, scr, d.k0, d.n0, F.lane, P1_PITCH); break;
    case 3: p0_transpose_finish<false, 1>(tv, 1536, (bf16*)(F.ws + WS_WBRA), 0, scr, d.k0, d.n0, F.lane, ACT_PITCH); break;
    case 4: p0_transpose_finish<false, 1>(tv, 512, (bf16*)(F.ws + WS_WBRA + 1536), 0, scr, d.k0, d.n0, F.lane, ACT_PITCH); break;
    case 5: p0_transpose_finish<false, 1>(tv, 1024, (bf16*)(F.ws + WS_WBRA + 2048), 0, scr, d.k0, d.n0, F.lane, ACT_PITCH); break;
    case 6: p0_transpose_finish<false, 1>(tv, D, (bf16*)(F.ws + WS_WOUT), 0, scr, d.k0, d.n0, F.lane); break;
    default: p0_transpose_finish<false, 0>(tv, D, (bf16*)(F.ws + WS_WQ), 0, scr, d.k0, d.n0, F.lane); break;
    }
}
__device__ __forceinline__ void p0_weight_items(Frame& F, int it0, int it1, int gw, int NGW) {
    LAS float* scr = (LAS float*)(F.lds + RING_OFF + F.wave * 16384);
    P0It cur, nxt; float ta[32], tb[32];
    int it = it0 + gw;
    if (!p0_decode(F, it, it1, cur)) return;
    p0_item_load(cur, F.lane, ta);
#pragma unroll 1
    for (;;) {
        bool more = p0_decode(F, it + NGW, it1, nxt);
        if (more) p0_item_load(nxt, F.lane, tb);
        p0_item_finish(F, cur, ta, scr);
        if (!more) break;
        more = p0_decode(F, it + 2 * NGW, it1, cur);
        if (more) p0_item_load(cur, F.lane, ta);
        p0_item_finish(F, nxt, tb, scr);
        if (!more) break;
        it += 2 * NGW;
    }
}
__device__ __forceinline__ void p0_prologue(Frame& F) {
    const int gw = F.vcu * NWAVES + F.wave, NGW = F.G * NWAVES;
    p0_weight_items(F, 0, P0_NITEMS, gw, NGW);
    bf16* XA = (bf16*)(F.ws + WS_XA);
    p0_convert_fp8_rows(F.in[I_X], (unsigned char*)XA, T, P1_PITCH, gw, NGW, F.lane, F.ws + WS_XA4);
    p0_convert_fp8_rows(F.in[I_MEM], (unsigned char*)XA + (size_t)T * P1_PITCH, MROWS, P1_PITCH, gw, NGW, F.lane);
    p0_convert(F.in[I_SK], (bf16*)(F.ws + WS_SK), (size_t)8 * 2 * 128 * 128, gw, NGW, F.lane);
    {
        float* rope = (float*)(F.ws + WS_ROPE);
        const int* pos = (const int*)F.in[I_POS];
        const int gt = (F.vcu * NWAVES + F.wave) * 64 + F.lane, NGT = NGW * 64;
        for (int i = gt; i < T * 64; i += NGT) {
            const int m = i >> 6, j = i & 63;
            const double inv = exp2(-(double)j * (13.287712379549449 / 64.0));
            float sn, cs; sincos_d((double)pos[m] * inv, sn, cs);
            { typedef float f32x2g __attribute__((ext_vector_type(2))); *(GAS f32x2g*)(rope + (size_t)i * 2) = (f32x2g){cs, sn}; }
        }
    }
}

__device__ __forceinline__ void peer_tables_convert(Frame& F) {
    gu32* ctr = F.ctl + CW_ROWS;
    for (;;) {
        unsigned r0 = 0u;
        if (F.lane == 0) r0 = __hip_atomic_fetch_add(ctr, 4u, RLX_AGENT);
        r0 = (unsigned)__builtin_amdgcn_readfirstlane((int)r0);
        if (r0 >= 2u * PEER_E) break;
#pragma unroll 1
        for (unsigned r = r0; r < r0 + 4u; ++r) {
            if (r < (unsigned)PEER_E) p0_convert_fp4_row(F.in[I_PU], F.ws + WS_PU, (int)r, 128.0f, F.lane);
            else p0_convert_fp4_row(F.in[I_PV], F.ws + WS_PV, (int)(r - PEER_E), PV_SCALE, F.lane);
        }
    }
}
__device__ __forceinline__ bf16x8 as_bf16x8(v4u v) { return __builtin_bit_cast(bf16x8, v); }
constexpr int KP = 272;
constexpr int VP = 528;

struct RowMap { const bf16* base; long row0; int rstride; int pitch; };
__device__ __forceinline__ const bf16* rm_ptr(const RowMap& r, int i) { return r.base + (r.row0 + (long)i * r.rstride) * (long)r.pitch; }

template <int NCH, bool BAND, bool OUT8>
__device__ __forceinline__ void attn_unit(LAS unsigned char* lds, const RowMap qm, const RowMap km, const RowMap vm, bf16* obase, long orow0, int orstride, int opitch, int kmin, float* lse_out, int lse_stride, int tid) {
    const int lane = tid & 63, w = __builtin_amdgcn_readfirstlane(tid >> 6), l15 = lane & 15, fq = lane >> 4;
    const int qi = 16 * w + l15;
    f32x4 s[16];
#pragma unroll
    for (int kt = 0; kt < 16; ++kt) s[kt] = (f32x4){0.f, 0.f, 0.f, 0.f};
    const bf16* qp = rm_ptr(qm, qi);
    v4u kreg[8], va[4], vb[4];
#define ATT_LOAD_K(ch) do { _Pragma("unroll") for (int p = 0; p < 8; ++p) { const int idx = p * 512 + tid, key = idx >> 4, c16 = idx & 15; \
        kreg[p] = (v4u){0u, 0u, 0u, 0u}; if (key >= kmin) kreg[p] = *(const GAS v4u*)(rm_ptr(km, key) + (ch) * 128 + c16 * 8); } } while (0)
#define ATT_WRITE_K() do { _Pragma("unroll") for (int p = 0; p < 8; ++p) { const int idx = p * 512 + tid, key = idx >> 4, c16 = idx & 15; *(LAS v4u*)(lds + key * KP + c16 * 16) = kreg[p]; } } while (0)
#define ATT_LOAD_V(ch) do { _Pragma("unroll") for (int p = 0; p < 4; ++p) { const int idx = p * 512 + tid, kp = idx & 127, dg = idx >> 7; \
        va[p] = (v4u){0u, 0u, 0u, 0u}; vb[p] = (v4u){0u, 0u, 0u, 0u}; \
        if (2 * kp >= kmin) { va[p] = *(const GAS v4u*)(rm_ptr(vm, 2 * kp) + (ch) * 128 + dg * 8); vb[p] = *(const GAS v4u*)(rm_ptr(vm, 2 * kp + 1) + (ch) * 128 + dg * 8); } } } while (0)
#define ATT_WRITE_VT() do { _Pragma("unroll") for (int p = 0; p < 4; ++p) { const int idx = p * 512 + tid, kp = idx & 127, dg = idx >> 7; \
        _Pragma("unroll") for (int e = 0; e < 8; ++e) { const unsigned lo = (va[p][e >> 1] >> (16 * (e & 1))) & 0xffffu, hi = (vb[p][e >> 1] >> (16 * (e & 1))) & 0xffffu; \
            *(LAS unsigned*)(lds + (dg * 8 + e) * VP + kp * 4) = lo | (hi << 16); } } } while (0)
    ATT_LOAD_K(0);
#pragma unroll
    for (int ch = 0; ch < NCH; ++ch) {
        ATT_WRITE_K();
        bf16x8 qf[4];
#pragma unroll
        for (int ks = 0; ks < 4; ++ks) qf[ks] = as_bf16x8(*(const GAS v4u*)(qp + ch * 128 + 32 * ks + 8 * fq));
        __syncthreads();
        if (ch + 1 < NCH) ATT_LOAD_K(ch + 1); else ATT_LOAD_V(0);
#pragma unroll
        for (int kt = 0; kt < 16; ++kt)
#pragma unroll
            for (int ks = 0; ks < 4; ++ks) {
                const bf16x8 kf = as_bf16x8(*(const LAS v4u*)(lds + (16 * kt + l15) * KP + 64 * ks + 16 * fq));
                s[kt] = __builtin_amdgcn_mfma_f32_16x16x32_bf16(kf, qf[ks], s[kt], 0, 0, 0);
            }
        __syncthreads();
    }
    float mx = -3.0e38f;
#pragma unroll
    for (int kt = 0; kt < 16; ++kt)
#pragma unroll
        for (int i = 0; i < 4; ++i) {
            if (BAND) { const int kj = 16 * kt + 4 * fq + i; const bool ok = (kj >= qi) && (kj <= qi + 128) && (kj >= kmin); s[kt][i] = ok ? s[kt][i] : -1.0e30f; }
            mx = fmaxf(mx, s[kt][i]);
        }
    mx = fmaxf(mx, __shfl_xor(mx, 16)); mx = fmaxf(mx, __shfl_xor(mx, 32));
    float sum = 0.f;
#pragma unroll
    for (int kt = 0; kt < 16; ++kt)
#pragma unroll
        for (int i = 0; i < 4; ++i) { const float p = __builtin_amdgcn_exp2f((s[kt][i] - mx) * 1.4426950409f); s[kt][i] = p; sum += p; }
    sum += __shfl_xor(sum, 16); sum += __shfl_xor(sum, 32);
    const float inv = 1.0f / sum;
    if (lse_out && fq == 0) lse_out[(long)qi * lse_stride] = mx + __logf(sum);
    bf16x8 pf[8];
#pragma unroll
    for (int kk = 0; kk < 8; ++kk) { v4u t; t.x = pg8::cvt_pk_bf16(s[2 * kk][0], s[2 * kk][1]); t.y = pg8::cvt_pk_bf16(s[2 * kk][2], s[2 * kk][3]);
        t.z = pg8::cvt_pk_bf16(s[2 * kk + 1][0], s[2 * kk + 1][1]); t.w = pg8::cvt_pk_bf16(s[2 * kk + 1][2], s[2 * kk + 1][3]); pf[kk] = as_bf16x8(t); }
    bf16* op = obase + (orow0 + (long)qi * orstride) * (long)opitch;
#pragma unroll
    for (int ch = 0; ch < NCH; ++ch) {
        ATT_WRITE_VT();
        __syncthreads();
        if (ch + 1 < NCH) ATT_LOAD_V(ch + 1);
        f32x4 o[8];
#pragma unroll
        for (int nt = 0; nt < 8; ++nt) o[nt] = (f32x4){0.f, 0.f, 0.f, 0.f};
#pragma unroll
        for (int nt = 0; nt < 8; ++nt)
#pragma unroll
            for (int kk = 0; kk < 8; ++kk) {
                const LAS unsigned char* vp = lds + (16 * nt + l15) * VP + 64 * kk + 8 * fq;
                const v2u v0 = *(const LAS v2u*)vp, v1 = *(const LAS v2u*)(vp + 32);
                const bf16x8 vf = as_bf16x8((v4u){v0.x, v0.y, v1.x, v1.y});
                o[nt] = __builtin_amdgcn_mfma_f32_16x16x32_bf16(vf, pf[kk], o[nt], 0, 0, 0);
            }
#pragma unroll
        for (int nt = 0; nt < 8; ++nt) {
            if (OUT8) { const float i8 = inv * 8.0f; *(GAS unsigned*)((unsigned char*)obase + (orow0 + (long)qi * orstride) * (long)opitch + ch * 128 + 16 * nt + 4 * fq) = pg8::pk4_fp8(o[nt][0] * i8, o[nt][1] * i8, o[nt][2] * i8, o[nt][3] * i8); }
            else { v2u t; t.x = pg8::cvt_pk_bf16(o[nt][0] * inv, o[nt][1] * inv); t.y = pg8::cvt_pk_bf16(o[nt][2] * inv, o[nt][3] * inv);
            *(GAS v2u*)(op + ch * 128 + 16 * nt + 4 * fq) = t; } }
        __syncthreads();
    }
#undef ATT_LOAD_K
#undef ATT_WRITE_K
#undef ATT_LOAD_V
#undef ATT_WRITE_VT
}

__device__ __forceinline__ void gmlp_unit(Frame& F, int n, int g3) {
    const int tid = F.tid, lane = F.lane, w = F.wave, l15 = lane & 15, fq = lane >> 4;
    const bf16* proj = (const bf16*)(F.ws + WS_PROJ);
    LAS unsigned char* vt = F.lds + RING_OFF;
    LAS float* stats = (LAS float*)(F.lds + RING_OFF + 128 * KP);
    const long R0 = (long)n * 128;
#pragma unroll 1
    for (int t4 = 0; t4 < 4; ++t4) {
        v4u q[4][3];
#pragma unroll
        for (int tt = 0; tt < 4; ++tt) { const GAS v4u* rp = (const GAS v4u*)(proj + (R0 + 16 * w + 4 * t4 + tt) * INW + C_GV) + lane;
#pragma unroll
            for (int j = 0; j < 3; ++j) q[tt][j] = rp[64 * j]; }
#pragma unroll
        for (int tt = 0; tt < 4; ++tt) {
            float sm = 0.f;
#pragma unroll
            for (int j = 0; j < 3; ++j)
#pragma unroll
                for (int e = 0; e < 4; ++e) sm += pg8::bf_lo(q[tt][j][e]) + pg8::bf_hi(q[tt][j][e]);
            const float mean = wave_sum_dpp(sm) * (1.0f / GMW); float s2 = 0.f;
#pragma unroll
            for (int j = 0; j < 3; ++j)
#pragma unroll
                for (int e = 0; e < 4; ++e) { const float d0 = pg8::bf_lo(q[tt][j][e]) - mean, d1 = pg8::bf_hi(q[tt][j][e]) - mean; s2 += d0 * d0 + d1 * d1; }
            const float rstd = 1.0f / sqrtf(wave_sum_dpp(s2) * (1.0f / GMW) + LN_EPS);
            const int tok = 16 * w + 4 * t4 + tt;
            if (lane == 0) { stats[2 * tok] = mean; stats[2 * tok + 1] = rstd; }
        }
    }
    __syncthreads();
#pragma unroll 1
    for (int g = 3 * g3; g < 3 * g3 + 3; ++g) {
    const float* lng = F.in[I_GLNG] + g * 128; const float* lnb = F.in[I_GLNB] + g * 128;
#pragma unroll
    for (int p = 0; p < 2; ++p) { const int idx = p * 512 + tid, sp = idx & 63, cg = idx >> 6;
        const v4u a = *(const GAS v4u*)(proj + (R0 + 2 * sp) * INW + C_GV + g * 128 + cg * 8), b = *(const GAS v4u*)(proj + (R0 + 2 * sp + 1) * INW + C_GV + g * 128 + cg * 8);
        const float m0 = stats[4 * sp], r0 = stats[4 * sp + 1], m1 = stats[4 * sp + 2], r1 = stats[4 * sp + 3];
#pragma unroll
        for (int e = 0; e < 8; ++e) { const float x0 = (e & 1) ? pg8::bf_hi(a[e >> 1]) : pg8::bf_lo(a[e >> 1]), x1 = (e & 1) ? pg8::bf_hi(b[e >> 1]) : pg8::bf_lo(b[e >> 1]);
            const float gg = lng[cg * 8 + e], bb = lnb[cg * 8 + e];
            *(LAS unsigned*)(vt + (cg * 8 + e) * KP + sp * 4) = pk2((x0 - m0) * r0 * gg + bb, (x1 - m1) * r1 * gg + bb); } }
    __syncthreads();
    f32x4 acc[8];
#pragma unroll
    for (int ct = 0; ct < 8; ++ct) acc[ct] = (f32x4){0.f, 0.f, 0.f, 0.f};
    const int t = 16 * w + l15;
    const float* wrow = F.in[I_GWS] + ((size_t)g * 128 + t) * 128;
    f32x4 wq[4][2]; v2u uq[8];
#pragma unroll
    for (int ks = 0; ks < 4; ++ks) { const int s0 = 32 * ks + 8 * fq; const int so = (32 * ks <= 16 * w + 15) ? s0 : 8 * fq; wq[ks][0] = *(const GAS f32x4*)(wrow + so); wq[ks][1] = *(const GAS f32x4*)(wrow + so + 4); }
#pragma unroll
    for (int ct = 0; ct < 8; ++ct) uq[ct] = *(const GAS v2u*)(proj + (R0 + t) * INW + C_GU + g * 128 + 16 * ct + 4 * fq);
    const float bs = F.in[I_GBS][g * 128 + t];
    __builtin_amdgcn_sched_barrier(0);
#pragma unroll
    for (int ks = 0; ks < 4; ++ks) {
        if (32 * ks <= 16 * w + 15) {
            const int s0 = 32 * ks + 8 * fq;
            const f32x4 w0 = wq[ks][0], w1 = wq[ks][1];
            v4u wf; wf.x = pk2(s0 + 0 <= t ? w0.x : 0.f, s0 + 1 <= t ? w0.y : 0.f); wf.y = pk2(s0 + 2 <= t ? w0.z : 0.f, s0 + 3 <= t ? w0.w : 0.f);
            wf.z = pk2(s0 + 4 <= t ? w1.x : 0.f, s0 + 5 <= t ? w1.y : 0.f); wf.w = pk2(s0 + 6 <= t ? w1.z : 0.f, s0 + 7 <= t ? w1.w : 0.f);
            const bf16x8 wb = as_bf16x8(wf);
#pragma unroll
            for (int ct = 0; ct < 8; ++ct) {
                const bf16x8 vf = as_bf16x8(*(const LAS v4u*)(vt + (16 * ct + l15) * KP + 64 * ks + 16 * fq));
                acc[ct] = __builtin_amdgcn_mfma_f32_16x16x32_bf16(vf, wb, acc[ct], 0, 0, 0);
            }
        }
    }
    bf16* aout = (bf16*)(F.ws + WS_AOUT);
#pragma unroll
    for (int ct = 0; ct < 8; ++ct) {
        const int c = g * 128 + 16 * ct + 4 * fq;
        const v2u uu = uq[ct];
        *(GAS unsigned*)((unsigned char*)aout + (R0 + t) * ACT_PITCH + c) = pg8::pk4_fp8(8.0f * pg8::bf_lo(uu.x) * (acc[ct][0] + bs), 8.0f * pg8::bf_hi(uu.x) * (acc[ct][1] + bs), 8.0f * pg8::bf_lo(uu.y) * (acc[ct][2] + bs), 8.0f * pg8::bf_hi(uu.y) * (acc[ct][3] + bs));
    }
    __syncthreads();
    }
}

__device__ __forceinline__ void p2_mixers(Frame& F) {
    const bf16* proj = (const bf16*)(F.ws + WS_PROJ);
    const bf16* mkv = (const bf16*)(F.ws + WS_MKV);
    LAS unsigned char* lds = F.lds + RING_OFF;
    if (!(DBG_P2SKIP & 1)) for (int u = F.vcu; u < 256; u += F.G) {
        const int b = u >> 7, h = (u >> 5) & 3, qb = u & 31;
        const RowMap qm{proj + C_MQ + h * 256, (long)b * SEQ + qb * 128, 1, INW};
        const RowMap km{mkv + h * 256, (long)b * MEMLEN, 1, 2048};
        const RowMap vm{mkv + 1024 + h * 256, (long)b * MEMLEN, 1, 2048};
        attn_unit<2, false, true>(lds, qm, km, vm, (bf16*)(F.ws + WS_MOUT + h * 256), (long)b * SEQ + qb * 128, 1, ACT_PITCH, 0, nullptr, 0, F.tid);
    }
    if (!(DBG_P2SKIP & 2)) for (int u = F.vcu; u < 768; u += F.G) {
        const int g = u >> 8, b = (u >> 7) & 1, hs = (u >> 5) & 3, rn = u & 31;
        const int d = (g == 0) ? 1 : (g == 1 ? 4 : 16), nb = 32 / d, r = rn / nb, n = rn % nb;
        const int head = g * 4 + hs;
        const long q0 = (long)b * SEQ + (long)n * 128 * d + r, k0 = q0 - 128L * d;
        const RowMap qm{proj + C_DQ + head * 128, q0, d, INW};
        const RowMap km{proj + C_DK + head * 128, k0, d, INW};
        const RowMap vm{proj + C_DV + head * 128, k0, d, INW};
        float* lse = (float*)(F.ws + WS_LSE) + ((size_t)g * T + q0) * 4 + hs;
        attn_unit<1, true, false>(lds, qm, km, vm, (bf16*)(F.ws + WS_OG) + (size_t)g * T * 512 + hs * 128, q0, d, 512, n == 0 ? 128 : 0, lse, 4 * d, F.tid);
    }
    if (!(DBG_P2SKIP & 4)) for (int u = F.vcu; u < 256; u += F.G) gmlp_unit(F, u >> 2, u & 3);
}

__device__ __forceinline__ void p3_merge(Frame& F) {
    const bf16* og = (const bf16*)(F.ws + WS_OG); const float* lse = (const float*)(F.ws + WS_LSE); bf16* bout = (bf16*)(F.ws + WS_BOUT);
    const int gt = (F.vcu * NWAVES + F.wave) * 64 + F.lane, NGT = F.G * NWAVES * 64;
    for (int i = gt; i < T * 64; i += NGT) {
        const int tok = i >> 6, c8 = i & 63, hs = c8 >> 4;
        const float l0 = lse[((size_t)0 * T + tok) * 4 + hs], l1 = lse[((size_t)1 * T + tok) * 4 + hs], l2 = lse[((size_t)2 * T + tok) * 4 + hs];
        const float m = fmaxf(l0, fmaxf(l1, l2)); const float e0 = __expf(l0 - m), e1 = __expf(l1 - m), e2 = __expf(l2 - m); const float is = 1.0f / (e0 + e1 + e2);
        const float w0 = e0 * is, w1 = e1 * is, w2 = e2 * is;
        const v4u a = *(const GAS v4u*)(og + ((size_t)0 * T + tok) * 512 + c8 * 8), b = *(const GAS v4u*)(og + ((size_t)1 * T + tok) * 512 + c8 * 8), c = *(const GAS v4u*)(og + ((size_t)2 * T + tok) * 512 + c8 * 8);
        float r[8];
#pragma unroll
        for (int e = 0; e < 4; ++e) { r[2 * e] = 8.0f * (w0 * pg8::bf_lo(a[e]) + w1 * pg8::bf_lo(b[e]) + w2 * pg8::bf_lo(c[e])); r[2 * e + 1] = 8.0f * (w0 * pg8::bf_hi(a[e]) + w1 * pg8::bf_hi(b[e]) + w2 * pg8::bf_hi(c[e])); }
        v2u o; o.x = pg8::pk4_fp8(r[0], r[1], r[2], r[3]); o.y = pg8::pk4_fp8(r[4], r[5], r[6], r[7]);
        *(GAS v2u*)((unsigned char*)bout + (size_t)tok * ACT_PITCH + c8 * 8) = o;
    }
}
__device__ __forceinline__ void p6_layernorm(Frame& F) {
    const bf16* z = (const bf16*)(F.ws + WS_Z); bf16* h1b = (bf16*)(F.ws + WS_H1B);
    const float* lg = F.in[I_LNMG]; const float* lb = F.in[I_LNMB];
    const int gw = F.vcu * NWAVES + F.wave, NGW = F.G * NWAVES, lane = F.lane;
    for (int m = gw; m < T; m += NGW) {
        const GAS v4u* zr = (const GAS v4u*)(z + (size_t)m * D) + lane;
        float v[64]; float s = 0.f;
#pragma unroll
        for (int j = 0; j < 8; ++j) { const v4u q = __builtin_nontemporal_load(zr + 64 * j);
#pragma unroll
            for (int e = 0; e < 4; ++e) { v[8 * j + 2 * e] = pg8::bf_lo(q[e]); v[8 * j + 2 * e + 1] = pg8::bf_hi(q[e]); s += v[8 * j + 2 * e] + v[8 * j + 2 * e + 1]; } }
        const float mean = wave_sum_dpp(s) * (1.f / D); float s2 = 0.f;
#pragma unroll
        for (int i = 0; i < 64; ++i) { v[i] -= mean; s2 += v[i] * v[i]; }
        const float rstd = 1.f / sqrtf(wave_sum_dpp(s2) * (1.f / D) + LN_EPS);
        GAS v4u* o = (GAS v4u*)(h1b + (size_t)m * D) + lane;
#pragma unroll
        for (int j = 0; j < 8; ++j) {
            const f32x4 ga = *((const GAS f32x4*)lg + 2 * lane + 128 * j), gb = *((const GAS f32x4*)lg + 2 * lane + 128 * j + 1), ba = *((const GAS f32x4*)lb + 2 * lane + 128 * j), bb = *((const GAS f32x4*)lb + 2 * lane + 128 * j + 1);
            v4u w; w.x = pk2(v[8 * j] * rstd * ga.x + ba.x, v[8 * j + 1] * rstd * ga.y + ba.y); w.y = pk2(v[8 * j + 2] * rstd * ga.z + ba.z, v[8 * j + 3] * rstd * ga.w + ba.w);
            w.z = pk2(v[8 * j + 4] * rstd * gb.x + bb.x, v[8 * j + 5] * rstd * gb.y + bb.y); w.w = pk2(v[8 * j + 6] * rstd * gb.z + bb.z, v[8 * j + 7] * rstd * gb.w + bb.w);
            o[64 * j] = w;
        }
    }
}

__device__ __forceinline__ unsigned f2ord(float f) { const unsigned u = __builtin_bit_cast(unsigned, f); return u ^ ((unsigned)((int)u >> 31) | 0x80000000u); }
__device__ __forceinline__ float ord2f(unsigned k) { const unsigned u = (k & 0x80000000u) ? (k ^ 0x80000000u) : ~k; return __builtin_bit_cast(float, u); }

__device__ __forceinline__ void p8_topk(Frame& F) {
    const bf16* Q = (const bf16*)(F.ws + WS_Q); const bf16* SK = (const bf16*)(F.ws + WS_SK);
    int* seli = (int*)(F.ws + WS_SELI); float* selg = (float*)(F.ws + WS_SELG);
    LAS unsigned char* lds = F.lds + RING_OFF;
    const int tid = F.tid, lane = F.lane, w = F.wave, l15 = lane & 15, fq = lane >> 4, gbase = lane & 48;
    for (int u = F.vcu; u < 512; u += F.G) {
        const int tb = u >> 3, h = u & 7;
#pragma unroll
        for (int p = 0; p < 8; ++p) { const int idx = p * 512 + tid, half = idx >> 11, key = (idx >> 4) & 127, c16 = idx & 15;
            *(LAS v4u*)(lds + (half * 128 + key) * KP + c16 * 16) = *(const GAS v4u*)(SK + ((size_t)(h * 2 + half) * 128 + key) * 128 + c16 * 8); }
        __syncthreads();
        f32x4 sc[2][8];
        const bf16* qrow = Q + (size_t)(tb * 128 + 16 * w + l15) * 2048 + h * 256;
#pragma unroll
        for (int p = 0; p < 2; ++p) {
            bf16x8 qf[4];
#pragma unroll
            for (int ks = 0; ks < 4; ++ks) qf[ks] = as_bf16x8(*(const GAS v4u*)(qrow + p * 128 + 32 * ks + 8 * fq));
#pragma unroll
            for (int nt = 0; nt < 8; ++nt) { sc[p][nt] = (f32x4){0.f, 0.f, 0.f, 0.f};
#pragma unroll
                for (int ks = 0; ks < 4; ++ks) {
                    const bf16x8 kf = as_bf16x8(*(const LAS v4u*)(lds + (p * 128 + 16 * nt + l15) * KP + 64 * ks + 16 * fq));
                    sc[p][nt] = __builtin_amdgcn_mfma_f32_16x16x32_bf16(qf[ks], kf, sc[p][nt], 0, 0, 0);
                } }
        }
        __syncthreads();
#pragma unroll
        for (int i = 0; i < 4; ++i) {
            unsigned rk[2];
#pragma unroll
            for (int p = 0; p < 2; ++p) {
                unsigned v[8];
#pragma unroll
                for (int nt = 0; nt < 8; ++nt) v[nt] = (f2ord(sc[p][nt][i]) & ~127u) | (unsigned)(127 - (16 * nt + l15));
                unsigned r = 0u;
#pragma unroll 1
                for (int it = 0; it < 16; ++it) {
                    unsigned b = max(max(max(v[0], v[1]), max(v[2], v[3])), max(max(v[4], v[5]), max(v[6], v[7])));
                    b = row_max_u32(b);
                    r = (l15 == it) ? b : r;
#pragma unroll
                    for (int nt = 0; nt < 8; ++nt) v[nt] = (v[nt] == b) ? 0u : v[nt];
                }
                rk[p] = r;
            }
            const float s1 = ord2f(rk[0] & ~127u), s2 = ord2f(rk[1] & ~127u);
            const int i1 = 127 - (int)(rk[0] & 127u), i2 = 127 - (int)(rk[1] & 127u);
            unsigned c[4];
            {
                const float s1_0 = __shfl(s1, gbase), s1_1 = __shfl(s1, gbase + 1), s1_2 = __shfl(s1, gbase + 2);
#pragma unroll
                for (int j = 0; j < 4; ++j) { const float v = s1 + __shfl(s2, gbase + j); c[j] = ((l15 + 1) * (j + 1) <= 16) ? ((f2ord(v) & ~255u) | (unsigned)(255 - (l15 * 16 + j))) : 0u; }
                const int hi = l15 >= 8;
                const int b1 = l15 - 4;
                const float v1 = s1_0 + __shfl(s2, gbase + (hi ? b1 : 0));
                if (hi) c[1] = (f2ord(v1) & ~255u) | (unsigned)(255 - b1);
                const int a2 = l15 >= 12 ? 1 : 0, b2 = l15 >= 12 ? l15 - 8 : l15 + 4;
                const float v2 = (a2 ? s1_1 : s1_0) + __shfl(s2, gbase + (hi ? b2 : 0));
                if (hi) c[2] = (f2ord(v2) & ~255u) | (unsigned)(255 - (a2 * 16 + b2));
                const float v3 = s1_2 + __shfl(s2, gbase + 4);
                if (l15 == 8) c[3] = (f2ord(v3) & ~255u) | (unsigned)(255 - (2 * 16 + 4));
            }
            unsigned r = 0u;
#pragma unroll 1
            for (int it = 0; it < 16; ++it) {
                unsigned b = row_max_u32(max(max(c[0], c[1]), max(c[2], c[3])));
                r = (l15 == it) ? b : r;
#pragma unroll
                for (int j = 0; j < 4; ++j) c[j] = (c[j] == b) ? 0u : c[j];
            }
            const float best = ord2f(r & ~255u); const int ci = 255 - (int)(r & 255u);
            const int e1 = __shfl(i1, gbase + (ci >> 4)), e2 = __shfl(i2, gbase + (ci & 15));
            const float mx0 = __shfl(best, gbase);
            const float ev = __expf(best - mx0);
            const float sm = row_sum_f32(ev);
            const size_t tok = (size_t)tb * 128 + 16 * w + 4 * fq + i;
            seli[tok * 128 + h * 16 + l15] = e1 * 128 + e2; selg[tok * 128 + h * 16 + l15] = ev / sm;
        }
    }
}

typedef float f32x2v __attribute__((ext_vector_type(2)));
typedef float f32x32v __attribute__((ext_vector_type(32)));
typedef float f32x4p __attribute__((ext_vector_type(4)));
typedef unsigned u32x6v __attribute__((ext_vector_type(6)));
#define PEER_LD(p) (*(p))
#define PEER_DECL(n) v4u n##ua, n##ud, n##va, n##vd
#define PEER_LOAD(n, eid) do { const unsigned char* up_ = PU + (size_t)(eid) * 2048; const unsigned char* vp_ = PV + (size_t)(eid) * 2048; \
    n##ua = PEER_LD((const GAS v4u*)up_ + lane); n##ud = PEER_LD((const GAS v4u*)(up_ + 1024) + lane); \
    n##va = PEER_LD((const GAS v4u*)vp_ + lane); n##vd = PEER_LD((const GAS v4u*)(vp_ + 1024) + lane); } while (0)
#define PEER_RUN(n, gate) peer_expert(n##ua, n##ud, n##va, n##vd, xl, y16, gate)
typedef _Float16 h2v __attribute__((ext_vector_type(2)));
__device__ __forceinline__ void peer_expert(const v4u ua, const v4u ud, const v4u va, const v4u vd, const LAS unsigned char* xl, h2v (&y)[32], float gate) {
    float d0 = 0.f, d1 = 0.f, d2 = 0.f, d3 = 0.f;
#pragma unroll
    for (int w = 0; w < 8; ++w) {
        const v4u xq = *(const LAS v4u*)(xl + w * 1024);
        unsigned xq0 = xq.x, xq1 = xq.y, xq2 = xq.z, xq3 = xq.w;
        asm volatile("" : "+v"(xq0), "+v"(xq1), "+v"(xq2), "+v"(xq3));
        const unsigned uw = w < 4 ? ua[w & 3] : ud[w & 3];
        d0 = __builtin_amdgcn_fdot2(__builtin_amdgcn_cvt_scalef32_pk_f16_fp4(uw, 1.0f, 0), __builtin_bit_cast(h2v, xq0), d0, false);
        d1 = __builtin_amdgcn_fdot2(__builtin_amdgcn_cvt_scalef32_pk_f16_fp4(uw, 1.0f, 1), __builtin_bit_cast(h2v, xq1), d1, false);
        d2 = __builtin_amdgcn_fdot2(__builtin_amdgcn_cvt_scalef32_pk_f16_fp4(uw, 1.0f, 2), __builtin_bit_cast(h2v, xq2), d2, false);
        d3 = __builtin_amdgcn_fdot2(__builtin_amdgcn_cvt_scalef32_pk_f16_fp4(uw, 1.0f, 3), __builtin_bit_cast(h2v, xq3), d3, false);
    }
    const float dot = wave_sum_dpp((d0 + d1) + (d2 + d3)) * (1.0f / 128.0f);
    const float a = pg8::gelu_tanh(dot) * gate * (1.0f / PV_SCALE);
    const h2v a2 = {(_Float16)a, (_Float16)a};
#pragma unroll
    for (int w = 0; w < 4; ++w) {
        y[4 * w + 0] = a2 * __builtin_amdgcn_cvt_scalef32_pk_f16_fp4(va[w], 1.0f, 0) + y[4 * w + 0]; y[4 * w + 1] = a2 * __builtin_amdgcn_cvt_scalef32_pk_f16_fp4(va[w], 1.0f, 1) + y[4 * w + 1];
        y[4 * w + 2] = a2 * __builtin_amdgcn_cvt_scalef32_pk_f16_fp4(va[w], 1.0f, 2) + y[4 * w + 2]; y[4 * w + 3] = a2 * __builtin_amdgcn_cvt_scalef32_pk_f16_fp4(va[w], 1.0f, 3) + y[4 * w + 3];
    }
#pragma unroll
    for (int w = 0; w < 4; ++w) {
        y[16 + 4 * w + 0] = a2 * __builtin_amdgcn_cvt_scalef32_pk_f16_fp4(vd[w], 1.0f, 0) + y[16 + 4 * w + 0]; y[16 + 4 * w + 1] = a2 * __builtin_amdgcn_cvt_scalef32_pk_f16_fp4(vd[w], 1.0f, 1) + y[16 + 4 * w + 1];
        y[16 + 4 * w + 2] = a2 * __builtin_amdgcn_cvt_scalef32_pk_f16_fp4(vd[w], 1.0f, 2) + y[16 + 4 * w + 2]; y[16 + 4 * w + 3] = a2 * __builtin_amdgcn_cvt_scalef32_pk_f16_fp4(vd[w], 1.0f, 3) + y[16 + 4 * w + 3];
    }
}
__device__ __forceinline__ int sel_id(int id0, int id1, int e) { return (e < 64) ? __builtin_amdgcn_readlane(id0, e & 63) : __builtin_amdgcn_readlane(id1, e & 63); }
__device__ __forceinline__ float sel_gate(float g0, float g1, int e) { return __builtin_bit_cast(float, (e < 64) ? __builtin_amdgcn_readlane(__builtin_bit_cast(int, g0), e & 63) : __builtin_amdgcn_readlane(__builtin_bit_cast(int, g1), e & 63)); }
template <bool HALF>
__device__ __forceinline__ void peer_item(Frame& F, const int tok, const int half, const int ti) {
    const bf16* h1b = (const bf16*)(F.ws + WS_H1B);
    const unsigned char* PU = F.ws + WS_PU; const unsigned char* PV = F.ws + WS_PV;
    const int* seli = (const int*)(F.ws + WS_SELI); const float* selg = (const float*)(F.ws + WS_SELG);
    const GAS float* lg0 = (const GAS float*)F.in[I_LNFG]; const GAS float* lb0 = (const GAS float*)F.in[I_LNFB];
    unsigned lseed = 0u; asm volatile("" : "+v"(lseed)); const int lane = (int)__builtin_amdgcn_mbcnt_hi(~0u, __builtin_amdgcn_mbcnt_lo(~0u, lseed));
    h2v y16[32];
    f32x2v y[32];
    LAS unsigned char* xl = F.lds + RING_OFF + F.wave * 8192 + lane * 16;
    { LAS unsigned char* xw_ = xl; const GAS bf16* xr = (const GAS bf16*)(h1b + (size_t)tok * D) + lane;
#pragma unroll
      for (int k = 0; k < 32; ++k) { const h2v xp = {(_Float16)__builtin_bit_cast(float, (unsigned)xr[(2 * k) * 64] << 16), (_Float16)__builtin_bit_cast(float, (unsigned)xr[(2 * k + 1) * 64] << 16)};
          *(LAS h2v*)(xw_ + (k >> 2) * 1024 + (k & 3) * 4) = xp; y16[k] = (h2v){(_Float16)0.f, (_Float16)0.f}; } }
    asm volatile("" : "+v"(xl));
    const int ida = seli[(size_t)tok * 128 + lane], idb = seli[(size_t)tok * 128 + 64 + lane];
    const float g0 = selg[(size_t)tok * 128 + lane], g1 = selg[(size_t)tok * 128 + 64 + lane];
    int id0, id1, sl0, sl1;
    {   const unsigned k0 = (unsigned)ida * 128u + (unsigned)lane, k1 = (unsigned)idb * 128u + 64u + (unsigned)lane;
        int r0 = 0, r1 = 0;
#pragma unroll 8
        for (int j = 0; j < 64; ++j) {
            const unsigned a = (unsigned)__builtin_amdgcn_readlane((int)k0, j), b = (unsigned)__builtin_amdgcn_readlane((int)k1, j);
            r0 += (int)(a < k0) + (int)(b < k0); r1 += (int)(a < k1) + (int)(b < k1);
        }
        LAS unsigned* sk = (LAS unsigned*)(F.lds + RING_OFF + 65536 + F.wave * 512);
        sk[r0] = k0; sk[r1] = k1;
        asm volatile("s_waitcnt lgkmcnt(0)" ::: "memory");
        const unsigned s0k = sk[lane], s1k = sk[64 + lane];
        asm volatile("s_waitcnt lgkmcnt(0)" ::: "memory");
        id0 = (int)(s0k >> 7); id1 = (int)(s1k >> 7); sl0 = (int)(s0k & 127u); sl1 = (int)(s1k & 127u);
    }
    constexpr int NE = HALF ? 64 : DBG_NEXPERTS;
    const int idh = half ? id1 : id0, slh = half ? sl1 : sl0;
#define PEER_ID(e) (HALF ? __builtin_amdgcn_readlane(idh, (e) & 63) : sel_id(id0, id1, (e)))
#define PEER_GT(e) sel_gate(g0, g1, (HALF ? __builtin_amdgcn_readlane(slh, (e) & 63) : sel_id(sl0, sl1, (e))))
    PEER_DECL(s0); PEER_DECL(s1); PEER_DECL(s2);
    PEER_LOAD(s0, PEER_ID(0));
    PEER_LOAD(s1, PEER_ID(1));
#pragma unroll 1
    for (int e = 0; e < NE - 2; e += 3) {
        PEER_LOAD(s2, PEER_ID(e + 2));
        PEER_RUN(s0, PEER_GT(e));
        PEER_LOAD(s0, PEER_ID(e + 3));
        PEER_RUN(s1, PEER_GT(e + 1));
        PEER_LOAD(s1, PEER_ID((e + 4) & (NE - 1)));
        PEER_RUN(s2, PEER_GT(e + 2));
    }
    if (HALF) { PEER_RUN(s0, PEER_GT(63)); }
    else if (DBG_NEXPERTS == 128) { PEER_RUN(s0, PEER_GT(126)); PEER_RUN(s1, PEER_GT(127)); }
#undef PEER_ID
#undef PEER_GT
#pragma unroll
    for (int k = 0; k < 32; ++k) y[k] = __builtin_convertvector(y16[k], f32x2v);
    if (HALF) {
        gu64* yp = (gu64*)(F.ws + WS_YP) + (size_t)(ti * 2 + half) * 2048 + lane;
#pragma unroll
        for (int k = 0; k < 32; ++k) __hip_atomic_store(yp + k * 64, __builtin_bit_cast(unsigned long long, y[k]), __ATOMIC_RELAXED, __HIP_MEMORY_SCOPE_AGENT);
        asm volatile("s_waitcnt vmcnt(0)" ::: "memory");
        unsigned old = 0u;
        if (lane == 0) old = __hip_atomic_fetch_add(F.ctl + CW_DONE + ti, 1u, __ATOMIC_RELAXED, __HIP_MEMORY_SCOPE_AGENT);
        old = (unsigned)__builtin_amdgcn_readfirstlane((int)old);
        if (old == 0u) return;
        __builtin_amdgcn_fence(__ATOMIC_ACQUIRE, "agent");
        const GAS f32x2v* op = (const GAS f32x2v*)(F.ws + WS_YP) + (size_t)(ti * 2 + (half ^ 1)) * 2048 + lane;
#pragma unroll
        for (int k = 0; k < 32; ++k) y[k] = y[k] + op[k * 64];
    }
    float s = 0.f;
    asm volatile("" : "+v"(xl));
#pragma unroll
    for (int k = 0; k < 32; ++k) { const f32x2v xw = __builtin_convertvector(*(const LAS h2v*)(xl + (k >> 2) * 1024 + (k & 3) * 4), f32x2v); y[k] = xw * ALPHA + y[k]; s += y[k].x + y[k].y; }
    const float mean = wave_sum_dpp(s) * (1.f / D); float s2 = 0.f;
#pragma unroll
    for (int k = 0; k < 32; ++k) { y[k] = y[k] - mean; s2 += y[k].x * y[k].x + y[k].y * y[k].y; }
    const float rstd = 1.f / sqrtf(wave_sum_dpp(s2) * (1.f / D) + LN_EPS);
    GAS float* orow = (GAS float*)(F.out + (size_t)tok * D) + lane;
    const GAS float* lgp = lg0 + lane; const GAS float* lbp = lb0 + lane;
#pragma unroll
    for (int k = 0; k < 32; ++k) {
        const float o0 = y[k].x * rstd * lgp[(2 * k) * 64] + lbp[(2 * k) * 64], o1 = y[k].y * rstd * lgp[(2 * k + 1) * 64] + lbp[(2 * k + 1) * 64];
        orow[(2 * k) * 64] = o0; orow[(2 * k + 1) * 64] = o1;
    }
}
__device__ __forceinline__ void p9_peer(Frame& F) {
    const int gw = F.vcu * NWAVES + F.wave, NGW = F.G * NWAVES;
    const int rounds = T / NGW > 1 ? T / NGW - 1 : 0;
    const int n_static = rounds * NGW;
#pragma unroll 1
    for (int tok = gw; tok < n_static; tok += NGW) peer_item<false>(F, tok, 0, 0);
    const int n_items = 2 * (T - n_static), per = (n_items + P11_NSH - 1) / P11_NSH;
    int sh = gw % P11_NSH;
#pragma unroll 1
    for (int tries = 0; tries < P11_NSH;) {
        unsigned t = 0u;
        if (F.lane == 0) t = __hip_atomic_fetch_add(F.ctl + CW_P11 + sh * 32, 1u, __ATOMIC_RELAXED, __HIP_MEMORY_SCOPE_AGENT);
        t = (unsigned)__builtin_amdgcn_readfirstlane((int)t);
        const int item = sh * per + (int)t;
        if ((int)t >= per || item >= n_items) { sh = (sh + 1 == P11_NSH) ? 0 : sh + 1; ++tries; continue; }
        peer_item<true>(F, n_static + (item >> 1), item & 1, item >> 1);
    }
}

struct Args { const float* in[23]; float* out; unsigned char* ws; int ph_lo, ph_hi, li, pad; };
__global__ void __launch_bounds__(NWAVES * 64, 2) fwd_kernel(Args args) {
    extern __shared__ __attribute__((aligned(16))) unsigned char lds[];
    Frame F;
    F.lds = (LAS unsigned char*)lds;
    F.MISC = (volatile LAS unsigned*)(F.lds + MISC_OFF);
    F.tid = threadIdx.x; F.lane = F.tid & 63; F.wave = __builtin_amdgcn_readfirstlane(F.tid >> 6);
    F.G = gridDim.x; { const int bx = blockIdx.x; F.vcu = (F.G % 8 == 0) ? (bx % 8) * (F.G / 8) + bx / 8 : bx; }
    F.ws = args.ws; F.out = args.out;
    F.ctl = (gu32*)(args.ws + WS_CTL);
#pragma unroll
    for (int i = 0; i < 23; ++i) F.in[i] = args.in[i];
    for (int u = F.tid; u < (LDS_BYTES - LDSCTL_OFF) / 4; u += NWAVES * 64) ((LAS unsigned*)(F.lds + LDSCTL_OFF))[u] = 0u;
    __syncthreads();
    XcdBarrier bar; bar.bar = (unsigned*)(F.ctl + CW_BAR); bar.x = 0; bar.st = nullptr;
    if (N_LAUNCHES == 1) bar = xcd_barrier_post((unsigned*)(F.ctl + CW_BAR), F.MISC + 8);
#define PROBE_ON (DBG_PROBE_A >= 0 || DBG_PROBE_B >= 0)
    int n_stamp = 0;
#define STAMP() do { if (PROBE_ON && blockIdx.x == 0 && F.tid == 0) { ((unsigned long long*)(args.ws + 8192))[n_stamp] = __builtin_amdgcn_s_memrealtime(); } ++n_stamp; } while (0)
    STAMP();
#define GRID_BAR() do { if (N_LAUNCHES == 1) xcd_barrier(bar); STAMP(); if (PROBE_ON && blockIdx.x == 0 && F.tid == 0) ((unsigned long long*)(args.ws + 8192 + 512))[n_stamp - 1] = __builtin_amdgcn_s_memtime(); } while (0)
    const int lo = args.ph_lo, hi = args.ph_hi;
#ifndef PHASE_MASK
#define PHASE_MASK 0xfff
#endif
#define IN(k) (((PHASE_MASK >> (k)) & 1) && lo <= (k) && (k) < hi)
#define BOTH(k) (IN(k) && IN((k) + 1))
    unsigned char* ws = args.ws;

    if (IN(0)) { p0_prologue(F); if (BOTH(0)) GRID_BAR(); }

    if (IN(1)) {
        pg8::Gemm g{(const pg8::bf16_t*)(ws + WS_XA), (const pg8::bf16_t*)(ws + WS_WALL), MALL, NALL, D / 2, 127, 121, P1_PITCH / 2};
        const int nconv = (F.G % 8 == 0 && F.G >= 64) ? F.G / 8 : 0, GG = F.G - nconv;
        pg8::SchedP1 S; S.init(GG, (int)blockIdx.x);
        pg8::EpiProj E{(pg8::bf16_t*)(ws + WS_PROJ), (pg8::bf16_t*)(ws + WS_GATES), (pg8::bf16_t*)(ws + WS_MKV), F.in[I_BGATE], (const float*)(ws + WS_ROPE)};
        if ((int)blockIdx.x < GG) pg8::gemm_phase<pg8::EpiProj, pg8::SchedP1, PG8_ALIGN, PG8_SP2, 1>(F.lds + RING_OFF, g, S, E);
        if ((int)blockIdx.x < GG) {
            pg8::Gemm g4{(const pg8::bf16_t*)(ws + WS_XA4), (const pg8::bf16_t*)(ws + WS_WG4), T, GATEW, D / 4, 126, 120, P1B_PITCH / 2};
            pg8::StaticOrder S4; S4.init(T, GATEW, GG, (int)blockIdx.x);
            pg8::EpiGate E4{E};
            pg8::gemm_phase<pg8::EpiGate, pg8::StaticOrder, PG8_ALIGN, PG8_SP2, 2>(F.lds + RING_OFF, g4, S4, E4);
        }
        peer_tables_convert(F);
        if (BOTH(1)) GRID_BAR();
    }

    if (IN(2)) { p2_mixers(F); if (BOTH(2)) GRID_BAR(); }

    if (IN(3)) { p3_merge(F); if (BOTH(3)) GRID_BAR(); }

    if (IN(4)) {
        pg8::StaticOrder S; S.init(T, D, F.G, (int)blockIdx.x);
        pg8::Gemm g{(const pg8::bf16_t*)(ws + WS_AOUT), (const pg8::bf16_t*)(ws + WS_WBRA), T, D, ACT_PITCH / 2, 124, 121};
        pg8::EpiMerge3 E{(const unsigned char*)(ws + WS_GATES), (pg8::bf16_t*)(ws + WS_MERGEDB)};
        pg8::gemm_phase<pg8::EpiMerge3, pg8::StaticOrder, PG8_ALIGN, PG8_SP2, 1>(F.lds + RING_OFF, g, S, E);
        if (BOTH(4)) GRID_BAR();
    }

    if (IN(7)) {
        pg8::Gemm g{(const pg8::bf16_t*)(ws + (DBG_P5A == 1 ? WS_XA : (DBG_P5A == 2 ? WS_PROJ : (DBG_P5A == 3 ? WS_AOUT : (DBG_P5A == 4 ? WS_GATES : (DBG_P5A == 5 ? WS_GATES + 128 * MiB : WS_MERGEDB)))))), (const pg8::bf16_t*)(ws + WS_WOUT), T, D, D / 2, 124, 121};
        pg8::StaticOrder S; S.init(T, D, F.G, (int)blockIdx.x);
        pg8::EpiResid E{F.in[I_X], (pg8::bf16_t*)(ws + WS_Z), ALPHA};
        pg8::gemm_phase<pg8::EpiResid, pg8::StaticOrder, PG8_ALIGN, PG8_SP2, 1>(F.lds + RING_OFF, g, S, E);
        if (BOTH(7)) GRID_BAR();
    }

    if (IN(8)) { p6_layernorm(F); if (BOTH(8)) GRID_BAR(); }

    if (IN(9)) {
        pg8::Gemm g{(const pg8::bf16_t*)(ws + WS_H1B), (const pg8::bf16_t*)(ws + WS_WQ), T, 2048, D};
        pg8::StaticOrder S; S.init(T, 2048, F.G, (int)blockIdx.x);
        pg8::EpiPlain E{(pg8::bf16_t*)(ws + WS_Q), 2048};
        pg8::gemm_phase<pg8::EpiPlain, pg8::StaticOrder, PG8_ALIGN, PG8_SP2>(F.lds + RING_OFF, g, S, E);
        if (BOTH(9)) GRID_BAR();
    }

    if (IN(10)) { p8_topk(F); if (BOTH(10)) GRID_BAR(); }

    if (IN(11)) { p9_peer(F); }
#undef IN
#undef BOTH
#undef GRID_BAR
}

extern "C" void kernel_launch(void* const* d_in, const int* in_sizes, int n_in, void* d_out, int out_size, void* d_ws, size_t ws_size, hipStream_t stream) {
    static int grid = 0;
    if (grid == 0) {
        if (n_in != 23 || in_sizes[0] != T * D || out_size != T * D || ws_size < WS_END) { fprintf(stderr, "kernel_launch: unexpected shapes (n_in %d, in0 %d, out %d, ws %zu); nothing launched\n", n_in, n_in > 0 ? in_sizes[0] : -1, out_size, ws_size); grid = -1; return; }
        int dev = 0, cus = 0, per_cu = 0;
        if (hipGetDevice(&dev) != hipSuccess || hipDeviceGetAttribute(&cus, hipDeviceAttributeMultiprocessorCount, dev) != hipSuccess) { grid = -1; return; }
        if (hipFuncSetAttribute((const void*)fwd_kernel, hipFuncAttributeMaxDynamicSharedMemorySize, LDS_BYTES) != hipSuccess) { fprintf(stderr, "kernel_launch: hipFuncSetAttribute failed\n"); grid = -1; return; }
        if (hipOccupancyMaxActiveBlocksPerMultiprocessor(&per_cu, (const void*)fwd_kernel, NWAVES * 64, LDS_BYTES) != hipSuccess || per_cu < 1)
            fprintf(stderr, "kernel_launch: note: occupancy query reports %d workgroups per CU\n", per_cu);
        (void)hipGetLastError();
        grid = cus;
    }
    if (grid < 0) return;
    if (hipMemsetAsync((char*)d_ws + WS_CTL, 0, CTL_ZERO_BYTES, stream) != hipSuccess) return;
    Args a{};
    for (int i = 0; i < 23; ++i) a.in[i] = (const float*)d_in[i];
    a.out = (float*)d_out; a.ws = (unsigned char*)d_ws; a.pad = 0;
    for (int li = 0; li < N_LAUNCHES; ++li) {
        a.ph_lo = (N_LAUNCHES == 1) ? 0 : li; a.ph_hi = (N_LAUNCHES == 1) ? N_PHASES : li + 1; a.li = li;
        hipLaunchKernelGGL(fwd_kernel, dim3(grid), dim3(NWAVES * 64), LDS_BYTES, stream, a);
        if (hipPeekAtLastError() != hipSuccess) break;
    }
}
```
